# Optimizing an MI355X kernel written in HIP

```python
import math
import jax
import jax.numpy as jnp
from jax import lax
import numpy as np

D_MODEL = 1024
BATCH = 8
SEQ = 4096
DEPTH = 2

CTX_LEN = 256
GRID_W = 64

LRU_WIDTH = 512
LRU_HEADS = 8
LRU_BLOCK = LRU_WIDTH // LRU_HEADS
CONV_W = 4
LRU_C = 8.0
DA_HEADS = 4
DA_HEAD_DIM = 64
DA_V_DIM = 2 * DA_HEAD_DIM
DA_WIDTH = DA_HEADS * DA_V_DIM
Q_BLOCK = 128
ROPE_BASE = 10000.0
IN_EVEN = 2 * LRU_WIDTH + 3 * DA_WIDTH
IN_SPLITS = (LRU_WIDTH, 2 * LRU_WIDTH, 2 * LRU_WIDTH + DA_WIDTH, 2 * LRU_WIDTH + 2 * DA_WIDTH)
FNET_GROUPS = 4
FNET_GROUP_DIM = D_MODEL // FNET_GROUPS
N_GROUPS = 4
EXPERTS_PER_GROUP = 8
N_EXPERTS = N_GROUPS * EXPERTS_PER_GROUP
TOP_K = 2
EXPERT_FF = 512
MOE_BLOCK = 128
LN_EPS = 1e-6
ALPHA = (2.0 * DEPTH) ** 0.25
BETA = (8.0 * DEPTH) ** -0.25

kernel_name = "hybrid_rglru_diffattn_fnet_hmoe_dit"


def _layer_norm(x, gain=None, bias=None):
    xf = x.astype(jnp.float32)
    mu = jnp.mean(xf, axis=-1, keepdims=True)
    var = jnp.mean(jnp.square(xf - mu), axis=-1, keepdims=True)
    y = (xf - mu) * lax.rsqrt(var + LN_EPS)
    if gain is not None:
        y = y * gain.astype(jnp.float32) + bias.astype(jnp.float32)
    return y.astype(x.dtype)


def _rms_norm(x, gain):
    xf = x.astype(jnp.float32)
    y = xf * lax.rsqrt(jnp.mean(jnp.square(xf), axis=-1, keepdims=True) + LN_EPS)
    return (y * gain.astype(jnp.float32)).astype(x.dtype)


def _modulate(x, shift, scale):
    return _layer_norm(x) * (1.0 + scale) + shift


def _ada_terms(cond, w, b):
    m = jax.nn.silu(cond) @ w + b
    m = m.reshape(m.shape[:-1] + (1, 6, D_MODEL))
    return [m[..., k, :] for k in range(6)]


def _axial_rope_tables(n_tok, dtype):
    t = jnp.arange(n_tok)
    row = (t // GRID_W).astype(jnp.float32)
    col = (t % GRID_W).astype(jnp.float32)
    nf = DA_HEAD_DIM // 4
    freqs = ROPE_BASE ** (-jnp.arange(nf, dtype=jnp.float32) / nf)
    ang = jnp.stack([row[:, None] * freqs, col[:, None] * freqs], axis=1)
    return jnp.cos(ang).astype(dtype), jnp.sin(ang).astype(dtype)


def _apply_axial_rope(x, cos, sin):
    xs = x.reshape(x.shape[:-1] + (2, 2, DA_HEAD_DIM // 4))
    x1 = xs[..., 0, :]
    x2 = xs[..., 1, :]
    out = jnp.stack([x1 * cos - x2 * sin, x2 * cos + x1 * sin], axis=-2)
    return out.reshape(x.shape)


def _diff_attend(q1, q2, k1, k2, v, lam):
    scale = DA_HEAD_DIM ** -0.5
    s1 = jnp.einsum('bhqd,bhkd->bhqk', q1, k1).astype(jnp.float32) * scale
    s2 = jnp.einsum('bhqd,bhkd->bhqk', q2, k2).astype(jnp.float32) * scale
    a = jax.nn.softmax(s1, axis=-1) - lam * jax.nn.softmax(s2, axis=-1)
    return jnp.einsum('bhqk,bhkv->bhqv', a.astype(v.dtype), v)


def _diff_attn_latent(q1, q2, k1, k2, v, lam):
    b, h, n, dh = q1.shape
    nb = n // Q_BLOCK

    def to_blocks(q):
        return jnp.moveaxis(q.reshape(b, h, nb, Q_BLOCK, dh), 2, 0)

    def one_block(qs):
        return _diff_attend(qs[0], qs[1], k1, k2, v, lam)

    out = lax.map(one_block, (to_blocks(q1), to_blocks(q2)))
    return jnp.moveaxis(out, 0, 2).reshape(b, h, n, DA_V_DIM)


def _merge_heads(o, gain, lam_init):
    b, h, n, dv = o.shape
    o = _rms_norm(o, gain) * (1.0 - lam_init)
    return o.transpose(0, 2, 1, 3).reshape(b, n, h * dv)


def _short_conv(x, w, b):
    n = x.shape[1]
    left = CONV_W // 2
    xp = jnp.pad(x, ((0, 0), (left, CONV_W - 1 - left), (0, 0)))
    y = b
    for k in range(CONV_W):
        y = y + xp[:, k:k + n] * w[k]
    return y


def _lru_coeffs(xc, wa, ba, wx, bx, lam):
    b, n, w = xc.shape
    xb = xc.reshape(b, n, LRU_HEADS, LRU_BLOCK)
    r = jax.nn.sigmoid((jnp.einsum('bnhi,hij->bnhj', xb, wa).reshape(b, n, w) + ba).astype(jnp.float32))
    i = jax.nn.sigmoid((jnp.einsum('bnhi,hij->bnhj', xb, wx).reshape(b, n, w) + bx).astype(jnp.float32))
    log_a = -LRU_C * jax.nn.softplus(-lam.astype(jnp.float32)) * r
    a = jnp.exp(log_a)
    mult = jnp.sqrt(-jnp.expm1(2.0 * log_a))
    return a, mult * i * xc.astype(jnp.float32)


def _combine(left, right):
    return left[0] * right[0], right[0] * left[1] + right[1]


def _linear_scan(a, b, h0, reverse):
    if reverse:
        a = jnp.flip(a, axis=1)
        b = jnp.flip(b, axis=1)
    a_cum, b_cum = lax.associative_scan(_combine, (a, b), axis=1)
    h = a_cum * h0[:, None, :] + b_cum
    return jnp.flip(h, axis=1) if reverse else h


def _rglru_bidir(xc_ctx, xc_lat, wa, ba, wx, bx, lam):
    y_ctx = jnp.zeros(xc_ctx.shape, jnp.float32)
    y_lat = jnp.zeros(xc_lat.shape, jnp.float32)
    h_zero = jnp.zeros((xc_ctx.shape[0], xc_ctx.shape[2]), jnp.float32)
    for d, rev in ((0, False), (1, True)):
        a_c, b_c = _lru_coeffs(xc_ctx, wa[d], ba[d], wx[d], bx[d], lam[d])
        h_c = _linear_scan(a_c, b_c, h_zero, rev)
        h_final = h_c[:, 0] if rev else h_c[:, -1]
        a_l, b_l = _lru_coeffs(xc_lat, wa[d], ba[d], wx[d], bx[d], lam[d])
        h_l = _linear_scan(a_l, b_l, h_final, rev)
        y_ctx = y_ctx + h_c
        y_lat = y_lat + h_l
    return y_ctx, y_lat


def _project_even(h, w_in):
    b, n, _ = h.shape
    gate, xr, q, k, v = jnp.split(h @ w_in, IN_SPLITS, axis=-1)
    q = q.reshape(b, n, DA_HEADS, 2, DA_HEAD_DIM).transpose(3, 0, 2, 1, 4)
    k = k.reshape(b, n, DA_HEADS, 2, DA_HEAD_DIM).transpose(3, 0, 2, 1, 4)
    v = v.reshape(b, n, DA_HEADS, DA_V_DIM).transpose(0, 2, 1, 3)
    return gate, xr, q, k, v


def _even_mixer(h_lat, h_ctx, w_in, conv_w, conv_b, ga_w, ga_b, gx_w, gx_b, lru_lambda,
                da_lambda, da_subln, w_out, lam_init, ctx_out):
    g_l, xr_l, q_l, k_l, v_l = _project_even(h_lat, w_in)
    g_c, xr_c, q_c, k_c, v_c = _project_even(h_ctx, w_in)
    cos, sin = _axial_rope_tables(h_lat.shape[1], q_l.dtype)
    q_l = _apply_axial_rope(q_l, cos, sin)
    k_l = _apply_axial_rope(k_l, cos, sin)
    lf = da_lambda.astype(jnp.float32)
    lam = jnp.exp(jnp.sum(lf[0] * lf[1])) - jnp.exp(jnp.sum(lf[2] * lf[3])) + lam_init
    k_all = jnp.concatenate([k_c, k_l], axis=3)
    v_all = jnp.concatenate([v_c, v_l], axis=2)
    o_l = _diff_attn_latent(q_l[0], q_l[1], k_all[0], k_all[1], v_all, lam)
    xc_l = _short_conv(xr_l, conv_w, conv_b)
    xc_c = _short_conv(xr_c, conv_w, conv_b)
    r_c, r_l = _rglru_bidir(xc_c, xc_l, ga_w, ga_b, gx_w, gx_b, lru_lambda)
    y_lat = jnp.concatenate([r_l.astype(h_lat.dtype) * jax.nn.gelu(g_l),
                             _merge_heads(o_l, da_subln, lam_init)], axis=-1) @ w_out
    if not ctx_out:
        return y_lat, None
    o_c = _diff_attend(q_c[0], q_c[1], k_c[0], k_c[1], v_c, lam)
    y_ctx = jnp.concatenate([r_c.astype(h_ctx.dtype) * jax.nn.gelu(g_c),
                             _merge_heads(o_c, da_subln, lam_init)], axis=-1) @ w_out
    return y_lat, y_ctx


def _fourier_mix(h, w, b):
    bsz, n, d = h.shape
    hg = h.astype(jnp.float32).reshape(bsz, n, FNET_GROUPS, FNET_GROUP_DIM).transpose(0, 2, 1, 3)
    y = jnp.fft.fft2(hg, axes=(-2, -1), norm='ortho').real
    y = y.transpose(0, 2, 1, 3).reshape(bsz, n, d).astype(h.dtype)
    return y @ w + b


def _hier_moe(t, wg, bg, wf, bf, w1, w3, w2):
    n_tok, d = t.shape
    g_logits = (t @ wg + bg).astype(jnp.float32)
    g_prob = jax.nn.softmax(g_logits, axis=-1)
    g_idx = jnp.argmax(g_logits, axis=-1)
    p_g = jnp.take_along_axis(g_prob, g_idx[:, None], axis=-1)
    f_logits = (t @ wf + bf).astype(jnp.float32).reshape(n_tok, N_GROUPS, EXPERTS_PER_GROUP)
    f_sel = jnp.take_along_axis(f_logits, g_idx[:, None, None], axis=1)[:, 0]
    top_v, top_j = lax.top_k(f_sel, TOP_K)
    gate_w = (jax.nn.softmax(top_v, axis=-1) * p_g).astype(t.dtype)
    e_idx = g_idx[:, None].astype(jnp.int32) * EXPERTS_PER_GROUP + top_j.astype(jnp.int32)
    m = n_tok * TOP_K
    flat_e = e_idx.reshape(m)
    flat_w = gate_w.reshape(m)
    flat_tok = jnp.repeat(jnp.arange(n_tok, dtype=jnp.int32), TOP_K)
    order = jnp.argsort(flat_e)
    s_e = flat_e[order]
    counts = jnp.bincount(flat_e, length=N_EXPERTS).astype(jnp.int32)
    padded = ((counts + MOE_BLOCK - 1) // MOE_BLOCK) * MOE_BLOCK
    start = jnp.cumsum(counts) - counts
    pend = jnp.cumsum(padded)
    pstart = pend - padded
    dest = pstart[s_e] + jnp.arange(m, dtype=jnp.int32) - start[s_e]
    n_blocks = -(-m // MOE_BLOCK) + N_EXPERTS
    n_rows = n_blocks * MOE_BLOCK
    row_tok = jnp.full((n_rows,), n_tok, dtype=jnp.int32).at[dest].set(flat_tok[order])
    row_w = jnp.zeros((n_rows,), t.dtype).at[dest].set(flat_w[order])
    block_start = jnp.arange(n_blocks, dtype=jnp.int32) * MOE_BLOCK
    block_e = jnp.minimum(jnp.searchsorted(pend, block_start, side='right'), N_EXPERTS - 1)
    t_pad = jnp.concatenate([t, jnp.zeros((1, d), t.dtype)], axis=0)
    xb = t_pad[row_tok].reshape(n_blocks, MOE_BLOCK, d)

    def expert_block(args):
        xe, e = args
        hid = jax.nn.silu(xe @ w1[e]) * (xe @ w3[e])
        return hid @ w2[e]

    yb = lax.map(expert_block, (xb, block_e))
    y = yb.reshape(n_rows, d) * row_w[:, None]
    return jnp.zeros((n_tok + 1, d), t.dtype).at[row_tok].add(y)[:n_tok]


def setup_inputs(seed: int = 0) -> dict:
    key = jax.random.key(seed)
    ks = iter(jax.random.split(key, 40))
    n_even = (DEPTH + 1) // 2
    n_odd = DEPTH // 2
    d = D_MODEL

    def nrm(shape, scale):
        return jax.random.normal(next(ks), shape, jnp.float32) * scale

    x = nrm((BATCH, SEQ, d), 1.0)
    c = nrm((BATCH, d), 1.0)
    ctx = nrm((BATCH, CTX_LEN, d), 1.0)
    c_ctx = nrm((d,), 1.0)
    ada_w = nrm((DEPTH, d, 6 * d), 0.5 * d ** -0.5)
    ada_b = nrm((DEPTH, 6 * d), 0.02)
    ln_g = 1.0 + nrm((DEPTH, 2, d), 0.02)
    ln_b = nrm((DEPTH, 2, d), 0.02)
    ev_w_in = nrm((n_even, d, IN_EVEN), d ** -0.5)
    ev_conv_w = nrm((n_even, CONV_W, LRU_WIDTH), CONV_W ** -0.5)
    ev_conv_b = nrm((n_even, LRU_WIDTH), 0.02)
    ev_gate_a_w = nrm((n_even, 2, LRU_HEADS, LRU_BLOCK, LRU_BLOCK), LRU_BLOCK ** -0.5)
    ev_gate_a_b = nrm((n_even, 2, LRU_WIDTH), 0.02)
    ev_gate_x_w = nrm((n_even, 2, LRU_HEADS, LRU_BLOCK, LRU_BLOCK), LRU_BLOCK ** -0.5)
    ev_gate_x_b = nrm((n_even, 2, LRU_WIDTH), 0.02)
    u = jax.random.uniform(next(ks), (n_even, 2, LRU_WIDTH), jnp.float32, minval=0.9, maxval=0.999)
    a0 = u ** (1.0 / LRU_C)
    ev_lru_lambda = jnp.log(a0) - jnp.log1p(-a0)
    ev_da_lambda = nrm((n_even, 4, DA_HEAD_DIM), 0.1)
    ev_da_subln = 1.0 + nrm((n_even, DA_V_DIM), 0.02)
    ev_w_out = nrm((n_even, LRU_WIDTH + DA_WIDTH, d), BETA * (LRU_WIDTH + DA_WIDTH) ** -0.5)
    od_w_out = nrm((n_odd, d, d), BETA * d ** -0.5)
    od_b_out = nrm((n_odd, d), 0.02)
    moe_wg = nrm((DEPTH, d, N_GROUPS), d ** -0.5)
    moe_bg = nrm((DEPTH, N_GROUPS), 0.01)
    moe_wf = nrm((DEPTH, d, N_EXPERTS), d ** -0.5)
    moe_bf = nrm((DEPTH, N_EXPERTS), 0.01)
    moe_w1 = nrm((DEPTH, N_EXPERTS, d, EXPERT_FF), d ** -0.5)
    moe_w3 = nrm((DEPTH, N_EXPERTS, d, EXPERT_FF), d ** -0.5)
    moe_w2 = nrm((DEPTH, N_EXPERTS, EXPERT_FF, d), BETA * EXPERT_FF ** -0.5)
    return {"x": x, "c": c, "ctx": ctx, "c_ctx": c_ctx, "ada_w": ada_w, "ada_b": ada_b,
            "ln_g": ln_g, "ln_b": ln_b, "ev_w_in": ev_w_in, "ev_conv_w": ev_conv_w,
            "ev_conv_b": ev_conv_b, "ev_gate_a_w": ev_gate_a_w, "ev_gate_a_b": ev_gate_a_b,
            "ev_gate_x_w": ev_gate_x_w, "ev_gate_x_b": ev_gate_x_b, "ev_lru_lambda": ev_lru_lambda,
            "ev_da_lambda": ev_da_lambda, "ev_da_subln": ev_da_subln, "ev_w_out": ev_w_out,
            "od_w_out": od_w_out, "od_b_out": od_b_out, "moe_wg": moe_wg, "moe_bg": moe_bg,
            "moe_wf": moe_wf, "moe_bf": moe_bf, "moe_w1": moe_w1, "moe_w3": moe_w3, "moe_w2": moe_w2}


def reference(x, c, ctx, c_ctx, ada_w, ada_b, ln_g, ln_b, ev_w_in, ev_conv_w, ev_conv_b,
              ev_gate_a_w, ev_gate_a_b, ev_gate_x_w, ev_gate_x_b, ev_lru_lambda, ev_da_lambda,
              ev_da_subln, ev_w_out, od_w_out, od_b_out, moe_wg, moe_bg, moe_wf, moe_bf,
              moe_w1, moe_w3, moe_w2):
    bsz, n_lat, d = x.shape
    n_ctx_tok = ctx.shape[0] * ctx.shape[1]
    for l in range(DEPTH):
        ctx_live = any(m % 2 == 0 for m in range(l + 1, DEPTH))
        sh1, sc1, g1, sh2, sc2, g2 = _ada_terms(c, ada_w[l], ada_b[l])
        csh1, csc1, cg1, csh2, csc2, cg2 = _ada_terms(c_ctx, ada_w[l], ada_b[l])
        if l % 2 == 0:
            e = l // 2
            lam_init = 0.8 - 0.6 * math.exp(-0.3 * l)
            y_lat, y_ctx = _even_mixer(_modulate(x, sh1, sc1), _modulate(ctx, csh1, csc1),
                                       ev_w_in[e], ev_conv_w[e], ev_conv_b[e], ev_gate_a_w[e],
                                       ev_gate_a_b[e], ev_gate_x_w[e], ev_gate_x_b[e],
                                       ev_lru_lambda[e], ev_da_lambda[e], ev_da_subln[e],
                                       ev_w_out[e], lam_init, ctx_live)
        else:
            o = l // 2
            y_lat = _fourier_mix(_modulate(x, sh1, sc1), od_w_out[o], od_b_out[o])
            y_ctx = _fourier_mix(_modulate(ctx, csh1, csc1), od_w_out[o], od_b_out[o]) if ctx_live else None
        x = _layer_norm(ALPHA * x + g1 * y_lat, ln_g[l, 0], ln_b[l, 0])
        if ctx_live:
            ctx = _layer_norm(ALPHA * ctx + cg1 * y_ctx, ln_g[l, 0], ln_b[l, 0])
            tok = jnp.concatenate([_modulate(ctx, csh2, csc2).reshape(-1, d),
                                   _modulate(x, sh2, sc2).reshape(-1, d)], axis=0)
            mo = _hier_moe(tok, moe_wg[l], moe_bg[l], moe_wf[l], moe_bf[l], moe_w1[l], moe_w3[l], moe_w2[l])
            m_ctx = mo[:n_ctx_tok].reshape(ctx.shape)
            m_lat = mo[n_ctx_tok:].reshape(x.shape)
            ctx = _layer_norm(ALPHA * ctx + cg2 * m_ctx, ln_g[l, 1], ln_b[l, 1])
        else:
            m_lat = _hier_moe(_modulate(x, sh2, sc2).reshape(-1, d), moe_wg[l], moe_bg[l], moe_wf[l],
                              moe_bf[l], moe_w1[l], moe_w3[l], moe_w2[l]).reshape(x.shape)
        x = _layer_norm(ALPHA * x + g2 * m_lat, ln_g[l, 1], ln_b[l, 1])
    return x
```

```cpp
#include <hip/hip_runtime.h>
#include <math.h>
#include <stdio.h>

namespace {
constexpr int D = 1024, NB = 8, SEQ = 4096, CTX = 256, EXT = CTX + SEQ, NTOK = NB * SEQ;
constexpr int LW = 512, NH = 4, DH = 64, DV = 128, INE = 2560;
constexpr int NE = 32, FF = 512;
constexpr float LN_EPS = 1e-6f, ALPHA = 1.41421356237309515f;

template <class F> __global__ __launch_bounds__(256) void k_gemm(int M, int N, int K, F f) {
    __shared__ float As[16][65], Bs[16][65];
    const int z = blockIdx.z, m0 = blockIdx.y * 64, n0 = blockIdx.x * 64, tid = threadIdx.x, tx = tid & 15, ty = tid >> 4;
    float acc[4][4];
#pragma unroll
    for (int i = 0; i < 4; ++i)
#pragma unroll
        for (int j = 0; j < 4; ++j) acc[i][j] = 0.f;
    for (int k0 = 0; k0 < K; k0 += 16) {
        for (int i = tid; i < 1024; i += 256) { const int kk = i & 15, mm = i >> 4, m = m0 + mm, k = k0 + kk; As[kk][mm] = (m < M && k < K) ? f.a(z, m, k) : 0.f; }
        for (int i = tid; i < 1024; i += 256) { const int nn = i & 63, kk = i >> 6, n = n0 + nn, k = k0 + kk; Bs[kk][nn] = (n < N && k < K) ? f.b(z, k, n) : 0.f; }
        __syncthreads();
#pragma unroll
        for (int kk = 0; kk < 16; ++kk) {
            float a[4], b[4];
#pragma unroll
            for (int i = 0; i < 4; ++i) { a[i] = As[kk][ty * 4 + i]; b[i] = Bs[kk][tx * 4 + i]; }
#pragma unroll
            for (int i = 0; i < 4; ++i)
#pragma unroll
                for (int j = 0; j < 4; ++j) acc[i][j] += a[i] * b[j];
        }
        __syncthreads();
    }
#pragma unroll
    for (int i = 0; i < 4; ++i)
#pragma unroll
        for (int j = 0; j < 4; ++j) { const int m = m0 + ty * 4 + i, n = n0 + tx * 4 + j; if (m < M && n < N) f.store(z, m, n, acc[i][j]); }
}
template <class F> void gemm(hipStream_t s, int M, int N, int K, int Z, F f) {
    dim3 g((N + 63) / 64, (M + 63) / 64, Z);
    hipLaunchKernelGGL(k_gemm<F>, g, dim3(256), 0, s, M, N, K, f);
}

__device__ __forceinline__ float wsum(float v) {
#pragma unroll
    for (int o = 32; o >= 1; o >>= 1) v += __shfl_xor(v, o);
    return v;
}
__device__ __forceinline__ float wmax(float v) {
#pragma unroll
    for (int o = 32; o >= 1; o >>= 1) v = fmaxf(v, __shfl_xor(v, o));
    return v;
}
__device__ __forceinline__ float sigmoidf_(float x) { return 1.f / (1.f + expf(-x)); }
__device__ __forceinline__ float siluf_(float x) { return x / (1.f + expf(-x)); }
__device__ __forceinline__ float gelu_tanh(float x) { return 0.5f * x * (1.f + tanhf(0.7978845608028654f * (x + 0.044715f * x * x * x))); }

struct FAda {
    const float *c, *cctx, *w, *bias; float* mods;
    __device__ float a(int z, int m, int k) const { const float v = (m < 8) ? c[m * D + k] : cctx[k]; return siluf_(v); }
    __device__ float b(int z, int k, int n) const { return w[((size_t)z * D + k) * 6144 + n]; }
    __device__ void store(int z, int m, int n, float v) const { mods[((size_t)z * 9 + m) * 6144 + n] = v + bias[(size_t)z * 6144 + n]; }
};

__global__ __launch_bounds__(256) void k_lnmod(const float* in, float* out, int nrows, int rows_per_b, const float* mods, int fixed_r, int shk, int sck) {
    const int row = blockIdx.x * 4 + (threadIdx.x >> 6), lane = threadIdx.x & 63; if (row >= nrows) return;
    const int r = fixed_r >= 0 ? fixed_r : row / rows_per_b;
    const float* x = in + (size_t)row * D; float v[16]; float s = 0.f;
#pragma unroll
    for (int j = 0; j < 16; ++j) { v[j] = x[lane + 64 * j]; s += v[j]; }
    const float mean = wsum(s) * (1.f / D); float q = 0.f;
#pragma unroll
    for (int j = 0; j < 16; ++j) { v[j] -= mean; q += v[j] * v[j]; }
    const float rstd = 1.f / sqrtf(wsum(q) * (1.f / D) + LN_EPS);
    const float* sh = mods + (size_t)r * 6144 + shk * 1024; const float* sc = mods + (size_t)r * 6144 + sck * 1024;
#pragma unroll
    for (int j = 0; j < 16; ++j) { const int c = lane + 64 * j; out[(size_t)row * D + c] = v[j] * rstd * (1.f + sc[c]) + sh[c]; }
}
__global__ __launch_bounds__(256) void k_resln(float* x, const float* y, const float* bias, int nrows, int rows_per_b, int b0, const float* mods, int gk, const float* lg, const float* lb) {
    const int row = blockIdx.x * 4 + (threadIdx.x >> 6), lane = threadIdx.x & 63; if (row >= nrows) return;
    const int r = b0 + row / rows_per_b;
    float* xr = x + (size_t)row * D; const float* yr = y + (size_t)row * D; const float* g = mods + (size_t)r * 6144 + gk * 1024;
    float v[16]; float s = 0.f;
#pragma unroll
    for (int j = 0; j < 16; ++j) { const int c = lane + 64 * j; v[j] = ALPHA * xr[c] + g[c] * (yr[c] + (bias ? bias[c] : 0.f)); s += v[j]; }
    const float mean = wsum(s) * (1.f / D); float q = 0.f;
#pragma unroll
    for (int j = 0; j < 16; ++j) { v[j] -= mean; q += v[j] * v[j]; }
    const float rstd = 1.f / sqrtf(wsum(q) * (1.f / D) + LN_EPS);
#pragma unroll
    for (int j = 0; j < 16; ++j) { const int c = lane + 64 * j; xr[c] = v[j] * rstd * lg[c] + lb[c]; }
}

struct FInProj {
    const float *h, *w; float* p;
    __device__ float a(int z, int m, int k) const { return h[(size_t)m * D + k]; }
    __device__ float b(int z, int k, int n) const { return w[(size_t)k * INE + n]; }
    __device__ void store(int z, int m, int n, float v) const { p[(size_t)m * INE + n] = v; }
};
__global__ void k_rope(float* p) {
    const int idx = blockIdx.x * blockDim.x + threadIdx.x; if (idx >= SEQ * 2 * NH * 2 * 2 * 16) return;
    const int f = idx & 15, axis = (idx >> 4) & 1, s = (idx >> 5) & 1, h = (idx >> 6) & 3, which = (idx >> 8) & 1, n = idx >> 9;
    const int pos = axis == 0 ? (n >> 6) : (n & 63);
    const float freq = powf(10000.f, -(float)f / 16.f); const float ang = (float)pos * freq; const float cs = cosf(ang), sn = sinf(ang);
    float* base = p + (size_t)(CTX + n) * INE + 1024 + which * 512 + h * 128 + s * 64 + axis * 32;
    const float x1 = base[f], x2 = base[16 + f];
    base[f] = x1 * cs - x2 * sn; base[16 + f] = x2 * cs + x1 * sn;
}
struct FScore {
    const float* p; float* S; int h;
    __device__ float a(int z, int m, int k) const { return p[(size_t)(CTX + m) * INE + 1024 + h * 128 + z * 64 + k]; }
    __device__ float b(int z, int k, int n) const { return p[(size_t)n * INE + 1536 + h * 128 + z * 64 + k]; }
    __device__ void store(int z, int m, int n, float v) const { S[((size_t)z * SEQ + m) * EXT + n] = v * 0.125f; }
};
__global__ __launch_bounds__(256) void k_softdiff(float* S, const float* lamp) {
    const int row = blockIdx.x * 4 + (threadIdx.x >> 6), lane = threadIdx.x & 63; if (row >= SEQ) return;
    float* s1 = S + (size_t)row * EXT; const float* s2 = S + ((size_t)SEQ + row) * EXT; const float lam = lamp[0];
    float m1 = -INFINITY, m2 = -INFINITY;
    for (int n = lane; n < EXT; n += 64) { m1 = fmaxf(m1, s1[n]); m2 = fmaxf(m2, s2[n]); }
    m1 = wmax(m1); m2 = wmax(m2); float l1 = 0.f, l2 = 0.f;
    for (int n = lane; n < EXT; n += 64) { l1 += expf(s1[n] - m1); l2 += expf(s2[n] - m2); }
    l1 = wsum(l1); l2 = wsum(l2);
    for (int n = lane; n < EXT; n += 64) s1[n] = expf(s1[n] - m1) / l1 - lam * expf(s2[n] - m2) / l2;
}
struct FPV {
    const float *S, *p; float* O; int h;
    __device__ float a(int z, int m, int k) const { return S[(size_t)m * EXT + k]; }
    __device__ float b(int z, int k, int n) const { return p[(size_t)k * INE + 2048 + h * 128 + n]; }
    __device__ void store(int z, int m, int n, float v) const { O[(size_t)m * DV + n] = v; }
};
__global__ __launch_bounds__(256) void k_subln(const float* O, const float* subln, float* cat, int h) {
    const int row = blockIdx.x * 4 + (threadIdx.x >> 6), lane = threadIdx.x & 63; if (row >= SEQ) return;
    const float a = O[(size_t)row * DV + lane], b = O[(size_t)row * DV + 64 + lane];
    const float ms = wsum(a * a + b * b) * (1.f / DV); const float r = 1.f / sqrtf(ms + LN_EPS);
    cat[(size_t)row * D + 512 + h * 128 + lane] = a * r * subln[lane] * 0.8f;
    cat[(size_t)row * D + 512 + h * 128 + 64 + lane] = b * r * subln[64 + lane] * 0.8f;
}
__global__ void k_lam(const float* dl, float* lamp) {
    const int lane = threadIdx.x; const float a = wsum(dl[lane] * dl[64 + lane]), b = wsum(dl[128 + lane] * dl[192 + lane]);
    if (lane == 0) lamp[0] = expf(a) - expf(b) + 0.2f;
}
__global__ void k_conv(const float* p, const float* cw, const float* cb, float* xc) {
    const int idx = blockIdx.x * blockDim.x + threadIdx.x; if (idx >= EXT * LW) return;
    const int c = idx & 511, e = idx >> 9; const int lo = e < CTX ? 0 : CTX, hi = e < CTX ? CTX : EXT;
    float y = cb[c];
#pragma unroll
    for (int k = 0; k < 4; ++k) { const int ee = e + k - 2; if (ee >= lo && ee < hi) y += p[(size_t)ee * INE + 512 + c] * cw[k * LW + c]; }
    xc[idx] = y;
}
struct FGate {
    const float *xc, *wa, *ba, *wx, *bx; float* ri;
    __device__ float a(int z, int m, int k) const { return xc[(size_t)m * LW + (z & 7) * 64 + k]; }
    __device__ float b(int z, int k, int n) const { const int d = z >> 4, t = (z >> 3) & 1, h = z & 7; const float* w = t ? wx : wa; return w[(((size_t)d * 8 + h) * 64 + k) * 64 + n]; }
    __device__ void store(int z, int m, int n, float v) const { const int d = z >> 4, t = (z >> 3) & 1, h = z & 7; const float* bb = t ? bx : ba;
        ri[(((size_t)d * 2 + t) * EXT + m) * LW + h * 64 + n] = sigmoidf_(v + bb[d * LW + h * 64 + n]); }
};
__global__ void k_coef(float* ri, const float* xc, const float* lam) {
    const int idx = blockIdx.x * blockDim.x + threadIdx.x; if (idx >= 2 * EXT * LW) return;
    const int c = idx & 511, e = (idx >> 9) % EXT, d = idx / (EXT * LW);
    float* ra = ri + (((size_t)d * 2 + 0) * EXT + e) * LW + c; float* rx = ri + (((size_t)d * 2 + 1) * EXT + e) * LW + c;
    const float r = *ra, ig = *rx, l = lam[d * LW + c];
    const float sp = (-l > 20.f) ? -l : log1pf(expf(-l));
    const float log_a = -8.f * sp * r; const float a = expf(log_a); const float mult = sqrtf(-expm1f(2.f * log_a));
    *ra = a; *rx = mult * ig * xc[(size_t)e * LW + c];
}
__global__ void k_scan(const float* ri, float* yl) {
    const int idx = blockIdx.x * blockDim.x + threadIdx.x; if (idx >= 2 * LW) return;
    const int c = idx & 511, d = idx >> 9;
    const float* A = ri + ((size_t)d * 2 + 0) * EXT * LW + c; const float* Bc = ri + ((size_t)d * 2 + 1) * EXT * LW + c; float* y = yl + (size_t)d * SEQ * LW + c;
    float h = 0.f;
    if (d == 0) { for (int e = 0; e < EXT; ++e) { h = A[(size_t)e * LW] * h + Bc[(size_t)e * LW]; if (e >= CTX) y[(size_t)(e - CTX) * LW] = h; } }
    else { for (int e = CTX - 1; e >= 0; --e) h = A[(size_t)e * LW] * h + Bc[(size_t)e * LW];
           for (int e = EXT - 1; e >= CTX; --e) { h = A[(size_t)e * LW] * h + Bc[(size_t)e * LW]; y[(size_t)(e - CTX) * LW] = h; } }
}
__global__ void k_catlru(const float* yl, const float* p, float* cat) {
    const int idx = blockIdx.x * blockDim.x + threadIdx.x; if (idx >= SEQ * LW) return;
    const int c = idx & 511, n = idx >> 9;
    cat[(size_t)n * D + c] = (yl[idx] + yl[(size_t)SEQ * LW + idx]) * gelu_tanh(p[(size_t)(CTX + n) * INE + c]);
}
struct FPlain {
    const float *A, *W; float* C; int K, N;
    __device__ float a(int z, int m, int k) const { return A[(size_t)m * K + k]; }
    __device__ float b(int z, int k, int n) const { return W[(size_t)k * N + n]; }
    __device__ void store(int z, int m, int n, float v) const { C[(size_t)m * N + n] = v; }
};
__global__ __launch_bounds__(256) void k_route(const float* t, const float* wg, const float* bg, const float* wf, const float* bf, int* eidx, float* ew) {
    const int tok = blockIdx.x * 4 + (threadIdx.x >> 6), lane = threadIdx.x & 63; if (tok >= NTOK) return;
    const float* x = t + (size_t)tok * D;
    float xv[16];
#pragma unroll
    for (int j = 0; j < 16; ++j) xv[j] = x[lane + 64 * j];
    float mine = 0.f;
    for (int o = 0; o < 36; ++o) {
        float p = 0.f;
        if (o < 4) {
#pragma unroll
            for (int j = 0; j < 16; ++j) p += xv[j] * wg[(lane + 64 * j) * 4 + o];
        } else {
#pragma unroll
            for (int j = 0; j < 16; ++j) p += xv[j] * wf[(lane + 64 * j) * 32 + (o - 4)];
        }
        p = wsum(p) + (o < 4 ? bg[o] : bf[o - 4]);
        if (lane == o) mine = p;
    }
    const float g0 = __shfl(mine, 0), g1 = __shfl(mine, 1), g2 = __shfl(mine, 2), g3 = __shfl(mine, 3);
    int gi = 0; float gm = g0;
    if (g1 > gm) { gm = g1; gi = 1; }
    if (g2 > gm) { gm = g2; gi = 2; }
    if (g3 > gm) { gm = g3; gi = 3; }
    const float pg = 1.f / (expf(g0 - gm) + expf(g1 - gm) + expf(g2 - gm) + expf(g3 - gm));
    int i0 = 0; float v0 = -INFINITY; int i1 = 0; float v1 = -INFINITY;
#pragma unroll
    for (int j = 0; j < 8; ++j) { const float v = __shfl(mine, 4 + gi * 8 + j);
        if (v > v0) { v1 = v0; i1 = i0; v0 = v; i0 = j; } else if (v > v1) { v1 = v; i1 = j; } }
    const float e1 = expf(v1 - v0); const float w0 = 1.f / (1.f + e1), w1 = e1 / (1.f + e1);
    if (lane == 0) { eidx[tok * 2] = gi * 8 + i0; eidx[tok * 2 + 1] = gi * 8 + i1; ew[tok * 2] = w0 * pg; ew[tok * 2 + 1] = w1 * pg; }
}
__global__ __launch_bounds__(256) void k_moe_tok(const float* t, const int* eidx, const float* ew, const float* w1, const float* w3, const float* w2, float* out) {
    __shared__ float xs[D]; __shared__ float hs[FF];
    const int tok = blockIdx.x, tid = threadIdx.x;
    for (int k = tid; k < D; k += 256) xs[k] = t[(size_t)tok * D + k];
    float o[4] = {0.f, 0.f, 0.f, 0.f};
    for (int kk = 0; kk < 2; ++kk) {
        const int e = eidx[tok * 2 + kk]; const float gw = ew[tok * 2 + kk];
        const float* W1 = w1 + (size_t)e * D * FF; const float* W3 = w3 + (size_t)e * D * FF; const float* W2 = w2 + (size_t)e * FF * D;
        __syncthreads();
        float a0 = 0.f, a1 = 0.f, b0 = 0.f, b1 = 0.f;
        for (int k = 0; k < D; ++k) { const float xv = xs[k]; a0 += xv * W1[(size_t)k * FF + tid]; a1 += xv * W1[(size_t)k * FF + 256 + tid]; b0 += xv * W3[(size_t)k * FF + tid]; b1 += xv * W3[(size_t)k * FF + 256 + tid]; }
        hs[tid] = siluf_(a0) * b0; hs[256 + tid] = siluf_(a1) * b1;
        __syncthreads();
        float c0 = 0.f, c1 = 0.f, c2 = 0.f, c3 = 0.f;
        for (int j = 0; j < FF; ++j) { const float hv = hs[j]; c0 += hv * W2[(size_t)j * D + tid]; c1 += hv * W2[(size_t)j * D + 256 + tid]; c2 += hv * W2[(size_t)j * D + 512 + tid]; c3 += hv * W2[(size_t)j * D + 768 + tid]; }
        o[0] += gw * c0; o[1] += gw * c1; o[2] += gw * c2; o[3] += gw * c3;
    }
#pragma unroll
    for (int i = 0; i < 4; ++i) out[(size_t)tok * D + i * 256 + tid] = o[i];
}
__global__ void k_costab(float* tab) { const int i = blockIdx.x * blockDim.x + threadIdx.x; if (i < 4096) tab[i] = (float)cos(2.0 * 3.14159265358979323846 * (double)i / 4096.0); }
struct FChanDft {
    const float *h, *tab; float *gr, *gs;
    __device__ float a(int z, int m, int k) const { return h[(size_t)m * D + z * 256 + k]; }
    __device__ float b(int z, int k, int n) const { const int nn = n & 255; const int j = (k * nn) & 255; return n < 256 ? tab[j * 16] : tab[((j * 16) + 3072) & 4095]; }
    __device__ void store(int z, int m, int n, float v) const { if (n < 256) gr[(size_t)m * D + z * 256 + n] = v; else gs[(size_t)m * D + z * 256 + n - 256] = v; }
};
struct FSeqDft {
    const float *gr, *gs, *tab; float* y;
    __device__ float a(int z, int m, int k) const { const int kk = k & 4095; const int j = (m * kk) & 4095; return k < 4096 ? tab[j] : -tab[(j + 3072) & 4095]; }
    __device__ float b(int z, int k, int n) const { return k < 4096 ? gr[(size_t)k * D + n] : gs[(size_t)(k - 4096) * D + n]; }
    __device__ void store(int z, int m, int n, float v) const { y[(size_t)m * D + n] = v * (1.f / 1024.f); }
};
}

extern "C" void kernel_launch(void* const* d_in, const int* in_sizes, int n_in, void* d_out, int out_size, void* d_ws, size_t ws_size, hipStream_t stream) {
    const float* x = (const float*)d_in[0]; const float* c = (const float*)d_in[1]; const float* ctx = (const float*)d_in[2]; const float* cctx = (const float*)d_in[3];
    const float* ada_w = (const float*)d_in[4]; const float* ada_b = (const float*)d_in[5]; const float* ln_g = (const float*)d_in[6]; const float* ln_b = (const float*)d_in[7];
    const float* w_in = (const float*)d_in[8]; const float* conv_w = (const float*)d_in[9]; const float* conv_b = (const float*)d_in[10];
    const float* ga_w = (const float*)d_in[11]; const float* ga_b = (const float*)d_in[12]; const float* gx_w = (const float*)d_in[13]; const float* gx_b = (const float*)d_in[14];
    const float* lru_lam = (const float*)d_in[15]; const float* da_lam = (const float*)d_in[16]; const float* subln = (const float*)d_in[17]; const float* w_out = (const float*)d_in[18];
    const float* od_w = (const float*)d_in[19]; const float* od_b = (const float*)d_in[20];
    const float* moe_wg = (const float*)d_in[21]; const float* moe_bg = (const float*)d_in[22]; const float* moe_wf = (const float*)d_in[23]; const float* moe_bf = (const float*)d_in[24];
    const float* moe_w1 = (const float*)d_in[25]; const float* moe_w3 = (const float*)d_in[26]; const float* moe_w2 = (const float*)d_in[27];
    float* X = (float*)d_out;

    float* ws = (float*)d_ws; size_t off = 0;
    auto take = [&](size_t n) { float* p = ws + off; off += (n + 63) & ~(size_t)63; return p; };
    float* MODS = take(2 * 9 * 6144);
    float* LAMP = take(64);
    float* TAB = take(4096);
    float* T = take((size_t)NTOK * D);
    float* MO = take((size_t)NTOK * D);
    int* EIDX = (int*)take((size_t)NTOK * 2);
    float* EW = take((size_t)NTOK * 2);
    float* Hb = take((size_t)EXT * D);
    float* P = take((size_t)EXT * INE);
    float* XC = take((size_t)EXT * LW);
    float* RI = take((size_t)4 * EXT * LW);
    float* YL = take((size_t)2 * SEQ * LW);
    float* CAT = take((size_t)SEQ * D);
    float* Y = take((size_t)SEQ * D);
    float* OH = take((size_t)SEQ * DV);
    float* S = take((size_t)2 * SEQ * EXT);
    if (off * 4 > ws_size) { fprintf(stderr, "kernel_launch: workspace too small: need %zu have %zu\n", off * 4, ws_size); return; }
    float* GR = S; float* GS = S + (size_t)SEQ * D;

    hipMemcpyAsync(X, x, (size_t)NTOK * D * 4, hipMemcpyDeviceToDevice, stream);
    { FAda f{c, cctx, ada_w, ada_b, MODS}; gemm(stream, 9, 6144, D, 2, f); }
    hipLaunchKernelGGL(k_lam, dim3(1), dim3(64), 0, stream, da_lam, LAMP);
    hipLaunchKernelGGL(k_costab, dim3(16), dim3(256), 0, stream, TAB);
    const float* M0 = MODS; const float* M1 = MODS + 9 * 6144;

    for (int b = 0; b < NB; ++b) {
        hipLaunchKernelGGL(k_lnmod, dim3(CTX / 4), dim3(256), 0, stream, ctx + (size_t)b * CTX * D, Hb, CTX, CTX, M0, 8, 0, 1);
        hipLaunchKernelGGL(k_lnmod, dim3(SEQ / 4), dim3(256), 0, stream, X + (size_t)b * SEQ * D, Hb + (size_t)CTX * D, SEQ, SEQ, M0, b, 0, 1);
        { FInProj f{Hb, w_in, P}; gemm(stream, EXT, INE, D, 1, f); }
        hipLaunchKernelGGL(k_rope, dim3(SEQ * 512 / 256), dim3(256), 0, stream, P);
        hipLaunchKernelGGL(k_conv, dim3(EXT * LW / 256), dim3(256), 0, stream, P, conv_w, conv_b, XC);
        { FGate f{XC, ga_w, ga_b, gx_w, gx_b, RI}; gemm(stream, EXT, 64, 64, 32, f); }
        hipLaunchKernelGGL(k_coef, dim3(2 * EXT * LW / 256), dim3(256), 0, stream, RI, XC, lru_lam);
        hipLaunchKernelGGL(k_scan, dim3(4), dim3(256), 0, stream, RI, YL);
        hipLaunchKernelGGL(k_catlru, dim3(SEQ * LW / 256), dim3(256), 0, stream, YL, P, CAT);
        for (int h = 0; h < NH; ++h) {
            { FScore f{P, S, h}; gemm(stream, SEQ, EXT, DH, 2, f); }
            hipLaunchKernelGGL(k_softdiff, dim3(SEQ / 4), dim3(256), 0, stream, S, LAMP);
            { FPV f{S, P, OH, h}; gemm(stream, SEQ, DV, EXT, 1, f); }
            hipLaunchKernelGGL(k_subln, dim3(SEQ / 4), dim3(256), 0, stream, OH, subln, CAT, h);
        }
        { FPlain f{CAT, w_out, Y, D, D}; gemm(stream, SEQ, D, D, 1, f); }
        hipLaunchKernelGGL(k_resln, dim3(SEQ / 4), dim3(256), 0, stream, X + (size_t)b * SEQ * D, Y, (const float*)nullptr, SEQ, SEQ, b, M0, 2, ln_g, ln_b);
    }
    hipLaunchKernelGGL(k_lnmod, dim3(NTOK / 4), dim3(256), 0, stream, X, T, NTOK, SEQ, M0, -1, 3, 4);
    hipLaunchKernelGGL(k_route, dim3(NTOK / 4), dim3(256), 0, stream, T, moe_wg, moe_bg, moe_wf, moe_bf, EIDX, EW);
    hipLaunchKernelGGL(k_moe_tok, dim3(NTOK), dim3(256), 0, stream, T, EIDX, EW, moe_w1, moe_w3, moe_w2, MO);
    hipLaunchKernelGGL(k_resln, dim3(NTOK / 4), dim3(256), 0, stream, X, MO, (const float*)nullptr, NTOK, SEQ, 0, M0, 5, ln_g + D, ln_b + D);
    hipLaunchKernelGGL(k_lnmod, dim3(NTOK / 4), dim3(256), 0, stream, X, T, NTOK, SEQ, M1, -1, 0, 1);
    for (int b = 0; b < NB; ++b) {
        { FChanDft f{T + (size_t)b * SEQ * D, TAB, GR, GS}; gemm(stream, SEQ, 512, 256, 4, f); }
        { FSeqDft f{GR, GS, TAB, CAT}; gemm(stream, SEQ, D, 2 * SEQ, 1, f); }
        { FPlain f{CAT, od_w, Y, D, D}; gemm(stream, SEQ, D, D, 1, f); }
        hipLaunchKernelGGL(k_resln, dim3(SEQ / 4), dim3(256), 0, stream, X + (size_t)b * SEQ * D, Y, od_b, SEQ, SEQ, b, M1, 2, ln_g + 2 * D, ln_b + 2 * D);
    }
    hipLaunchKernelGGL(k_lnmod, dim3(NTOK / 4), dim3(256), 0, stream, X, T, NTOK, SEQ, M1, -1, 3, 4);
    hipLaunchKernelGGL(k_route, dim3(NTOK / 4), dim3(256), 0, stream, T, moe_wg + D * 4, moe_bg + 4, moe_wf + D * 32, moe_bf + 32, EIDX, EW);
    hipLaunchKernelGGL(k_moe_tok, dim3(NTOK), dim3(256), 0, stream, T, EIDX, EW, moe_w1 + (size_t)NE * D * FF, moe_w3 + (size_t)NE * D * FF, moe_w2 + (size_t)NE * FF * D, MO);
    hipLaunchKernelGGL(k_resln, dim3(NTOK / 4), dim3(256), 0, stream, X, MO, (const float*)nullptr, NTOK, SEQ, 0, M1, 5, ln_g + 3 * D, ln_b + 3 * D);
}
```

```cpp
#include <hip/hip_runtime.h>
#include <stdio.h>
#include <stdint.h>
#include <math.h>

#ifndef FAST_GEMM
#define FAST_GEMM 1
#endif

constexpr int D = 1024, NB = 8, SEQ = 4096, CTX = 256, NLAT = NB * SEQ, NCTX = NB * CTX, MALL = NLAT + NCTX;
constexpr int INE = 2560, LW = 512, NH = 4, NE = 32, FF = 512;
constexpr int MOE_ROWS = 2 * NLAT + NE * 256, MOE_TILES = MOE_ROWS / 256;
constexpr float LN_EPS = 1e-6f, ALPHA = 1.41421356237309515f;
constexpr float QSCALE = 0.125f * 1.4426950408889634f;
constexpr int NWAVES = 8, NTHREADS = 512;

constexpr size_t MiB = 1u << 20;
constexpr size_t WS_CTL = 0, CTL_ZERO_BYTES = 1 * MiB;
constexpr size_t WS_MODS = 1 * MiB;
constexpr size_t WS_ROPE = WS_MODS + 512 * 1024;
constexpr size_t WS_SMALL = WS_ROPE + 16 * 1024;
constexpr size_t WS_GATEW = WS_MODS + 768 * 1024;
constexpr size_t WS_CDFT = 2 * MiB;
constexpr size_t WS_WIN = 3 * MiB, WS_WOUT = 8 * MiB, WS_ODW = 10 * MiB;
constexpr size_t WS_CMAT = 12 * MiB;
constexpr size_t WS_MOEW = 76 * MiB, MOEW_LAYER = 96 * MiB, MOEW_W2 = 64 * MiB;
constexpr size_t WS_R0 = 268 * MiB;
constexpr size_t WS_R1 = 336 * MiB;
constexpr size_t R1_GX = 0, R1_QB = 68 * MiB, R1_KB = 100 * MiB, R1_VB = 134 * MiB;
constexpr size_t WS_R2 = 504 * MiB;
constexpr size_t WS_MISC = 576 * MiB;
constexpr size_t MISC_EIDX = 0, MISC_EW = 256 * 1024, MISC_ROWTOK = 512 * 1024;
constexpr size_t WS_END = 578 * MiB;
constexpr int CW_BAR = 4096;
constexpr int CW_CNT = 16384;
constexpr int RING_BYTES = 131072, LDSCTL_OFF = RING_BYTES, LDS_BYTES = 147456;
constexpr int LC_BAR = 0;
constexpr int LC_TSTART = 64;
constexpr int LC_XS = 1024;

#define GAS __attribute__((address_space(1)))
#define LAS __attribute__((address_space(3)))
typedef unsigned short bf16_t;
typedef short bf16x8 __attribute__((ext_vector_type(8)));
typedef float f32x4 __attribute__((ext_vector_type(4)));
typedef float f32x2 __attribute__((ext_vector_type(2)));
typedef unsigned u32x4 __attribute__((ext_vector_type(4)));
typedef unsigned u32x2 __attribute__((ext_vector_type(2)));

__device__ __forceinline__ unsigned f2bf(float f) { unsigned u = __float_as_uint(f); return (u + 0x7fffu + ((u >> 16) & 1u)) >> 16; }
__device__ __forceinline__ float bf2f(unsigned b) { return __uint_as_float(b << 16); }
__device__ __forceinline__ unsigned pk2(float lo, float hi) { return f2bf(lo) | (f2bf(hi) << 16); }
__device__ __forceinline__ float bflo(unsigned w) { return __uint_as_float(w << 16); }
__device__ __forceinline__ float bfhi(unsigned w) { return __uint_as_float(w & 0xffff0000u); }
__device__ __forceinline__ float wave_sum(float v) {
#pragma unroll
    for (int o = 1; o < 64; o <<= 1) v += __shfl_xor(v, o);
    return v;
}
__device__ __forceinline__ float wave_max(float v) {
#pragma unroll
    for (int o = 1; o < 64; o <<= 1) v = fmaxf(v, __shfl_xor(v, o));
    return v;
}
__device__ __forceinline__ float sigmoid_f(float x) { return 1.f / (1.f + __expf(-x)); }
__device__ __forceinline__ float silu_f(float x) { return x / (1.f + __expf(-x)); }
__device__ __forceinline__ float gelu_tanh_f(float x) { const float u = 0.7978845608028654f * (x + 0.044715f * x * x * x); return x / (1.f + __expf(-2.f * u)); }

#define XB_TMO      128
#define XB_XCNT(j)  (256  + 64 * (j))
#define XB_XSUB(j)  (1280 + 64 * (j))
#define XB_XGEN(j)  (2304 + 64 * (j))
#define XB_TOP      3328
#define XB_TOPGEN   3392
#define XCD_BAR_WORDS 3456
#define XB_SPIN_CAP (1u << 18)
__device__ __forceinline__ unsigned xb_ld(unsigned* p)              { return __hip_atomic_load(p, __ATOMIC_RELAXED, __HIP_MEMORY_SCOPE_AGENT); }
__device__ __forceinline__ unsigned xb_add(unsigned* p, unsigned v) { return __hip_atomic_fetch_add(p, v, __ATOMIC_RELAXED, __HIP_MEMORY_SCOPE_AGENT); }
__device__ __forceinline__ unsigned xb_xcc_id() { return (unsigned)__builtin_amdgcn_s_getreg((3 << 11) | 20) & 0xFu; }
#define XB_SPIN(cond, bar) do { unsigned _sp = 0; while (cond) { __builtin_amdgcn_s_sleep(1); \
    if ((++_sp & 255u) == 0u) { if (xb_ld(&(bar)[XB_TMO])) break; if (_sp > XB_SPIN_CAP) { atomicAdd(&(bar)[XB_TMO], 1u); break; } } } } while (0)
struct XcdBarrier { unsigned* bar; unsigned x; volatile LAS unsigned* st; };
__device__ __forceinline__ XcdBarrier xcd_barrier_post(unsigned* bar, volatile LAS unsigned* st) {
    XcdBarrier b; b.bar = bar; b.x = xb_xcc_id(); b.st = st;
    if (threadIdx.x == 0) (void)xb_add(&bar[XB_XCNT(b.x)], 1u);
    return b;
}
__device__ __forceinline__ void xcd_barrier_complete(unsigned* bar, unsigned x, unsigned& nloc, unsigned& nx) {
    const unsigned G = gridDim.x * gridDim.y * gridDim.z;
    unsigned sum, cnt, mine, sp = 0u;
    for (;;) {
        sum = 0u; cnt = 0u; mine = 0u;
#pragma unroll
        for (unsigned j = 0; j < 16; ++j) { const unsigned c = xb_ld(&bar[XB_XCNT(j)]); sum += c; cnt += (c > 0u) ? 1u : 0u; mine = (j == x) ? c : mine; }
        if (sum == G) break;
        __builtin_amdgcn_s_sleep(1);
        if ((++sp & 255u) == 0u) { if (xb_ld(&bar[XB_TMO])) break; if (sp > XB_SPIN_CAP) { atomicAdd(&bar[XB_TMO], 1u); break; } }
    }
    nloc = mine > 0u ? mine : 1u; nx = cnt > 0u ? cnt : 1u;
}
__device__ __forceinline__ void xcd_barrier(const XcdBarrier& b) {
    asm volatile("s_waitcnt vmcnt(0)" ::: "memory");
    __syncthreads();
    if (threadIdx.x == 0) {
        unsigned* bar = b.bar;
        __builtin_amdgcn_s_waitcnt(0);
        unsigned nloc = b.st[0], nx = b.st[1];
        if (nloc == 0u) { xcd_barrier_complete(bar, b.x, nloc, nx); b.st[0] = nloc; b.st[1] = nx; }
        const unsigned old = xb_add(&bar[XB_XSUB(b.x)], 1u);
        const unsigned gen = old / nloc;
        if (old + 1u == (gen + 1u) * nloc) {
            __builtin_amdgcn_fence(__ATOMIC_RELEASE, "agent");
            asm volatile("s_waitcnt vmcnt(0)" ::: "memory");
            const unsigned og = xb_add(&bar[XB_TOP], 1u);
            const unsigned tg = og / nx;
            if (og + 1u == (tg + 1u) * nx) xb_add(&bar[XB_TOPGEN], 1u);
            else XB_SPIN(xb_ld(&bar[XB_TOPGEN]) == tg, bar);
            __builtin_amdgcn_fence(__ATOMIC_ACQUIRE, "agent");
            xb_add(&bar[XB_XGEN(b.x)], 1u);
            asm volatile("s_waitcnt vmcnt(0)" ::: "memory");
        } else {
            XB_SPIN(xb_ld(&bar[XB_XGEN(b.x)]) == gen, bar);
            __builtin_amdgcn_fence(__ATOMIC_ACQUIRE, "agent");
            asm volatile("s_waitcnt vmcnt(0)" ::: "memory");
        }
    }
    __syncthreads();
}

namespace pg8 {
constexpr int BM = 256, BK = 64, HALF = 128, HTB = HALF * BK * 2, STAGE_BYTES = 8 * HTB, NXCD = 8, WGM = 8;
__host__ __device__ __forceinline__ int lds_byte(int r, int c) { const int st = (r >> 4) * 2 + (c >> 5), rr = r & 15, cc = c & 31, ob = rr * 64 + cc * 2; return st * 1024 + (ob ^ (((ob >> 9) & 1) << 5)); }
__host__ __device__ __forceinline__ void stage_rc(int b, int& R, int& C) { const int st = b / 1024, sb = b % 1024, swz = sb ^ (((sb >> 9) & 1) << 5); R = (st >> 1) * 16 + swz / 64; C = (st & 1) * 32 + (swz % 64) / 2; }
__host__ __device__ __forceinline__ int perm32(int rho) { const int n = rho >> 4, i = rho & 15; return 8 * (i >> 2) + 4 * n + (i & 3); }
struct Unit { int pm, pn; const char* A; const char* B; };
struct Shape { int K, pitchA, pitchB; };
__device__ __forceinline__ unsigned cvt_pk_bf16(float lo, float hi) { unsigned r; asm volatile("v_cvt_pk_bf16_f32 %0, %1, %2" : "=v"(r) : "v"(lo), "v"(hi)); return r; }

template <class Epi, class Sched, bool ALIGN_EPI = true>
__device__ __forceinline__ void gemm_phase(LAS unsigned char* lds, const Shape g, const Sched& S, const Epi& E) {
    int tid_ = threadIdx.x; asm volatile("" : "+v"(tid_));
    const int tid = tid_, wid = __builtin_amdgcn_readfirstlane(tid >> 6), lane = tid & 63, wr = wid >> 2, wc = wid & 3, fr = lane & 15, fq = lane >> 4;
    const int K = g.K, nt = K / BK;
    unsigned voffA[2], voffB[2];
#pragma unroll
    for (int i = 0; i < 2; ++i) { int R, C; stage_rc(tid * 16 + i * 8192, R, C); const int Rb = Epi::PERM ? ((R & ~31) + perm32(R & 31)) : R;
        voffA[i] = (unsigned)(R * g.pitchA + C) * 2u; voffB[i] = (unsigned)(Rb * g.pitchB + C) * 2u; }
    const size_t kstep = (size_t)(BK * 2);
    const size_t hstepA = (size_t)HALF * g.pitchA * 2, hstepB = (size_t)HALF * g.pitchB * 2;
    const unsigned ldsw = (unsigned)wid * 1024u;
    const int aoff = lds_byte(wr * 64 + fr, fq * 8), boff = lds_byte(wc * 32 + fr, fq * 8);
#define PG8_SA(b, h) (((b) * 2 + (h)) * HTB)
#define PG8_SB(b, h) ((4 + (b) * 2 + (h)) * HTB)
#define PG8_STAGE(bufoff, gbase, voff) do { _Pragma("unroll") for (int _i = 0; _i < 2; ++_i) \
        __builtin_amdgcn_global_load_lds((const unsigned*)((const char*)(gbase) + (voff)[_i]), (LAS unsigned*)(lds + (bufoff) + ldsw + _i * 8192), 16, 0, 0); } while (0)
#define PG8_LDA(dst, b, h) do { _Pragma("unroll") for (int m = 0; m < 4; ++m) _Pragma("unroll") for (int k = 0; k < 2; ++k) dst[m][k] = *(const LAS bf16x8*)(lds + PG8_SA(b, h) + aoff + m * 2048 + k * 1024); } while (0)
#define PG8_LDB(dst, b, h) do { _Pragma("unroll") for (int n = 0; n < 2; ++n) _Pragma("unroll") for (int k = 0; k < 2; ++k) dst[n][k] = *(const LAS bf16x8*)(lds + PG8_SB(b, h) + boff + n * 2048 + k * 1024); } while (0)
#define PG8_MMA(ai, bj, At, Bt) do { __builtin_amdgcn_s_setprio(1); _Pragma("unroll") for (int m = 0; m < 4; ++m) _Pragma("unroll") for (int n = 0; n < 2; ++n) _Pragma("unroll") for (int k = 0; k < 2; ++k) \
        acc[ai][bj][m][n] = __builtin_amdgcn_mfma_f32_16x16x32_bf16(Bt[n][k], At[m][k], acc[ai][bj][m][n], 0, 0, 0); __builtin_amdgcn_s_setprio(0); } while (0)
#define PG8_WAIT_V(n) asm volatile("s_waitcnt vmcnt(" #n ")" ::: "memory")
#define PG8_WAIT_L(n) asm volatile("s_waitcnt lgkmcnt(" #n ")" ::: "memory")
#define PG8_BAR __builtin_amdgcn_s_barrier()
#define PG8_SCHED __builtin_amdgcn_sched_barrier(0)
    Unit cur, nxt; int ui = 0;
    if (!S.next(0, cur)) return;
    f32x4 acc[2][2][4][2];
#pragma unroll
    for (int a = 0; a < 2; ++a)
#pragma unroll
        for (int b = 0; b < 2; ++b)
#pragma unroll
            for (int m = 0; m < 4; ++m)
#pragma unroll
                for (int n = 0; n < 2; ++n) acc[a][b][m][n] = (f32x4){0.f, 0.f, 0.f, 0.f};
    bf16x8 At[4][2], B0[2][2], B1[2][2];
    const char* cA = cur.A; const char* cB = cur.B;
    PG8_STAGE(PG8_SB(0, 0), cB, voffB); PG8_STAGE(PG8_SB(0, 1), cB + hstepB, voffB); PG8_STAGE(PG8_SA(0, 0), cA, voffA); PG8_STAGE(PG8_SA(0, 1), cA + hstepA, voffA);
    if (wr == 1) PG8_BAR;
    PG8_WAIT_V(2); PG8_BAR;
    PG8_STAGE(PG8_SB(1, 0), cB + kstep, voffB); PG8_STAGE(PG8_SA(1, 0), cA + kstep, voffA); PG8_STAGE(PG8_SB(1, 1), cB + hstepB + kstep, voffB);
    PG8_WAIT_V(6); PG8_BAR;
    for (;;) {
        const bool has_next = S.next(ui + 1, nxt);
        const char* nA = has_next ? nxt.A : cA; const char* nB = has_next ? nxt.B : cB;
        for (int t = 0; t < nt; t += 2) {
            const bool last = (t == nt - 2);
            const char* a1 = cA + (size_t)(t + 1) * kstep;
            const char* a2 = last ? nA : cA + (size_t)(t + 2) * kstep; const char* b2 = last ? nB : cB + (size_t)(t + 2) * kstep;
            const char* a3 = a2 + kstep; const char* b3 = b2 + kstep;
            PG8_LDB(B0, 0, 0); PG8_LDB(B1, 0, 1); PG8_SCHED; PG8_LDA(At, 0, 0); PG8_STAGE(PG8_SA(1, 1), a1 + hstepA, voffA);
            PG8_WAIT_V(8); PG8_WAIT_L(0); PG8_BAR; PG8_MMA(0, 0, At, B0); PG8_MMA(0, 1, At, B1); PG8_BAR; PG8_SCHED;
            PG8_LDA(At, 0, 1); PG8_STAGE(PG8_SB(0, 0), b2, voffB); PG8_STAGE(PG8_SB(0, 1), b2 + hstepB, voffB); PG8_STAGE(PG8_SA(0, 0), a2, voffA);
            PG8_WAIT_V(8); PG8_WAIT_L(0); PG8_BAR; PG8_MMA(1, 0, At, B0); PG8_MMA(1, 1, At, B1); PG8_BAR; PG8_SCHED;
            PG8_LDB(B0, 1, 0); PG8_LDB(B1, 1, 1); PG8_SCHED; PG8_LDA(At, 1, 0); PG8_STAGE(PG8_SA(0, 1), a2 + hstepA, voffA);
            PG8_WAIT_V(8); PG8_WAIT_L(0); PG8_BAR; PG8_MMA(0, 0, At, B0); PG8_MMA(0, 1, At, B1); PG8_BAR; PG8_SCHED;
            PG8_LDA(At, 1, 1); PG8_STAGE(PG8_SB(1, 0), b3, voffB); PG8_STAGE(PG8_SB(1, 1), b3 + hstepB, voffB); PG8_STAGE(PG8_SA(1, 0), a3, voffA);
            PG8_WAIT_V(8); PG8_WAIT_L(0); PG8_BAR; PG8_MMA(1, 0, At, B0); PG8_MMA(1, 1, At, B1); PG8_BAR; PG8_SCHED;
        }
        if constexpr (ALIGN_EPI) { if (wr == 0) PG8_BAR; }
        E(acc, cur, wr, wc, fr, fq);
        if (!has_next) break;
#pragma unroll
        for (int a = 0; a < 2; ++a)
#pragma unroll
            for (int b = 0; b < 2; ++b)
#pragma unroll
                for (int m = 0; m < 4; ++m)
#pragma unroll
                    for (int n = 0; n < 2; ++n) acc[a][b][m][n] = (f32x4){0.f, 0.f, 0.f, 0.f};
        cur = nxt; cA = nA; cB = nB; ++ui;
        if constexpr (ALIGN_EPI) { if (wr == 1) PG8_BAR; }
    }
    PG8_WAIT_V(0);
    if constexpr (!ALIGN_EPI) { if (wr == 0) PG8_BAR; }
    PG8_BAR;
#undef PG8_SA
#undef PG8_SB
#undef PG8_STAGE
#undef PG8_LDA
#undef PG8_LDB
#undef PG8_MMA
#undef PG8_WAIT_V
#undef PG8_WAIT_L
#undef PG8_BAR
#undef PG8_SCHED
}

template <class Epi, class Sched>
__device__ __forceinline__ void gemm_phase_ref(const Shape g, const Sched& S, const Epi& E) {
    const int tid = threadIdx.x, wid = __builtin_amdgcn_readfirstlane(tid >> 6), lane = tid & 63, wr = wid >> 2, wc = wid & 3, fr = lane & 15, fq = lane >> 4;
    Unit u;
    for (int it = 0; S.next(it, u); ++it) {
        f32x4 acc[2][2][4][2];
#pragma unroll
        for (int a = 0; a < 2; ++a)
#pragma unroll
            for (int b = 0; b < 2; ++b)
#pragma unroll
                for (int m = 0; m < 4; ++m)
#pragma unroll
                    for (int n = 0; n < 2; ++n) acc[a][b][m][n] = (f32x4){0.f, 0.f, 0.f, 0.f};
#pragma unroll
        for (int ai = 0; ai < 2; ++ai) {
            for (int k8 = 0; k8 < g.K / 8; ++k8) {
                float a[4][8];
#pragma unroll
                for (int m = 0; m < 4; ++m) { const u32x4 w = *(const u32x4*)(u.A + ((size_t)(ai * 128 + wr * 64 + m * 16 + fr) * g.pitchA + k8 * 8) * 2);
                    a[m][0] = bflo(w.x); a[m][1] = bfhi(w.x); a[m][2] = bflo(w.y); a[m][3] = bfhi(w.y); a[m][4] = bflo(w.z); a[m][5] = bfhi(w.z); a[m][6] = bflo(w.w); a[m][7] = bfhi(w.w); }
#pragma unroll
                for (int bj = 0; bj < 2; ++bj)
#pragma unroll
                    for (int n = 0; n < 2; ++n)
#pragma unroll
                        for (int ii = 0; ii < 4; ++ii) {
                            const int col = bj * 128 + wc * 32 + (Epi::PERM ? 8 * fq + 4 * n + ii : 16 * n + 4 * fq + ii);
                            const u32x4 w = *(const u32x4*)(u.B + ((size_t)col * g.pitchB + k8 * 8) * 2);
                            const float b0 = bflo(w.x), b1 = bfhi(w.x), b2 = bflo(w.y), b3 = bfhi(w.y), b4 = bflo(w.z), b5 = bfhi(w.z), b6 = bflo(w.w), b7 = bfhi(w.w);
#pragma unroll
                            for (int m = 0; m < 4; ++m)
                                acc[ai][bj][m][n][ii] += a[m][0] * b0 + a[m][1] * b1 + a[m][2] * b2 + a[m][3] * b3 + a[m][4] * b4 + a[m][5] * b5 + a[m][6] * b6 + a[m][7] * b7;
                        }
            }
        }
        E(acc, u, wr, wc, fr, fq);
    }
}
}

struct Args { const float* in[28]; float* out; unsigned char* ws; int ph_lo, ph_hi; };
struct Frame {
    LAS unsigned char* lds; unsigned* ctl; unsigned char* ws;
    int tid, lane, wave, G, vcu;
    const float* in[28]; float* out;
};
#define LDS_WAIT() asm volatile("s_waitcnt lgkmcnt(0)" ::: "memory")

template <class RowMap>
__device__ __forceinline__ void p0_transpose_item(const float* W, int K, int N, bf16_t* WT, RowMap rowmap, LAS float* scr, int item, int lane) {
    const int nblk = N / 32, kb = item / nblk, nb = item % nblk, k0 = 64 * kb, n0 = 32 * nb;
#pragma unroll 8
    for (int i = 0; i < 32; ++i) { const int kk = 2 * i + (lane >> 5); scr[kk * 33 + (lane & 31)] = W[(size_t)(k0 + kk) * N + n0 + (lane & 31)]; }
    LDS_WAIT(); asm volatile("" ::: "memory");
    const int c = lane & 7;
#pragma unroll
    for (int j = 0; j < 4; ++j) { const int n = (lane >> 3) + 8 * j; const LAS float* s = scr + (8 * c) * 33 + n;
        u32x4 o; o.x = pk2(s[0 * 33], s[1 * 33]); o.y = pk2(s[2 * 33], s[3 * 33]); o.z = pk2(s[4 * 33], s[5 * 33]); o.w = pk2(s[6 * 33], s[7 * 33]);
        *(u32x4*)(WT + (size_t)rowmap(n0 + n) * K + k0 + 8 * c) = o; }
    LDS_WAIT(); asm volatile("" ::: "memory");
}
struct RmId { __device__ int operator()(int n) const { return n; } };
struct RmW1 { __device__ int operator()(int j) const { return (j >> 2) * 8 + (j & 3); } };
struct RmW3 { __device__ int operator()(int j) const { return (j >> 2) * 8 + 4 + (j & 3); } };

__device__ __forceinline__ void p0_prologue(Frame& F) {
    unsigned char* ws = F.ws;
    LAS float* scr = (LAS float*)(F.lds + F.wave * 16384);
    const int gw = F.vcu * NWAVES + F.wave, NGW = F.G * NWAVES;
    constexpr int I_WIN = 16 * 80, I_SQ = 16 * 32, I_W13 = 16 * 16, I_W2 = 8 * 32;
    constexpr int N0 = I_WIN, N1 = N0 + I_SQ, N2 = N1 + I_SQ, N3 = N2 + 2 * NE * I_W13  , N4 = N3 + 2 * NE * I_W13  , N5 = N4 + 2 * NE * I_W2;
    for (int it = gw; it < N5; it += NGW) {
        if (it < N0) { p0_transpose_item(F.in[8], D, INE, (bf16_t*)(ws + WS_WIN), RmId(), scr, it, F.lane); continue; }
        if (it < N1) { p0_transpose_item(F.in[18], D, D, (bf16_t*)(ws + WS_WOUT), RmId(), scr, it - N0, F.lane); continue; }
        if (it < N2) { p0_transpose_item(F.in[19], D, D, (bf16_t*)(ws + WS_ODW), RmId(), scr, it - N1, F.lane); continue; }
        if (it < N3) { const int r = it - N2, le = r / I_W13, l = le / NE, e = le % NE;
            p0_transpose_item(F.in[25] + (size_t)le * D * FF, D, FF, (bf16_t*)(ws + WS_MOEW + l * MOEW_LAYER) + (size_t)e * D * D, RmW1(), scr, r % I_W13, F.lane); continue; }
        if (it < N4) { const int r = it - N3, le = r / I_W13, l = le / NE, e = le % NE;
            p0_transpose_item(F.in[26] + (size_t)le * D * FF, D, FF, (bf16_t*)(ws + WS_MOEW + l * MOEW_LAYER) + (size_t)e * D * D, RmW3(), scr, r % I_W13, F.lane); continue; }
        { const int r = it - N4, le = r / I_W2, l = le / NE, e = le % NE;
            p0_transpose_item(F.in[27] + (size_t)le * FF * D, FF, D, (bf16_t*)(ws + WS_MOEW + l * MOEW_LAYER + MOEW_W2) + (size_t)e * D * FF, RmId(), scr, r % I_W2, F.lane); }
    }
    const int gt = F.vcu * NTHREADS + F.tid, NGT = F.G * NTHREADS;
    { bf16_t* gwt = (bf16_t*)(ws + WS_GATEW);
      for (int i = gt; i < 2 * 2 * 8 * 64 * 64; i += NGT) { const int k = i & 63, n = (i >> 6) & 63, h = (i >> 12) & 7, t = (i >> 15) & 1, d = i >> 16;
          const float* w = t ? F.in[13] : F.in[11]; gwt[i] = (bf16_t)f2bf(w[(((size_t)d * 8 + h) * 64 + k) * 64 + n]); } }
    { float* rope = (float*)(ws + WS_ROPE);
      for (int i = gt; i < 64 * 16; i += NGT) { const int f = i & 15, pos = i >> 4; const float freq = powf(10000.f, -(float)f / 16.f); const float ang = (float)pos * freq;
          rope[i * 2] = (float)cos((double)ang); rope[i * 2 + 1] = (float)sin((double)ang); }
      float* sm = (float*)(ws + WS_SMALL);
      for (int i = gt; i < 2 * LW; i += NGT) { const float l = F.in[15][i]; sm[64 + i] = (-l > 20.f) ? -l : log1pf(expf(-l)); }
      if (blockIdx.x == 0 && F.wave == 0) { const float* dl = F.in[16]; const float a = wave_sum(dl[F.lane] * dl[64 + F.lane]), b = wave_sum(dl[128 + F.lane] * dl[192 + F.lane]);
          if (F.lane == 0) sm[0] = expf(a) - expf(b) + 0.2f; } }
    __syncthreads();
    { LAS float* tab = (LAS float*)F.lds;
      for (int i = F.tid; i < 4096; i += NTHREADS) tab[i] = (float)cos(2.0 * 3.14159265358979323846 * (double)i / 4096.0);
      __syncthreads();
      bf16_t* cd = (bf16_t*)(ws + WS_CDFT);
      for (int i = gt; i < 512 * 256; i += NGT) { const int c = i & 255, m = i >> 8; const int j = ((m & 255) * c) & 255; cd[i] = (bf16_t)f2bf(m < 256 ? tab[j * 16] : tab[(j * 16 + 3072) & 4095]); }
      bf16_t* cm = (bf16_t*)(ws + WS_CMAT);
      for (int i8 = gt; i8 < 4096 * 8192 / 8; i8 += NGT) { const int m = i8 >> 10, k0 = (i8 & 1023) * 8; unsigned w[4];
#pragma unroll
          for (int q = 0; q < 4; ++q) { float v[2];
#pragma unroll
              for (int e = 0; e < 2; ++e) { const int k = k0 + 2 * q + e, kk = k & 4095, j = (m * kk) & 4095; v[e] = k < 4096 ? tab[j] : -tab[(j + 3072) & 4095]; }
              w[q] = pk2(v[0], v[1]); }
          *(u32x4*)(cm + (size_t)i8 * 8) = (u32x4){w[0], w[1], w[2], w[3]}; }
      __syncthreads(); }
    { LAS float* sc = (LAS float*)F.lds;
      LAS float* red = sc + 9 * 1024;
      for (int i = F.tid; i < 9 * 1024; i += NTHREADS) { const int r = i >> 10, k = i & 1023; const float v = r < 8 ? F.in[1][r * D + k] : F.in[3][k]; sc[i] = v / (1.f + expf(-v)); }
      __syncthreads();
      float* mods = (float*)(ws + WS_MODS);
      for (int u = F.vcu; u < 2 * 96; u += F.G) { const int l = u / 96, n0 = (u % 96) * 64, col = F.tid & 63, kc = F.tid >> 6;
          float a9[9];
#pragma unroll
          for (int r = 0; r < 9; ++r) a9[r] = 0.f;
          const float* w = F.in[4] + ((size_t)l * D + kc * 128) * 6144 + n0 + col;
          for (int k = 0; k < 128; ++k) { const float wv = w[(size_t)k * 6144];
#pragma unroll
              for (int r = 0; r < 9; ++r) a9[r] += sc[r * 1024 + kc * 128 + k] * wv; }
#pragma unroll
          for (int r = 0; r < 9; ++r) red[(kc * 9 + r) * 64 + col] = a9[r];
          __syncthreads();
          for (int i = F.tid; i < 9 * 64; i += NTHREADS) { const int r = i >> 6, c = i & 63; float s = 0.f;
#pragma unroll
              for (int q = 0; q < 8; ++q) s += red[(q * 9 + r) * 64 + c];
              mods[((size_t)l * 9 + r) * 6144 + n0 + c] = s + F.in[5][l * 6144 + n0 + c]; }
          __syncthreads(); } }
}

__device__ __forceinline__ void ln_stats(f32x4 (&v)[4], float& mean, float& rstd) {
    float s = 0.f;
#pragma unroll
    for (int j = 0; j < 4; ++j) s += (v[j].x + v[j].y) + (v[j].z + v[j].w);
    mean = wave_sum(s) * (1.f / D); float q = 0.f;
#pragma unroll
    for (int j = 0; j < 4; ++j) { const f32x4 d = v[j] - mean; q += (d.x * d.x + d.y * d.y) + (d.z * d.z + d.w * d.w); }
    rstd = 1.f / sqrtf(wave_sum(q) * (1.f / D) + LN_EPS);
}
__device__ __forceinline__ void p1_lnmod(Frame& F) {
    const int gw = F.vcu * NWAVES + F.wave, NGW = F.G * NWAVES; const float* mods = (const float*)(F.ws + WS_MODS); bf16_t* H = (bf16_t*)(F.ws + WS_R0);
    for (int row = gw; row < MALL; row += NGW) {
        const float* src = row < NLAT ? F.in[0] + (size_t)row * D : F.in[2] + (size_t)(row - NLAT) * D; const int r = row < NLAT ? (row >> 12) : 8;
        f32x4 v[4];
#pragma unroll
        for (int j = 0; j < 4; ++j) v[j] = ((const f32x4*)src)[F.lane + 64 * j];
        float mean, rstd; ln_stats(v, mean, rstd);
        const f32x4* sh = (const f32x4*)(mods + (size_t)r * 6144); const f32x4* sc = (const f32x4*)(mods + (size_t)r * 6144 + 1024);
#pragma unroll
        for (int j = 0; j < 4; ++j) { const f32x4 a = sh[F.lane + 64 * j], b = sc[F.lane + 64 * j]; const f32x4 o = (v[j] - mean) * rstd * (b + 1.f) + a;
            ((u32x2*)(H + (size_t)row * D))[F.lane + 64 * j] = (u32x2){pk2(o.x, o.y), pk2(o.z, o.w)}; }
    }
}
__device__ __forceinline__ void row_phase_a(Frame& F, int layer, const float* xin, const float* bias) {
    const int gw = F.vcu * NWAVES + F.wave, NGW = F.G * NWAVES; const float* mods = (const float*)(F.ws + WS_MODS) + (size_t)layer * 9 * 6144;
    const float* Y = (const float*)(F.ws + WS_R1); bf16_t* T = (bf16_t*)(F.ws + WS_R0); float* X = F.out;
    const float* lg = F.in[6] + (size_t)(layer * 2) * D; const float* lb = F.in[7] + (size_t)(layer * 2) * D;
    const float* wg = F.in[21] + (size_t)layer * D * 4; const float* bg = F.in[22] + layer * 4; const float* wf = F.in[23] + (size_t)layer * D * 32; const float* bfp = F.in[24] + layer * 32;
    int* eidx = (int*)(F.ws + WS_MISC + MISC_EIDX); float* ew = (float*)(F.ws + WS_MISC + MISC_EW); unsigned* cnt = F.ctl + CW_CNT + layer * 128;
    for (int row = gw; row < NLAT; row += NGW) {
        const int b = row >> 12; const float* mr = mods + (size_t)b * 6144;
        f32x4 v[4];
#pragma unroll
        for (int j = 0; j < 4; ++j) { const int q = F.lane + 64 * j; f32x4 y = ((const f32x4*)(Y + (size_t)row * D))[q]; if (bias) y = y + ((const f32x4*)bias)[q];
            v[j] = ((const f32x4*)(xin + (size_t)row * D))[q] * ALPHA + ((const f32x4*)(mr + 2 * 1024))[q] * y; }
        float mean, rstd; ln_stats(v, mean, rstd);
#pragma unroll
        for (int j = 0; j < 4; ++j) { const int q = F.lane + 64 * j; v[j] = (v[j] - mean) * rstd * ((const f32x4*)lg)[q] + ((const f32x4*)lb)[q]; ((f32x4*)(X + (size_t)row * D))[q] = v[j]; }
        ln_stats(v, mean, rstd);
#pragma unroll
        for (int j = 0; j < 4; ++j) { const int q = F.lane + 64 * j; v[j] = (v[j] - mean) * rstd * (((const f32x4*)(mr + 4 * 1024))[q] + 1.f) + ((const f32x4*)(mr + 3 * 1024))[q];
            ((u32x2*)(T + (size_t)row * D))[q] = (u32x2){pk2(v[j].x, v[j].y), pk2(v[j].z, v[j].w)}; }
        float mine = 0.f;
        for (int o = 0; o < 36; ++o) {
            float p = 0.f;
            if (o < 4) {
#pragma unroll
                for (int j = 0; j < 4; ++j) { const int c = 4 * (F.lane + 64 * j); p += v[j].x * wg[c * 4 + o] + v[j].y * wg[(c + 1) * 4 + o] + v[j].z * wg[(c + 2) * 4 + o] + v[j].w * wg[(c + 3) * 4 + o]; }
            } else {
#pragma unroll
                for (int j = 0; j < 4; ++j) { const int c = 4 * (F.lane + 64 * j), e = o - 4; p += v[j].x * wf[c * 32 + e] + v[j].y * wf[(c + 1) * 32 + e] + v[j].z * wf[(c + 2) * 32 + e] + v[j].w * wf[(c + 3) * 32 + e]; }
            }
            p = wave_sum(p) + (o < 4 ? bg[o] : bfp[o - 4]);
            if (F.lane == o) mine = p;
        }
        const float g0 = __shfl(mine, 0), g1 = __shfl(mine, 1), g2 = __shfl(mine, 2), g3 = __shfl(mine, 3);
        int gi = 0; float gm = g0;
        if (g1 > gm) { gm = g1; gi = 1; }
        if (g2 > gm) { gm = g2; gi = 2; }
        if (g3 > gm) { gm = g3; gi = 3; }
        const float pg = 1.f / (expf(g0 - gm) + expf(g1 - gm) + expf(g2 - gm) + expf(g3 - gm));
        int i0 = 0; float v0 = -INFINITY; int i1 = 0; float v1 = -INFINITY;
#pragma unroll
        for (int j = 0; j < 8; ++j) { const float vv = __shfl(mine, 4 + gi * 8 + j);
            if (vv > v0) { v1 = v0; i1 = i0; v0 = vv; i0 = j; } else if (vv > v1) { v1 = vv; i1 = j; } }
        const float e1 = expf(v1 - v0); const float w0 = 1.f / (1.f + e1), w1 = e1 / (1.f + e1);
        if (F.lane == 0) { const int ea = gi * 8 + i0, eb = gi * 8 + i1; eidx[row * 2] = ea; eidx[row * 2 + 1] = eb; ew[row * 2] = w0 * pg; ew[row * 2 + 1] = w1 * pg;
            atomicAdd(cnt + ea, 1u); atomicAdd(cnt + eb, 1u); }
    }
}
__device__ __forceinline__ void row_phase_b(Frame& F, int layer, bool make_h) {
    const int gw = F.vcu * NWAVES + F.wave, NGW = F.G * NWAVES; const float* mods = (const float*)(F.ws + WS_MODS) + (size_t)layer * 9 * 6144;
    const float* modn = (const float*)(F.ws + WS_MODS) + (size_t)(layer + 1) * 9 * 6144;
    const bf16_t* MO = (const bf16_t*)(F.ws + WS_R1); bf16_t* H = (bf16_t*)(F.ws + WS_R0); float* X = F.out;
    const float* lg = F.in[6] + (size_t)(layer * 2 + 1) * D; const float* lb = F.in[7] + (size_t)(layer * 2 + 1) * D;
    for (int row = gw; row < NLAT; row += NGW) {
        const int b = row >> 12; const float* mr = mods + (size_t)b * 6144;
        f32x4 v[4];
#pragma unroll
        for (int j = 0; j < 4; ++j) { const int q = F.lane + 64 * j; const u32x2 m0 = ((const u32x2*)(MO + (size_t)row * D))[q], m1 = ((const u32x2*)(MO + ((size_t)NLAT + row) * D))[q];
            const f32x4 m = (f32x4){bflo(m0.x) + bflo(m1.x), bfhi(m0.x) + bfhi(m1.x), bflo(m0.y) + bflo(m1.y), bfhi(m0.y) + bfhi(m1.y)};
            v[j] = ((const f32x4*)(X + (size_t)row * D))[q] * ALPHA + ((const f32x4*)(mr + 5 * 1024))[q] * m; }
        float mean, rstd; ln_stats(v, mean, rstd);
#pragma unroll
        for (int j = 0; j < 4; ++j) { const int q = F.lane + 64 * j; v[j] = (v[j] - mean) * rstd * ((const f32x4*)lg)[q] + ((const f32x4*)lb)[q]; ((f32x4*)(X + (size_t)row * D))[q] = v[j]; }
        if (make_h) { const float* mn = modn + (size_t)b * 6144;
            ln_stats(v, mean, rstd);
#pragma unroll
            for (int j = 0; j < 4; ++j) { const int q = F.lane + 64 * j; const f32x4 o = (v[j] - mean) * rstd * (((const f32x4*)(mn + 1024))[q] + 1.f) + ((const f32x4*)mn)[q];
                ((u32x2*)(H + (size_t)row * D))[q] = (u32x2){pk2(o.x, o.y), pk2(o.z, o.w)}; } }
    }
}

__device__ __forceinline__ void moe_tile_prefix(Frame& F, int layer) {
    volatile LAS int* ts = (volatile LAS int*)(F.lds + LDSCTL_OFF + LC_TSTART);
    if (F.tid == 0) { int acc = 0; for (int e = 0; e < NE; ++e) { ts[e] = acc; acc += (int)((xb_ld(F.ctl + CW_CNT + layer * 128 + e) + 255u) >> 8); } ts[NE] = acc; }
    __syncthreads();
}
__device__ __forceinline__ void moe_positions(Frame& F, int layer) {
    moe_tile_prefix(F, layer);
    const LAS int* ts = (const LAS int*)(F.lds + LDSCTL_OFF + LC_TSTART);
    const int* eidx = (const int*)(F.ws + WS_MISC + MISC_EIDX); int* rowtok = (int*)(F.ws + WS_MISC + MISC_ROWTOK);
    unsigned* cnt = F.ctl + CW_CNT + layer * 128; unsigned* cur = cnt + 64;
    const bf16_t* T = (const bf16_t*)(F.ws + WS_R0); bf16_t* TS = (bf16_t*)(F.ws + WS_R1);
    const int gw = F.vcu * NWAVES + F.wave, NGW = F.G * NWAVES;
    for (int a0 = gw * 64; a0 < 2 * NLAT; a0 += NGW * 64) {
        const int a = a0 + F.lane; const int e = eidx[a];
        const int pos = ts[e] * 256 + (int)atomicAdd(cur + e, 1u);
        rowtok[pos] = a;
        for (int j = 0; j < 64; ++j) { const int pj = __shfl(pos, j); const int tok = (a0 + j) >> 1;
            const u32x4* s = (const u32x4*)(T + (size_t)tok * D); u32x4* d = (u32x4*)(TS + (size_t)pj * D);
            d[F.lane] = s[F.lane]; d[64 + F.lane] = s[64 + F.lane]; }
    }
    const int gt = F.vcu * NTHREADS + F.tid;
    if (gt < NE * 256) { const int e = gt >> 8, r = gt & 255; const int c = (int)xb_ld(cnt + e); const int padded = (c + 255) & ~255; if (c + r < padded) rowtok[ts[e] * 256 + c + r] = -1; }
}

struct DenseOrder {
    int nM, nN, nwg, G, c; const char* A; const char* B; size_t strideA, strideB;
    __device__ void init(int nM_, int nN_, int G_, int c_, const void* A_, size_t sA, const void* B_, size_t sB) { nM = nM_; nN = nN_; nwg = nM * nN; G = G_; c = c_; A = (const char*)A_; B = (const char*)B_; strideA = sA; strideB = sB; }
    __device__ bool next(int i, pg8::Unit& u) const {
        const long L = (long)i * G + c; if (L >= nwg) return false;
        int wgid = (int)L; { const int q = nwg / 8, r = nwg % 8, xcd = wgid % 8, off = wgid / 8; wgid = (xcd < r ? xcd * (q + 1) : r * (q + 1) + (xcd - r) * q) + off; }
        const int nig = 8 * nN, gid = wgid / nig, fm = gid * 8, gsz = (nM - fm) < 8 ? (nM - fm) : 8;
        u.pm = fm + ((wgid % nig) % gsz); u.pn = (wgid % nig) / gsz; u.A = A + (size_t)u.pm * strideA; u.B = B + (size_t)u.pn * strideB; return true;
    }
};
struct MoeOrder {
    const LAS int* ts; int G, c; const char* A; const char* W; size_t strideA, strideE, strideN;
    __device__ bool next(int i, pg8::Unit& u) const {
        const int L = i * G + c; const int ntile = ts[NE]; if (L >= ntile * 4) return false;
        const int rt = L >> 2, pn = L & 3; int e = 0;
#pragma unroll 1
        for (int q = 1; q < NE; ++q) e += (ts[q] <= rt) ? 1 : 0;
        u.pm = rt; u.pn = pn; u.A = A + (size_t)rt * strideA; u.B = W + (size_t)e * strideE + (size_t)pn * strideN; return true;
    }
};
struct ChanDftOrder {
    int G, c; const char* A; const char* H;
    __device__ bool next(int i, pg8::Unit& u) const {
        const int L = i * G + c; if (L >= 1024) return false;
        const int nt = L >> 3, g = (L >> 1) & 3, mt = L & 1;
        u.pm = g * 2 + mt; u.pn = nt; u.A = A + (size_t)mt * 256 * 256 * 2; u.B = H + ((size_t)nt * 256 * D + g * 256) * 2; return true;
    }
};
struct SeqDftOrder {
    int G, c; const char* A; const char* GT;
    __device__ bool next(int i, pg8::Unit& u) const {
        const int L = i * G + c; if (L >= 512) return false;
        const int pn = L & 3, mt = (L >> 2) & 15, b = L >> 6;
        u.pm = b * 16 + mt; u.pn = pn; u.A = A + (size_t)mt * 256 * 8192 * 2; u.B = GT + ((size_t)(b * 1024 + pn * 256) * 8192) * 2; return true;
    }
};

struct EpiInProj {
    static constexpr bool PERM = true;
    bf16_t *GX, *QB, *KB, *VB; const float* rope;
    __device__ __forceinline__ void operator()(const f32x4 (&acc)[2][2][4][2], const pg8::Unit& u, int wr, int wc, int fr, int fq) const {
        const int region = u.pn >> 1, cb = (u.pn & 1) * 256 + wc * 32 + 8 * fq; const bool latent = u.pm < (NLAT / 256);
        const bool dorope = latent && (region == 2 || region == 3); const int axis = wc & 1, half = fq >> 1, f0 = 8 * (fq & 1);
        if (region == 2 && !latent) return;
#pragma unroll
        for (int ai = 0; ai < 2; ++ai)
#pragma unroll
            for (int m = 0; m < 4; ++m) { const int row = u.pm * 256 + ai * 128 + wr * 64 + m * 16 + fr;
#pragma unroll
                for (int bj = 0; bj < 2; ++bj) { const int c = cb + bj * 128; float v[8];
#pragma unroll
                    for (int i = 0; i < 4; ++i) { v[i] = acc[ai][bj][m][0][i]; v[4 + i] = acc[ai][bj][m][1][i]; }
                    if (dorope) { const int tn = row & 4095, pos = axis ? (tn & 63) : (tn >> 6); const f32x4* cs = (const f32x4*)(rope + (size_t)(pos * 16 + f0) * 2);
                        const f32x4 c0 = cs[0], c1 = cs[1], c2 = cs[2], c3 = cs[3];
                        const float co[8] = {c0.x, c0.z, c1.x, c1.z, c2.x, c2.z, c3.x, c3.z}, si[8] = {c0.y, c0.w, c1.y, c1.w, c2.y, c2.w, c3.y, c3.w};
#pragma unroll
                        for (int i = 0; i < 8; ++i) { const float pv = __shfl_xor(v[i], 32); v[i] = v[i] * co[i] + (half ? pv : -pv) * si[i]; } }
                    if (region == 2) {
#pragma unroll
                        for (int i = 0; i < 8; ++i) v[i] *= QSCALE; }
                    const u32x4 w = (u32x4){pg8::cvt_pk_bf16(v[0], v[1]), pg8::cvt_pk_bf16(v[2], v[3]), pg8::cvt_pk_bf16(v[4], v[5]), pg8::cvt_pk_bf16(v[6], v[7])};
                    bf16_t* dst = region == 0 ? GX + (size_t)row * D + c : region == 1 ? GX + (size_t)row * D + 512 + c : region == 2 ? QB + (size_t)row * 512 + c : region == 3 ? KB + (size_t)row * 512 + c : VB + (size_t)row * 512 + c;
                    *(u32x4*)dst = w; } }
    }
};
struct EpiF32 {
    static constexpr bool PERM = false;
    float* C;
    __device__ __forceinline__ void operator()(const f32x4 (&acc)[2][2][4][2], const pg8::Unit& u, int wr, int wc, int fr, int fq) const {
        const int row0 = u.pm * 256 + wr * 64 + fr, col0 = u.pn * 256 + wc * 32 + 4 * fq;
#pragma unroll
        for (int ai = 0; ai < 2; ++ai)
#pragma unroll
            for (int m = 0; m < 4; ++m) { float* rowp = C + (size_t)(row0 + ai * 128 + m * 16) * D + col0;
#pragma unroll
                for (int bj = 0; bj < 2; ++bj)
#pragma unroll
                    for (int n = 0; n < 2; ++n) *(f32x4*)(rowp + bj * 128 + n * 16) = acc[ai][bj][m][n]; }
    }
};
struct EpiSwiGLU {
    static constexpr bool PERM = true;
    bf16_t* HID;
    __device__ __forceinline__ void operator()(const f32x4 (&acc)[2][2][4][2], const pg8::Unit& u, int wr, int wc, int fr, int fq) const {
        const int cb = u.pn * 256 + wc * 32 + 8 * fq;
#pragma unroll
        for (int ai = 0; ai < 2; ++ai)
#pragma unroll
            for (int m = 0; m < 4; ++m) { const int row = u.pm * 256 + ai * 128 + wr * 64 + m * 16 + fr;
#pragma unroll
                for (int bj = 0; bj < 2; ++bj) { const int j0 = ((cb + bj * 128) >> 3) * 4; const f32x4 a = acc[ai][bj][m][0], b = acc[ai][bj][m][1];
                    const float h0 = silu_f(a[0]) * b[0], h1 = silu_f(a[1]) * b[1], h2 = silu_f(a[2]) * b[2], h3 = silu_f(a[3]) * b[3];
                    *(u32x2*)(HID + (size_t)row * FF + j0) = (u32x2){pg8::cvt_pk_bf16(h0, h1), pg8::cvt_pk_bf16(h2, h3)}; } }
    }
};
struct EpiScatter {
    static constexpr bool PERM = true;
    bf16_t* MOUT; const int* rowtok; const float* ew;
    __device__ __forceinline__ void operator()(const f32x4 (&acc)[2][2][4][2], const pg8::Unit& u, int wr, int wc, int fr, int fq) const {
        const int cb = u.pn * 256 + wc * 32 + 8 * fq;
#pragma unroll
        for (int ai = 0; ai < 2; ++ai)
#pragma unroll
            for (int m = 0; m < 4; ++m) { const int row = u.pm * 256 + ai * 128 + wr * 64 + m * 16 + fr; const int a = rowtok[row];
                if (a >= 0) { const float w = ew[a]; bf16_t* dst = MOUT + ((size_t)(a & 1) * NLAT + (a >> 1)) * D + cb;
#pragma unroll
                    for (int bj = 0; bj < 2; ++bj) { const f32x4 x = acc[ai][bj][m][0] * w, y = acc[ai][bj][m][1] * w;
                        *(u32x4*)(dst + bj * 128) = (u32x4){pg8::cvt_pk_bf16(x[0], x[1]), pg8::cvt_pk_bf16(x[2], x[3]), pg8::cvt_pk_bf16(y[0], y[1]), pg8::cvt_pk_bf16(y[2], y[3])}; } } }
    }
};
struct EpiGT {
    static constexpr bool PERM = true;
    bf16_t* GT;
    __device__ __forceinline__ void operator()(const f32x4 (&acc)[2][2][4][2], const pg8::Unit& u, int wr, int wc, int fr, int fq) const {
        const int g = u.pm >> 1, mt = u.pm & 1; const int nb = u.pn * 256 + wc * 32 + 8 * fq;
#pragma unroll
        for (int ai = 0; ai < 2; ++ai)
#pragma unroll
            for (int m = 0; m < 4; ++m) { const int mrow = mt * 256 + ai * 128 + wr * 64 + m * 16 + fr; const int chan = g * 256 + (mrow & 255), part = mrow >> 8;
#pragma unroll
                for (int bj = 0; bj < 2; ++bj) { const int n = nb + bj * 128, b = n >> 12, nl = n & 4095; const f32x4 x = acc[ai][bj][m][0], y = acc[ai][bj][m][1];
                    *(u32x4*)(GT + ((size_t)(b * 1024 + chan) * 8192) + part * 4096 + nl) = (u32x4){pg8::cvt_pk_bf16(x[0], x[1]), pg8::cvt_pk_bf16(x[2], x[3]), pg8::cvt_pk_bf16(y[0], y[1]), pg8::cvt_pk_bf16(y[2], y[3])}; } }
    }
};
struct EpiBf16S {
    static constexpr bool PERM = true;
    bf16_t* O; float scale;
    __device__ __forceinline__ void operator()(const f32x4 (&acc)[2][2][4][2], const pg8::Unit& u, int wr, int wc, int fr, int fq) const {
        const int cb = u.pn * 256 + wc * 32 + 8 * fq;
#pragma unroll
        for (int ai = 0; ai < 2; ++ai)
#pragma unroll
            for (int m = 0; m < 4; ++m) { const int row = u.pm * 256 + ai * 128 + wr * 64 + m * 16 + fr;
#pragma unroll
                for (int bj = 0; bj < 2; ++bj) { const f32x4 x = acc[ai][bj][m][0] * scale, y = acc[ai][bj][m][1] * scale;
                    *(u32x4*)(O + (size_t)row * D + cb + bj * 128) = (u32x4){pg8::cvt_pk_bf16(x[0], x[1]), pg8::cvt_pk_bf16(x[2], x[3]), pg8::cvt_pk_bf16(y[0], y[1]), pg8::cvt_pk_bf16(y[2], y[3])}; } }
    }
};
template <class Epi, class Sched> __device__ __forceinline__ void run_gemm(Frame& F, const pg8::Shape g, const Sched& S, const Epi& E) {
#if FAST_GEMM
    pg8::Shape gg = g; asm volatile("" : "+s"(gg.K));
    pg8::gemm_phase<Epi, Sched, true>(F.lds, gg, S, E);
#else
    pg8::gemm_phase_ref<Epi, Sched>(g, S, E);
#endif
}

__device__ __forceinline__ void lru_simple(Frame& F, int b) {
    const bf16_t* GX = (const bf16_t*)(F.ws + WS_R1 + R1_GX); bf16_t* CAT = (bf16_t*)(F.ws + WS_R0); float* YF = (float*)(F.ws + WS_R2);
    const float* cw = F.in[9]; const float* cbp = F.in[10]; const float* sp = (const float*)(F.ws + WS_SMALL) + 64;
    LAS bf16_t* wl = (LAS bf16_t*)F.lds;
    LAS float* xs = (LAS float*)(F.lds + LDSCTL_OFF + LC_XS);
    const int c = F.tid, h = c >> 6, j = c & 63;
    const float w0 = cw[c], w1 = cw[LW + c], w2 = cw[2 * LW + c], w3 = cw[3 * LW + c], cb = cbp[c];
    for (int d = 0; d < 2; ++d) {
        __syncthreads();
        for (int i = F.tid; i < 2 * 8 * 64 * 64; i += NTHREADS) { const int jj = i & 63, ii = (i >> 6) & 63, hh = (i >> 12) & 7, t = i >> 15; const float* w = t ? F.in[13] : F.in[11];
            wl[i] = (bf16_t)f2bf(w[(((size_t)d * 8 + hh) * 64 + ii) * 64 + jj]); }
        __syncthreads();
        const float ba = F.in[12][d * LW + c], bx = F.in[14][d * LW + c], spc = sp[d * LW + c];
        float hst = 0.f;
        for (int step = 0; step < CTX + SEQ; ++step) {
            const bool isctx = step < CTX; const int n = isctx ? (d == 0 ? step : CTX - 1 - step) : (d == 0 ? step - CTX : SEQ - 1 - (step - CTX));
            const int len = isctx ? CTX : SEQ; const size_t row0 = isctx ? (size_t)NLAT + (size_t)b * CTX : (size_t)b * SEQ;
            float xc = cb;
            if (n - 2 >= 0) xc += bf2f(GX[(row0 + n - 2) * D + 512 + c]) * w0;
            if (n - 1 >= 0) xc += bf2f(GX[(row0 + n - 1) * D + 512 + c]) * w1;
            xc += bf2f(GX[(row0 + n) * D + 512 + c]) * w2;
            if (n + 1 < len) xc += bf2f(GX[(row0 + n + 1) * D + 512 + c]) * w3;
            __syncthreads();
            xs[c] = bf2f(f2bf(xc));
            __syncthreads();
            float ra = 0.f, rx = 0.f;
            for (int i = 0; i < 64; ++i) { const float xv = xs[h * 64 + i]; ra += xv * bf2f(wl[((0 * 8 + h) * 64 + i) * 64 + j]); rx += xv * bf2f(wl[((1 * 8 + h) * 64 + i) * 64 + j]); }
            const float r = sigmoid_f(ra + ba), ig = sigmoid_f(rx + bx);
            const float log_a = -8.f * spc * r; const float a = expf(log_a); const float mult = sqrtf(-expm1f(2.f * log_a));
            hst = a * hst + mult * ig * xc;
            if (!isctx) { const size_t o = ((size_t)b * SEQ + n) * LW + c;
                if (d == 0) YF[o] = hst;
                else { const float g = bf2f(GX[((size_t)b * SEQ + n) * D + c]); CAT[((size_t)b * SEQ + n) * D + c] = (bf16_t)f2bf((YF[o] + hst) * gelu_tanh_f(g)); } }
        }
    }
    __syncthreads();
}

__device__ __forceinline__ void attn_simple(Frame& F) {
    const bf16_t* QB = (const bf16_t*)(F.ws + WS_R1 + R1_QB); const bf16_t* KB = (const bf16_t*)(F.ws + WS_R1 + R1_KB); const bf16_t* VB = (const bf16_t*)(F.ws + WS_R1 + R1_VB);
    bf16_t* CAT = (bf16_t*)(F.ws + WS_R0); const float lam = ((const float*)(F.ws + WS_SMALL))[0]; const float* subln = F.in[17];
    LAS float* Qs = (LAS float*)F.lds;
    LAS float* Ks = Qs + 64 * 128;
    LAS float* Vs = Ks + 64 * 129;
    LAS float* Ps = Vs + 64 * 128;
    const int lane = F.lane, wv = F.wave;
    for (int u = F.vcu; u < NB * NH * (SEQ / 64); u += F.G) {
        const int qb = u & 63, h = (u >> 6) & 3, b = u >> 8;
        __syncthreads();
        for (int i = F.tid; i < 64 * 128; i += NTHREADS) { const int r = i >> 7, cc = i & 127; Qs[i] = bf2f(QB[((size_t)b * SEQ + qb * 64 + r) * 512 + h * 128 + cc]); }
        float m1[8], m2[8], l1[8], l2[8], o1a[8], o1b[8], o2a[8], o2b[8];
#pragma unroll
        for (int r = 0; r < 8; ++r) { m1[r] = -INFINITY; m2[r] = -INFINITY; l1[r] = 0.f; l2[r] = 0.f; o1a[r] = 0.f; o1b[r] = 0.f; o2a[r] = 0.f; o2b[r] = 0.f; }
        for (int pass = 0; pass < 2; ++pass) {
            for (int t = 0; t < (CTX + SEQ) / 64; ++t) {
                const size_t krow0 = t < 4 ? (size_t)NLAT + (size_t)b * CTX + t * 64 : (size_t)b * SEQ + (t - 4) * 64;
                __syncthreads();
                for (int i = F.tid; i < 64 * 128; i += NTHREADS) { const int r = i >> 7, cc = i & 127; Ks[r * 129 + cc] = bf2f(KB[(krow0 + r) * 512 + h * 128 + cc]); Vs[i] = bf2f(VB[(krow0 + r) * 512 + h * 128 + cc]); }
                __syncthreads();
#pragma unroll
                for (int r = 0; r < 8; ++r) {
                    const LAS float* q = Qs + (wv * 8 + r) * 128; const LAS float* k = Ks + lane * 129;
                    float s1 = 0.f, s2 = 0.f;
                    for (int dd = 0; dd < 64; ++dd) { s1 += q[dd] * k[dd]; s2 += q[64 + dd] * k[64 + dd]; }
                    if (pass == 0) { m1[r] = fmaxf(m1[r], s1); m2[r] = fmaxf(m2[r], s2); }
                    else {
                        const float p1 = exp2f(s1 - m1[r]), p2 = exp2f(s2 - m2[r]);
                        l1[r] += p1; l2[r] += p2;
                        Ps[(wv * 2 + 0) * 64 + lane] = p1; Ps[(wv * 2 + 1) * 64 + lane] = p2;
                        LDS_WAIT(); asm volatile("" ::: "memory");
                        float a0 = 0.f, a1 = 0.f, c0 = 0.f, c1 = 0.f;
                        for (int kk = 0; kk < 64; ++kk) { const float pp1 = Ps[(wv * 2 + 0) * 64 + kk], pp2 = Ps[(wv * 2 + 1) * 64 + kk]; const float va = Vs[kk * 128 + lane], vb = Vs[kk * 128 + 64 + lane];
                            a0 += pp1 * va; a1 += pp1 * vb; c0 += pp2 * va; c1 += pp2 * vb; }
                        o1a[r] += a0; o1b[r] += a1; o2a[r] += c0; o2b[r] += c1;
                        LDS_WAIT(); asm volatile("" ::: "memory");
                    }
                }
            }
            if (pass == 0) {
#pragma unroll
                for (int r = 0; r < 8; ++r) { m1[r] = wave_max(m1[r]); m2[r] = wave_max(m2[r]); }
            }
        }
#pragma unroll
        for (int r = 0; r < 8; ++r) {
            const float L1 = wave_sum(l1[r]), L2 = wave_sum(l2[r]);
            const float oa = o1a[r] / L1 - lam * o2a[r] / L2, ob = o1b[r] / L1 - lam * o2b[r] / L2;
            const float ms = wave_sum(oa * oa + ob * ob) * (1.f / 128.f); const float rs = 1.f / sqrtf(ms + LN_EPS);
            bf16_t* dst = CAT + ((size_t)b * SEQ + qb * 64 + wv * 8 + r) * D + 512 + h * 128;
            dst[lane] = (bf16_t)f2bf(oa * rs * subln[lane] * 0.8f); dst[64 + lane] = (bf16_t)f2bf(ob * rs * subln[64 + lane] * 0.8f);
        }
    }
    __syncthreads();
}

constexpr int NPHASE = 18;
__global__ void __launch_bounds__(NTHREADS, 2) mk_fwd(Args args) {
    extern __shared__ __attribute__((aligned(16))) unsigned char lds_raw[];
    Frame F;
    F.lds = (LAS unsigned char*)lds_raw; F.ws = args.ws; F.ctl = (unsigned*)(args.ws + WS_CTL); F.out = args.out;
#pragma unroll
    for (int i = 0; i < 28; ++i) F.in[i] = args.in[i];
    F.tid = threadIdx.x; F.lane = F.tid & 63; F.wave = __builtin_amdgcn_readfirstlane(F.tid >> 6);
    F.G = gridDim.x; { const int bx = blockIdx.x; F.vcu = (F.G % 8 == 0) ? (bx % 8) * (F.G / 8) + bx / 8 : bx; }
    for (int u = F.tid; u < (LDS_BYTES - LDSCTL_OFF) / 4; u += NTHREADS) ((LAS unsigned*)(F.lds + LDSCTL_OFF))[u] = 0u;
    __syncthreads();
    XcdBarrier bar = xcd_barrier_post(F.ctl + CW_BAR, (volatile LAS unsigned*)(F.lds + LDSCTL_OFF + LC_BAR));
#if defined(PH_RUNTIME)
    const int lo = args.ph_lo, hi = args.ph_hi;
#else
    constexpr int lo = 0, hi = NPHASE;
#endif
#ifndef SKIP_MASK
#define SKIP_MASK 0u
#endif
#define IN(k) (!((SKIP_MASK >> (k)) & 1u) && lo <= (k) && (k) < hi)
#define SEAM(k) do { if (IN(k) && IN((k) + 1)) xcd_barrier(bar); } while (0)
#define PHB() do { int t_ = threadIdx.x; asm volatile("" : "+v"(t_)); F.tid = t_; F.lane = t_ & 63; F.wave = __builtin_amdgcn_readfirstlane(t_ >> 6); } while (0)
    unsigned char* ws = args.ws;
    bf16_t* R0 = (bf16_t*)(ws + WS_R0); unsigned char* R1 = ws + WS_R1;

    if (IN(0)) { PHB(); p0_prologue(F); } SEAM(0);
    if (IN(1)) { PHB(); p1_lnmod(F); } SEAM(1);
    if (IN(2)) {
        DenseOrder S; S.init(MALL / 256, INE / 256, F.G, (int)blockIdx.x, R0, (size_t)256 * D * 2, ws + WS_WIN, (size_t)256 * D * 2);
        EpiInProj E{(bf16_t*)(R1 + R1_GX), (bf16_t*)(R1 + R1_QB), (bf16_t*)(R1 + R1_KB), (bf16_t*)(R1 + R1_VB), (const float*)(ws + WS_ROPE)};
        run_gemm(F, pg8::Shape{D, D, D}, S, E);
    } SEAM(2);
    if (IN(3)) {
        PHB(); if ((int)blockIdx.x < NB) lru_simple(F, (int)blockIdx.x);
        PHB(); attn_simple(F);
    } SEAM(3);
    if (IN(4)) {
        DenseOrder S; S.init(NLAT / 256, D / 256, F.G, (int)blockIdx.x, R0, (size_t)256 * D * 2, ws + WS_WOUT, (size_t)256 * D * 2);
        EpiF32 E{(float*)R1};
        run_gemm(F, pg8::Shape{D, D, D}, S, E);
    } SEAM(4);
    if (IN(5)) { PHB(); row_phase_a(F, 0, F.in[0], nullptr); } SEAM(5);
#pragma unroll
    for (int layer = 0; layer < 2; ++layer) {
        const int pb = layer == 0 ? 6 : 14;
        unsigned char* moew = ws + WS_MOEW + (size_t)layer * MOEW_LAYER;
        if (IN(pb)) { PHB(); moe_positions(F, layer); } SEAM(pb);
        if (IN(pb + 1)) {
            PHB(); moe_tile_prefix(F, layer);
            MoeOrder S{(const LAS int*)(F.lds + LDSCTL_OFF + LC_TSTART), F.G, (int)blockIdx.x, (const char*)R1, (const char*)moew, (size_t)256 * D * 2, (size_t)D * D * 2, (size_t)256 * D * 2};
            EpiSwiGLU E{(bf16_t*)(ws + WS_R2)};
            run_gemm(F, pg8::Shape{D, D, D}, S, E);
        } SEAM(pb + 1);
        if (IN(pb + 2)) {
            PHB(); moe_tile_prefix(F, layer);
            MoeOrder S{(const LAS int*)(F.lds + LDSCTL_OFF + LC_TSTART), F.G, (int)blockIdx.x, (const char*)(ws + WS_R2), (const char*)(moew + MOEW_W2), (size_t)256 * FF * 2, (size_t)D * FF * 2, (size_t)256 * FF * 2};
            EpiScatter E{(bf16_t*)R1, (const int*)(ws + WS_MISC + MISC_ROWTOK), (const float*)(ws + WS_MISC + MISC_EW)};
            run_gemm(F, pg8::Shape{FF, FF, FF}, S, E);
        } SEAM(pb + 2);
        if (IN(pb + 3)) { PHB(); row_phase_b(F, layer, layer == 0); } SEAM(pb + 3);
        if (layer == 0) {
            if (IN(10)) {
                ChanDftOrder S{F.G, (int)blockIdx.x, (const char*)(ws + WS_CDFT), (const char*)R0};
                EpiGT E{(bf16_t*)R1};
                run_gemm(F, pg8::Shape{256, 256, D}, S, E);
            } SEAM(10);
            if (IN(11)) {
                SeqDftOrder S{F.G, (int)blockIdx.x, (const char*)(ws + WS_CMAT), (const char*)R1};
                EpiBf16S E{R0, 1.f / 1024.f};
                run_gemm(F, pg8::Shape{8192, 8192, 8192}, S, E);
            } SEAM(11);
            if (IN(12)) {
                DenseOrder S; S.init(NLAT / 256, D / 256, F.G, (int)blockIdx.x, R0, (size_t)256 * D * 2, ws + WS_ODW, (size_t)256 * D * 2);
                EpiF32 E{(float*)R1};
                run_gemm(F, pg8::Shape{D, D, D}, S, E);
            } SEAM(12);
            if (IN(13)) { PHB(); row_phase_a(F, 1, F.out, F.in[20]); } SEAM(13);
        }
    }
#undef IN
#undef SEAM
}

extern "C" void kernel_launch(void* const* d_in, const int* in_sizes, int n_in, void* d_out, int out_size, void* d_ws, size_t ws_size, hipStream_t stream) {
    static int grid = 0;
    if (grid == 0) {
        if (n_in != 28 || out_size != NLAT * D || ws_size < WS_END) { fprintf(stderr, "kernel_launch: unexpected problem (n_in %d, out %d, ws %zu < %zu)\n", n_in, out_size, ws_size, (size_t)WS_END); grid = -1; return; }
        int dev = 0, cus = 0, per_cu = 0;
        if (hipGetDevice(&dev) != hipSuccess || hipDeviceGetAttribute(&cus, hipDeviceAttributeMultiprocessorCount, dev) != hipSuccess) { grid = -1; return; }
        if (hipFuncSetAttribute((const void*)mk_fwd, hipFuncAttributeMaxDynamicSharedMemorySize, LDS_BYTES) != hipSuccess) { fprintf(stderr, "kernel_launch: hipFuncSetAttribute failed\n"); grid = -1; return; }
        if (hipOccupancyMaxActiveBlocksPerMultiprocessor(&per_cu, (const void*)mk_fwd, NTHREADS, LDS_BYTES) != hipSuccess || per_cu < 1) fprintf(stderr, "kernel_launch: occupancy query reports %d\n", per_cu);
        (void)hipGetLastError();
        grid = cus;
    }
    if (grid < 0) return;
    if (hipMemsetAsync((char*)d_ws + WS_CTL, 0, CTL_ZERO_BYTES, stream) != hipSuccess) return;
    Args a{};
    for (int i = 0; i < 28; ++i) a.in[i] = (const float*)d_in[i];
    a.out = (float*)d_out; a.ws = (unsigned char*)d_ws; a.ph_lo = 0; a.ph_hi = NPHASE;
    hipLaunchKernelGGL(mk_fwd, dim3(grid), dim3(NTHREADS), LDS_BYTES, stream, a);
}
```

```cpp
#include <hip/hip_runtime.h>
#include <stdio.h>
#include <stdint.h>
#include <math.h>

#ifndef FAST_LRU
#define FAST_LRU 1
#endif
#ifndef FAST_ATTN
#define FAST_ATTN 1
#endif
#ifndef FAST_GEMM
#define FAST_GEMM 1
#endif

constexpr int D = 1024, NB = 8, SEQ = 4096, CTX = 256, NLAT = NB * SEQ, NCTX = NB * CTX, MALL = NLAT + NCTX;
constexpr int INE = 2560, LW = 512, NH = 4, NE = 32, FF = 512;
constexpr int MOE_ROWS = 2 * NLAT + NE * 256, MOE_TILES = MOE_ROWS / 256;
constexpr float LN_EPS = 1e-6f, ALPHA = 1.41421356237309515f;
constexpr float QSCALE = 0.125f * 1.4426950408889634f;
constexpr int NWAVES = 8, NTHREADS = 512;

constexpr size_t MiB = 1u << 20;
constexpr size_t WS_CTL = 0, CTL_ZERO_BYTES = 1 * MiB;
constexpr size_t WS_MODS = 1 * MiB;
constexpr size_t WS_ROPE = WS_MODS + 512 * 1024;
constexpr size_t WS_SMALL = WS_ROPE + 16 * 1024;
constexpr size_t WS_GATEW = WS_MODS + 768 * 1024;
constexpr size_t WS_CDFT = 2 * MiB;
constexpr size_t WS_WIN = 3 * MiB, WS_WOUT = 8 * MiB, WS_ODW = 10 * MiB;
constexpr size_t WS_CMAT = 12 * MiB;
constexpr size_t WS_MOEW = 76 * MiB, MOEW_LAYER = 96 * MiB, MOEW_W2 = 64 * MiB;
constexpr size_t WS_R0 = 268 * MiB;
constexpr size_t WS_R1 = 336 * MiB;
constexpr size_t R1_GX = 0, R1_QB = 68 * MiB, R1_KB = 100 * MiB, R1_VB = 134 * MiB;
constexpr size_t WS_R2 = 504 * MiB;
constexpr size_t WS_MISC = 576 * MiB;
constexpr size_t MISC_EIDX = 0, MISC_EW = 256 * 1024, MISC_ROWTOK = 512 * 1024;
constexpr size_t MISC_BCNT = 896 * 1024;
constexpr size_t MISC_WRT = 5632 * 1024;
constexpr size_t MISC_SUMM = 1 * MiB;
constexpr size_t WS_END = 582 * MiB;
constexpr int CW_BAR = 4096;
constexpr int CW_CNT = 16384;
constexpr int RING_BYTES = 131072, LDSCTL_OFF = 139264, LDS_BYTES = 147456;
constexpr int LC_BAR = 0;
constexpr int LC_TSTART = 64;
constexpr int LC_XS = 1024;
constexpr int LC_HIST = 3072, LC_BASE = 3200, LC_LCUR = 3328;
constexpr int LC_POS = 4096;

#define GAS __attribute__((address_space(1)))
#define LAS __attribute__((address_space(3)))
typedef unsigned short bf16_t;
typedef short bf16x8 __attribute__((ext_vector_type(8)));
typedef float f32x4 __attribute__((ext_vector_type(4)));
typedef float f32x2 __attribute__((ext_vector_type(2)));
typedef unsigned u32x4 __attribute__((ext_vector_type(4)));
typedef unsigned u32x2 __attribute__((ext_vector_type(2)));

__device__ __forceinline__ unsigned f2bf(float f) { unsigned u = __float_as_uint(f); return (u + 0x7fffu + ((u >> 16) & 1u)) >> 16; }
__device__ __forceinline__ float bf2f(unsigned b) { return __uint_as_float(b << 16); }
__device__ __forceinline__ unsigned pk2(float lo, float hi) { return f2bf(lo) | (f2bf(hi) << 16); }
__device__ __forceinline__ float bflo(unsigned w) { return __uint_as_float(w << 16); }
__device__ __forceinline__ float bfhi(unsigned w) { return __uint_as_float(w & 0xffff0000u); }
__device__ __forceinline__ float wave_sum(float v) {
#pragma unroll
    for (int o = 1; o < 64; o <<= 1) v += __shfl_xor(v, o);
    return v;
}
__device__ __forceinline__ float wave_max(float v) {
#pragma unroll
    for (int o = 1; o < 64; o <<= 1) v = fmaxf(v, __shfl_xor(v, o));
    return v;
}
__device__ __forceinline__ float sigmoid_f(float x) { return 1.f / (1.f + __expf(-x)); }
__device__ __forceinline__ float silu_f(float x) { return x / (1.f + __expf(-x)); }
__device__ __forceinline__ float gelu_tanh_f(float x) { const float u = 0.7978845608028654f * (x + 0.044715f * x * x * x); return x / (1.f + __expf(-2.f * u)); }

#define XB_TMO      128
#define XB_XCNT(j)  (256  + 64 * (j))
#define XB_XSUB(j)  (1280 + 64 * (j))
#define XB_XGEN(j)  (2304 + 64 * (j))
#define XB_TOP      3328
#define XB_TOPGEN   3392
#define XCD_BAR_WORDS 3456
#define XB_SPIN_CAP (1u << 18)
__device__ __forceinline__ unsigned xb_ld(unsigned* p)              { return __hip_atomic_load(p, __ATOMIC_RELAXED, __HIP_MEMORY_SCOPE_AGENT); }
__device__ __forceinline__ unsigned xb_add(unsigned* p, unsigned v) { return __hip_atomic_fetch_add(p, v, __ATOMIC_RELAXED, __HIP_MEMORY_SCOPE_AGENT); }
__device__ __forceinline__ unsigned xb_xcc_id() { return (unsigned)__builtin_amdgcn_s_getreg((3 << 11) | 20) & 0xFu; }
#define XB_SPIN(cond, bar) do { unsigned _sp = 0; while (cond) { __builtin_amdgcn_s_sleep(1); \
    if ((++_sp & 255u) == 0u) { if (xb_ld(&(bar)[XB_TMO])) break; if (_sp > XB_SPIN_CAP) { atomicAdd(&(bar)[XB_TMO], 1u); break; } } } } while (0)
struct XcdBarrier { unsigned* bar; unsigned x; volatile LAS unsigned* st; };
__device__ __forceinline__ XcdBarrier xcd_barrier_post(unsigned* bar, volatile LAS unsigned* st) {
    XcdBarrier b; b.bar = bar; b.x = xb_xcc_id(); b.st = st;
    if (threadIdx.x == 0) (void)xb_add(&bar[XB_XCNT(b.x)], 1u);
    return b;
}
__device__ __forceinline__ void xcd_barrier_complete(unsigned* bar, unsigned x, unsigned& nloc, unsigned& nx) {
    const unsigned G = gridDim.x * gridDim.y * gridDim.z;
    unsigned sum, cnt, mine, sp = 0u;
    for (;;) {
        sum = 0u; cnt = 0u; mine = 0u;
#pragma unroll
        for (unsigned j = 0; j < 16; ++j) { const unsigned c = xb_ld(&bar[XB_XCNT(j)]); sum += c; cnt += (c > 0u) ? 1u : 0u; mine = (j == x) ? c : mine; }
        if (sum == G) break;
        __builtin_amdgcn_s_sleep(1);
        if ((++sp & 255u) == 0u) { if (xb_ld(&bar[XB_TMO])) break; if (sp > XB_SPIN_CAP) { atomicAdd(&bar[XB_TMO], 1u); break; } }
    }
    nloc = mine > 0u ? mine : 1u; nx = cnt > 0u ? cnt : 1u;
}
__device__ __forceinline__ void xcd_barrier(const XcdBarrier& b) {
    asm volatile("s_waitcnt vmcnt(0)" ::: "memory");
    __syncthreads();
    if (threadIdx.x == 0) {
        unsigned* bar = b.bar;
        __builtin_amdgcn_s_waitcnt(0);
        unsigned nloc = b.st[0], nx = b.st[1];
        if (nloc == 0u) { xcd_barrier_complete(bar, b.x, nloc, nx); b.st[0] = nloc; b.st[1] = nx; }
        const unsigned old = xb_add(&bar[XB_XSUB(b.x)], 1u);
        const unsigned gen = old / nloc;
        if (old + 1u == (gen + 1u) * nloc) {
            __builtin_amdgcn_fence(__ATOMIC_RELEASE, "agent");
            asm volatile("s_waitcnt vmcnt(0)" ::: "memory");
            const unsigned og = xb_add(&bar[XB_TOP], 1u);
            const unsigned tg = og / nx;
            if (og + 1u == (tg + 1u) * nx) xb_add(&bar[XB_TOPGEN], 1u);
            else XB_SPIN(xb_ld(&bar[XB_TOPGEN]) == tg, bar);
            __builtin_amdgcn_fence(__ATOMIC_ACQUIRE, "agent");
            xb_add(&bar[XB_XGEN(b.x)], 1u);
            asm volatile("s_waitcnt vmcnt(0)" ::: "memory");
        } else {
            XB_SPIN(xb_ld(&bar[XB_XGEN(b.x)]) == gen, bar);
            __builtin_amdgcn_fence(__ATOMIC_ACQUIRE, "agent");
            asm volatile("s_waitcnt vmcnt(0)" ::: "memory");
        }
    }
    __syncthreads();
}

namespace pg8 {
constexpr int BM = 256, BK = 64, HALF = 128, HTB = HALF * BK * 2, STAGE_BYTES = 8 * HTB, NXCD = 8, WGM = 8;
__host__ __device__ __forceinline__ int lds_byte(int r, int c) { const int st = (r >> 4) * 2 + (c >> 5), rr = r & 15, cc = c & 31, ob = rr * 64 + cc * 2; return st * 1024 + (ob ^ (((ob >> 9) & 1) << 5)); }
__host__ __device__ __forceinline__ void stage_rc(int b, int& R, int& C) { const int st = b / 1024, sb = b % 1024, swz = sb ^ (((sb >> 9) & 1) << 5); R = (st >> 1) * 16 + swz / 64; C = (st & 1) * 32 + (swz % 64) / 2; }
__host__ __device__ __forceinline__ int perm32(int rho) { const int n = rho >> 4, i = rho & 15; return 8 * (i >> 2) + 4 * n + (i & 3); }
struct Unit { int pm, pn; const char* A; const char* B; };
struct Shape { int K, pitchA, pitchB; };
__device__ __forceinline__ unsigned cvt_pk_bf16(float lo, float hi) { unsigned r; asm volatile("v_cvt_pk_bf16_f32 %0, %1, %2" : "=v"(r) : "v"(lo), "v"(hi)); return r; }

template <class Epi, class Sched, bool ALIGN_EPI = true>
__device__ __forceinline__ void gemm_phase(LAS unsigned char* lds, const Shape g, const Sched& S, const Epi& E) {
    int tid_ = threadIdx.x; asm volatile("" : "+v"(tid_));
    const int tid = tid_, wid = __builtin_amdgcn_readfirstlane(tid >> 6), lane = tid & 63, wr = wid >> 2, wc = wid & 3, fr = lane & 15, fq = lane >> 4;
    const int K = g.K, nt = K / BK;
    unsigned voffA[2], voffB[2];
#pragma unroll
    for (int i = 0; i < 2; ++i) { int R, C; stage_rc(tid * 16 + i * 8192, R, C); const int Rb = Epi::PERM ? ((R & ~31) + perm32(R & 31)) : R;
        voffA[i] = (unsigned)(R * g.pitchA + C) * 2u; voffB[i] = (unsigned)(Rb * g.pitchB + C) * 2u; }
    const size_t kstep = (size_t)(BK * 2);
    const size_t hstepA = (size_t)HALF * g.pitchA * 2, hstepB = (size_t)HALF * g.pitchB * 2;
    const unsigned ldsw = (unsigned)wid * 1024u;
    const int aoff = lds_byte(wr * 64 + fr, fq * 8), boff = lds_byte(wc * 32 + fr, fq * 8);
#define PG8_SA(b, h) (((b) * 2 + (h)) * HTB)
#define PG8_SB(b, h) ((4 + (b) * 2 + (h)) * HTB)
#define PG8_STAGE(bufoff, gbase, voff) do { _Pragma("unroll") for (int _i = 0; _i < 2; ++_i) \
        __builtin_amdgcn_global_load_lds((const unsigned*)((const char*)(gbase) + (voff)[_i]), (LAS unsigned*)(lds + (bufoff) + ldsw + _i * 8192), 16, 0, 0); } while (0)
#define PG8_LDA(dst, b, h) do { _Pragma("unroll") for (int m = 0; m < 4; ++m) _Pragma("unroll") for (int k = 0; k < 2; ++k) dst[m][k] = *(const LAS bf16x8*)(lds + PG8_SA(b, h) + aoff + m * 2048 + k * 1024); } while (0)
#define PG8_LDB(dst, b, h) do { _Pragma("unroll") for (int n = 0; n < 2; ++n) _Pragma("unroll") for (int k = 0; k < 2; ++k) dst[n][k] = *(const LAS bf16x8*)(lds + PG8_SB(b, h) + boff + n * 2048 + k * 1024); } while (0)
#define PG8_MMA(ai, bj, At, Bt) do { __builtin_amdgcn_s_setprio(1); _Pragma("unroll") for (int m = 0; m < 4; ++m) _Pragma("unroll") for (int n = 0; n < 2; ++n) _Pragma("unroll") for (int k = 0; k < 2; ++k) \
        acc[ai][bj][m][n] = __builtin_amdgcn_mfma_f32_16x16x32_bf16(Bt[n][k], At[m][k], acc[ai][bj][m][n], 0, 0, 0); __builtin_amdgcn_s_setprio(0); } while (0)
#define PG8_WAIT_V(n) asm volatile("s_waitcnt vmcnt(" #n ")" ::: "memory")
#define PG8_WAIT_L(n) asm volatile("s_waitcnt lgkmcnt(" #n ")" ::: "memory")
#define PG8_BAR __builtin_amdgcn_s_barrier()
#define PG8_SCHED __builtin_amdgcn_sched_barrier(0)
    Unit cur, nxt; int ui = 0;
    if (!S.next(0, cur)) return;
    f32x4 acc[2][2][4][2];
#pragma unroll
    for (int a = 0; a < 2; ++a)
#pragma unroll
        for (int b = 0; b < 2; ++b)
#pragma unroll
            for (int m = 0; m < 4; ++m)
#pragma unroll
                for (int n = 0; n < 2; ++n) acc[a][b][m][n] = (f32x4){0.f, 0.f, 0.f, 0.f};
    bf16x8 At[4][2], B0[2][2], B1[2][2];
    const char* cA = cur.A; const char* cB = cur.B;
    PG8_STAGE(PG8_SB(0, 0), cB, voffB); PG8_STAGE(PG8_SB(0, 1), cB + hstepB, voffB); PG8_STAGE(PG8_SA(0, 0), cA, voffA); PG8_STAGE(PG8_SA(0, 1), cA + hstepA, voffA);
    if (wr == 1) PG8_BAR;
    PG8_WAIT_V(2); PG8_BAR;
    PG8_STAGE(PG8_SB(1, 0), cB + kstep, voffB); PG8_STAGE(PG8_SA(1, 0), cA + kstep, voffA); PG8_STAGE(PG8_SB(1, 1), cB + hstepB + kstep, voffB);
    PG8_WAIT_V(6); PG8_BAR;
    for (;;) {
        const bool has_next = S.next(ui + 1, nxt);
        const char* nA = has_next ? nxt.A : cA; const char* nB = has_next ? nxt.B : cB;
        for (int t = 0; t < nt; t += 2) {
            const bool last = (t == nt - 2);
            const char* a1 = cA + (size_t)(t + 1) * kstep;
            const char* a2 = last ? nA : cA + (size_t)(t + 2) * kstep; const char* b2 = last ? nB : cB + (size_t)(t + 2) * kstep;
            const char* a3 = a2 + kstep; const char* b3 = b2 + kstep;
            PG8_LDB(B0, 0, 0); PG8_LDB(B1, 0, 1); PG8_SCHED; PG8_LDA(At, 0, 0); PG8_STAGE(PG8_SA(1, 1), a1 + hstepA, voffA);
            PG8_WAIT_V(8); PG8_WAIT_L(0); PG8_BAR; PG8_MMA(0, 0, At, B0); PG8_MMA(0, 1, At, B1); PG8_BAR; PG8_SCHED;
            PG8_LDA(At, 0, 1); PG8_STAGE(PG8_SB(0, 0), b2, voffB); PG8_STAGE(PG8_SB(0, 1), b2 + hstepB, voffB); PG8_STAGE(PG8_SA(0, 0), a2, voffA);
            PG8_WAIT_V(8); PG8_WAIT_L(0); PG8_BAR; PG8_MMA(1, 0, At, B0); PG8_MMA(1, 1, At, B1); PG8_BAR; PG8_SCHED;
            PG8_LDB(B0, 1, 0); PG8_LDB(B1, 1, 1); PG8_SCHED; PG8_LDA(At, 1, 0); PG8_STAGE(PG8_SA(0, 1), a2 + hstepA, voffA);
            PG8_WAIT_V(8); PG8_WAIT_L(0); PG8_BAR; PG8_MMA(0, 0, At, B0); PG8_MMA(0, 1, At, B1); PG8_BAR; PG8_SCHED;
            PG8_LDA(At, 1, 1); PG8_STAGE(PG8_SB(1, 0), b3, voffB); PG8_STAGE(PG8_SB(1, 1), b3 + hstepB, voffB); PG8_STAGE(PG8_SA(1, 0), a3, voffA);
            PG8_WAIT_V(8); PG8_WAIT_L(0); PG8_BAR; PG8_MMA(1, 0, At, B0); PG8_MMA(1, 1, At, B1); PG8_BAR; PG8_SCHED;
        }
        if constexpr (ALIGN_EPI) { if (wr == 0) PG8_BAR; }
        E(acc, cur, wr, wc, fr, fq);
        if (!has_next) break;
#pragma unroll
        for (int a = 0; a < 2; ++a)
#pragma unroll
            for (int b = 0; b < 2; ++b)
#pragma unroll
                for (int m = 0; m < 4; ++m)
#pragma unroll
                    for (int n = 0; n < 2; ++n) acc[a][b][m][n] = (f32x4){0.f, 0.f, 0.f, 0.f};
        cur = nxt; cA = nA; cB = nB; ++ui;
        if constexpr (ALIGN_EPI) { if (wr == 1) PG8_BAR; }
    }
    PG8_WAIT_V(0);
    if constexpr (!ALIGN_EPI) { if (wr == 0) PG8_BAR; }
    PG8_BAR;
#undef PG8_SA
#undef PG8_SB
#undef PG8_STAGE
#undef PG8_LDA
#undef PG8_LDB
#undef PG8_MMA
#undef PG8_WAIT_V
#undef PG8_WAIT_L
#undef PG8_BAR
#undef PG8_SCHED
}

template <class Epi, class Sched>
__device__ __forceinline__ void gemm_phase_ref(const Shape g, const Sched& S, const Epi& E) {
    const int tid = threadIdx.x, wid = __builtin_amdgcn_readfirstlane(tid >> 6), lane = tid & 63, wr = wid >> 2, wc = wid & 3, fr = lane & 15, fq = lane >> 4;
    Unit u;
    for (int it = 0; S.next(it, u); ++it) {
        f32x4 acc[2][2][4][2];
#pragma unroll
        for (int a = 0; a < 2; ++a)
#pragma unroll
            for (int b = 0; b < 2; ++b)
#pragma unroll
                for (int m = 0; m < 4; ++m)
#pragma unroll
                    for (int n = 0; n < 2; ++n) acc[a][b][m][n] = (f32x4){0.f, 0.f, 0.f, 0.f};
#pragma unroll
        for (int ai = 0; ai < 2; ++ai) {
            for (int k8 = 0; k8 < g.K / 8; ++k8) {
                float a[4][8];
#pragma unroll
                for (int m = 0; m < 4; ++m) { const u32x4 w = *(const u32x4*)(u.A + ((size_t)(ai * 128 + wr * 64 + m * 16 + fr) * g.pitchA + k8 * 8) * 2);
                    a[m][0] = bflo(w.x); a[m][1] = bfhi(w.x); a[m][2] = bflo(w.y); a[m][3] = bfhi(w.y); a[m][4] = bflo(w.z); a[m][5] = bfhi(w.z); a[m][6] = bflo(w.w); a[m][7] = bfhi(w.w); }
#pragma unroll
                for (int bj = 0; bj < 2; ++bj)
#pragma unroll
                    for (int n = 0; n < 2; ++n)
#pragma unroll
                        for (int ii = 0; ii < 4; ++ii) {
                            const int col = bj * 128 + wc * 32 + (Epi::PERM ? 8 * fq + 4 * n + ii : 16 * n + 4 * fq + ii);
                            const u32x4 w = *(const u32x4*)(u.B + ((size_t)col * g.pitchB + k8 * 8) * 2);
                            const float b0 = bflo(w.x), b1 = bfhi(w.x), b2 = bflo(w.y), b3 = bfhi(w.y), b4 = bflo(w.z), b5 = bfhi(w.z), b6 = bflo(w.w), b7 = bfhi(w.w);
#pragma unroll
                            for (int m = 0; m < 4; ++m)
                                acc[ai][bj][m][n][ii] += a[m][0] * b0 + a[m][1] * b1 + a[m][2] * b2 + a[m][3] * b3 + a[m][4] * b4 + a[m][5] * b5 + a[m][6] * b6 + a[m][7] * b7;
                        }
            }
        }
        E(acc, u, wr, wc, fr, fq);
    }
}
}

struct Args { const float* in[28]; float* out; unsigned char* ws; int ph_lo, ph_hi; };
struct Frame {
    LAS unsigned char* lds; unsigned* ctl; unsigned char* ws;
    int tid, lane, wave, G, vcu;
    const float* in[28]; float* out;
};
#define LDS_WAIT() asm volatile("s_waitcnt lgkmcnt(0)" ::: "memory")

template <class RowMap>
__device__ __forceinline__ void p0_transpose_item(const float* W, int K, int N, bf16_t* WT, RowMap rowmap, LAS float* scr, int item, int lane) {
    const int nblk = N / 32, kb = item / nblk, nb = item % nblk, k0 = 64 * kb, n0 = 32 * nb;
#pragma unroll 8
    for (int i = 0; i < 32; ++i) { const int kk = 2 * i + (lane >> 5); scr[kk * 33 + (lane & 31)] = W[(size_t)(k0 + kk) * N + n0 + (lane & 31)]; }
    LDS_WAIT(); asm volatile("" ::: "memory");
    const int c = lane & 7;
#pragma unroll
    for (int j = 0; j < 4; ++j) { const int n = (lane >> 3) + 8 * j; const LAS float* s = scr + (8 * c) * 33 + n;
        u32x4 o; o.x = pk2(s[0 * 33], s[1 * 33]); o.y = pk2(s[2 * 33], s[3 * 33]); o.z = pk2(s[4 * 33], s[5 * 33]); o.w = pk2(s[6 * 33], s[7 * 33]);
        *(u32x4*)(WT + (size_t)rowmap(n0 + n) * K + k0 + 8 * c) = o; }
    LDS_WAIT(); asm volatile("" ::: "memory");
}
struct RmId { __device__ int operator()(int n) const { return n; } };
struct RmW1 { __device__ int operator()(int j) const { return (j >> 2) * 8 + (j & 3); } };
struct RmW3 { __device__ int operator()(int j) const { return (j >> 2) * 8 + 4 + (j & 3); } };

__device__ __forceinline__ void p0_prologue(Frame& F) {
    unsigned char* ws = F.ws;
    LAS float* scr = (LAS float*)(F.lds + F.wave * 16384);
    const int gw = F.vcu * NWAVES + F.wave, NGW = F.G * NWAVES;
    constexpr int I_WIN = 16 * 80, I_SQ = 16 * 32, I_W13 = 16 * 16, I_W2 = 8 * 32;
    constexpr int N0 = I_WIN, N1 = N0 + I_SQ, N2 = N1 + I_SQ, N3 = N2 + 2 * NE * I_W13  , N4 = N3 + 2 * NE * I_W13  , N5 = N4 + 2 * NE * I_W2;
    for (int it = gw; it < N5; it += NGW) {
        if (it < N0) { p0_transpose_item(F.in[8], D, INE, (bf16_t*)(ws + WS_WIN), RmId(), scr, it, F.lane); continue; }
        if (it < N1) { p0_transpose_item(F.in[18], D, D, (bf16_t*)(ws + WS_WOUT), RmId(), scr, it - N0, F.lane); continue; }
        if (it < N2) { p0_transpose_item(F.in[19], D, D, (bf16_t*)(ws + WS_ODW), RmId(), scr, it - N1, F.lane); continue; }
        if (it < N3) { const int r = it - N2, le = r / I_W13, l = le / NE, e = le % NE;
            p0_transpose_item(F.in[25] + (size_t)le * D * FF, D, FF, (bf16_t*)(ws + WS_MOEW + l * MOEW_LAYER) + (size_t)e * D * D, RmW1(), scr, r % I_W13, F.lane); continue; }
        if (it < N4) { const int r = it - N3, le = r / I_W13, l = le / NE, e = le % NE;
            p0_transpose_item(F.in[26] + (size_t)le * D * FF, D, FF, (bf16_t*)(ws + WS_MOEW + l * MOEW_LAYER) + (size_t)e * D * D, RmW3(), scr, r % I_W13, F.lane); continue; }
        { const int r = it - N4, le = r / I_W2, l = le / NE, e = le % NE;
            p0_transpose_item(F.in[27] + (size_t)le * FF * D, FF, D, (bf16_t*)(ws + WS_MOEW + l * MOEW_LAYER + MOEW_W2) + (size_t)e * D * FF, RmId(), scr, r % I_W2, F.lane); }
    }
    const int gt = F.vcu * NTHREADS + F.tid, NGT = F.G * NTHREADS;
    { bf16_t* gwt = (bf16_t*)(ws + WS_GATEW);
      for (int i = gt; i < 2 * 2 * 8 * 64 * 64; i += NGT) { const int k = i & 63, n = (i >> 6) & 63, h = (i >> 12) & 7, t = (i >> 15) & 1, d = i >> 16;
          const float* w = t ? F.in[13] : F.in[11]; gwt[i] = (bf16_t)f2bf(w[(((size_t)d * 8 + h) * 64 + k) * 64 + n]); } }
    { bf16_t* wrt = (bf16_t*)(ws + WS_MISC + MISC_WRT);
      for (int i = gt; i < 2 * 48 * 1024; i += NGT) { const int k = i & 1023, n = (i >> 10) % 48, l = i / (48 * 1024);
          const float w = n < 4 ? F.in[21][((size_t)l * D + k) * 4 + n] : n < 36 ? F.in[23][((size_t)l * D + k) * 32 + (n - 4)] : 0.f;
          const unsigned hi = f2bf(w); const unsigned lo = f2bf(w - bf2f(hi));
          wrt[((size_t)(l * 2 + 0) * 48 + n) * 1024 + k] = (bf16_t)hi; wrt[((size_t)(l * 2 + 1) * 48 + n) * 1024 + k] = (bf16_t)lo; } }
    { float* rope = (float*)(ws + WS_ROPE);
      for (int i = gt; i < 64 * 16; i += NGT) { const int f = i & 15, pos = i >> 4; const float freq = powf(10000.f, -(float)f / 16.f); const float ang = (float)pos * freq;
          rope[i * 2] = (float)cos((double)ang); rope[i * 2 + 1] = (float)sin((double)ang); }
      float* sm = (float*)(ws + WS_SMALL);
      for (int i = gt; i < 2 * LW; i += NGT) { const float l = F.in[15][i]; sm[64 + i] = (-l > 20.f) ? -l : log1pf(expf(-l)); }
      if (blockIdx.x == 0 && F.wave == 0) { const float* dl = F.in[16]; const float a = wave_sum(dl[F.lane] * dl[64 + F.lane]), b = wave_sum(dl[128 + F.lane] * dl[192 + F.lane]);
          if (F.lane == 0) sm[0] = expf(a) - expf(b) + 0.2f; } }
    __syncthreads();
    { LAS float* tab = (LAS float*)F.lds;
      for (int i = F.tid; i < 4096; i += NTHREADS) tab[i] = (float)cos(2.0 * 3.14159265358979323846 * (double)i / 4096.0);
      __syncthreads();
      bf16_t* cd = (bf16_t*)(ws + WS_CDFT);
      for (int i = gt; i < 512 * 256; i += NGT) { const int c = i & 255, m = i >> 8; const int j = ((m & 255) * c) & 255; cd[i] = (bf16_t)f2bf(m < 256 ? tab[j * 16] : tab[(j * 16 + 3072) & 4095]); }
      bf16_t* cm = (bf16_t*)(ws + WS_CMAT);
      for (int i8 = gt; i8 < 4096 * 8192 / 8; i8 += NGT) { const int m = i8 >> 10, k0 = (i8 & 1023) * 8; unsigned w[4];
#pragma unroll
          for (int q = 0; q < 4; ++q) { float v[2];
#pragma unroll
              for (int e = 0; e < 2; ++e) { const int k = k0 + 2 * q + e, kk = k & 4095, j = (m * kk) & 4095; v[e] = k < 4096 ? tab[j] : -tab[(j + 3072) & 4095]; }
              w[q] = pk2(v[0], v[1]); }
          *(u32x4*)(cm + (size_t)i8 * 8) = (u32x4){w[0], w[1], w[2], w[3]}; }
      __syncthreads(); }
    { LAS float* sc = (LAS float*)F.lds;
      LAS float* red = sc + 9 * 1024;
      for (int i = F.tid; i < 9 * 1024; i += NTHREADS) { const int r = i >> 10, k = i & 1023; const float v = r < 8 ? F.in[1][r * D + k] : F.in[3][k]; sc[i] = v / (1.f + expf(-v)); }
      __syncthreads();
      float* mods = (float*)(ws + WS_MODS);
      for (int u = F.vcu; u < 2 * 96; u += F.G) { const int l = u / 96, n0 = (u % 96) * 64, col = F.tid & 63, kc = F.tid >> 6;
          float a9[9];
#pragma unroll
          for (int r = 0; r < 9; ++r) a9[r] = 0.f;
          const float* w = F.in[4] + ((size_t)l * D + kc * 128) * 6144 + n0 + col;
          for (int k = 0; k < 128; ++k) { const float wv = w[(size_t)k * 6144];
#pragma unroll
              for (int r = 0; r < 9; ++r) a9[r] += sc[r * 1024 + kc * 128 + k] * wv; }
#pragma unroll
          for (int r = 0; r < 9; ++r) red[(kc * 9 + r) * 64 + col] = a9[r];
          __syncthreads();
          for (int i = F.tid; i < 9 * 64; i += NTHREADS) { const int r = i >> 6, c = i & 63; float s = 0.f;
#pragma unroll
              for (int q = 0; q < 8; ++q) s += red[(q * 9 + r) * 64 + c];
              mods[((size_t)l * 9 + r) * 6144 + n0 + c] = s + F.in[5][l * 6144 + n0 + c]; }
          __syncthreads(); } }
}

__device__ __forceinline__ void ln_stats(f32x4 (&v)[4], float& mean, float& rstd) {
    float s = 0.f;
#pragma unroll
    for (int j = 0; j < 4; ++j) s += (v[j].x + v[j].y) + (v[j].z + v[j].w);
    mean = wave_sum(s) * (1.f / D); float q = 0.f;
#pragma unroll
    for (int j = 0; j < 4; ++j) { const f32x4 d = v[j] - mean; q += (d.x * d.x + d.y * d.y) + (d.z * d.z + d.w * d.w); }
    rstd = 1.f / sqrtf(wave_sum(q) * (1.f / D) + LN_EPS);
}
__device__ __forceinline__ void p1_lnmod(Frame& F) {
    const int gw = F.vcu * NWAVES + F.wave, NGW = F.G * NWAVES; const float* mods = (const float*)(F.ws + WS_MODS); bf16_t* H = (bf16_t*)(F.ws + WS_R0);
    for (int row = gw; row < MALL; row += NGW) {
        const float* src = row < NLAT ? F.in[0] + (size_t)row * D : F.in[2] + (size_t)(row - NLAT) * D; const int r = row < NLAT ? (row >> 12) : 8;
        f32x4 v[4];
#pragma unroll
        for (int j = 0; j < 4; ++j) v[j] = ((const f32x4*)src)[F.lane + 64 * j];
        float mean, rstd; ln_stats(v, mean, rstd);
        const f32x4* sh = (const f32x4*)(mods + (size_t)r * 6144); const f32x4* sc = (const f32x4*)(mods + (size_t)r * 6144 + 1024);
#pragma unroll
        for (int j = 0; j < 4; ++j) { const f32x4 a = sh[F.lane + 64 * j], b = sc[F.lane + 64 * j]; const f32x4 o = (v[j] - mean) * rstd * (b + 1.f) + a;
            ((u32x2*)(H + (size_t)row * D))[F.lane + 64 * j] = (u32x2){pk2(o.x, o.y), pk2(o.z, o.w)}; }
    }
}
constexpr int RT_PITCH = 2064;
__device__ __forceinline__ void row_phase_a(Frame& F, int layer, const float* xin, const float* bias) {
    const float* mods = (const float*)(F.ws + WS_MODS) + (size_t)layer * 9 * 6144;
    const float* Y = (const float*)(F.ws + WS_R1); bf16_t* T = (bf16_t*)(F.ws + WS_R0); float* X = F.out;
    const float* lg = F.in[6] + (size_t)(layer * 2) * D; const float* lb = F.in[7] + (size_t)(layer * 2) * D;
    const float* bg = F.in[22] + layer * 4; const float* bfp = F.in[24] + layer * 32;
    const bf16_t* WRT = (const bf16_t*)(F.ws + WS_MISC + MISC_WRT) + (size_t)layer * 2 * 48 * 1024;
    int* eidx = (int*)(F.ws + WS_MISC + MISC_EIDX); float* ew = (float*)(F.ws + WS_MISC + MISC_EW); unsigned* cnt = F.ctl + CW_CNT + layer * 128;
    unsigned* bcnt = (unsigned*)(F.ws + WS_MISC + MISC_BCNT);
    LAS unsigned char* lds = F.lds; LAS unsigned char* TH = lds; LAS unsigned char* TL = lds + 32 * RT_PITCH;
    LAS float* PART = (LAS float*)lds; LAS float* LOG = (LAS float*)(lds + 8 * 32 * 48 * 4);
    LAS unsigned* hist = (LAS unsigned*)(lds + LDSCTL_OFF + LC_HIST);
    const int lane = F.lane, wid = F.wave, fr = lane & 15, fq = lane >> 4;
    if (F.tid < 32) hist[F.tid] = 0u;
    __syncthreads();
    const int TPB = (NLAT / 32) / F.G;
    for (int ti = 0; ti < TPB; ++ti) { const int tile = (int)blockIdx.x * TPB + ti;
#pragma unroll 1
        for (int i = 0; i < 4; ++i) { const int rl = wid * 4 + i, row = tile * 32 + rl; const int b = row >> 12; const float* mr = mods + (size_t)b * 6144;
            f32x4 v[4];
#pragma unroll
            for (int j = 0; j < 4; ++j) { const int q = lane + 64 * j; f32x4 y = ((const f32x4*)(Y + (size_t)row * D))[q]; if (bias) y = y + ((const f32x4*)bias)[q];
                v[j] = ((const f32x4*)(xin + (size_t)row * D))[q] * ALPHA + ((const f32x4*)(mr + 2 * 1024))[q] * y; }
            float mean, rstd; ln_stats(v, mean, rstd);
#pragma unroll
            for (int j = 0; j < 4; ++j) { const int q = lane + 64 * j; v[j] = (v[j] - mean) * rstd * ((const f32x4*)lg)[q] + ((const f32x4*)lb)[q]; ((f32x4*)(X + (size_t)row * D))[q] = v[j]; }
            ln_stats(v, mean, rstd);
#pragma unroll
            for (int j = 0; j < 4; ++j) { const int q = lane + 64 * j; const f32x4 t = (v[j] - mean) * rstd * (((const f32x4*)(mr + 4 * 1024))[q] + 1.f) + ((const f32x4*)(mr + 3 * 1024))[q];
                const unsigned h0 = f2bf(t.x), h1 = f2bf(t.y), h2 = f2bf(t.z), h3 = f2bf(t.w);
                const u32x2 hw = (u32x2){h0 | (h1 << 16), h2 | (h3 << 16)};
                const u32x2 lw = (u32x2){pk2(t.x - bf2f(h0), t.y - bf2f(h1)), pk2(t.z - bf2f(h2), t.w - bf2f(h3))};
                ((u32x2*)(T + (size_t)row * D))[q] = hw;
                *(LAS u32x2*)(TH + rl * RT_PITCH + q * 8) = hw; *(LAS u32x2*)(TL + rl * RT_PITCH + q * 8) = lw; } }
        __syncthreads();
        f32x4 acc[2][3];
#pragma unroll
        for (int mt = 0; mt < 2; ++mt)
#pragma unroll
            for (int nt = 0; nt < 3; ++nt) acc[mt][nt] = (f32x4){0.f, 0.f, 0.f, 0.f};
#pragma unroll
        for (int ks = 0; ks < 4; ++ks) { const int k0 = wid * 128 + ks * 32 + 8 * fq;
            bf16x8 ah[2], al[2], bh[3], bl[3];
#pragma unroll
            for (int mt = 0; mt < 2; ++mt) { ah[mt] = *(const LAS bf16x8*)(TH + (16 * mt + fr) * RT_PITCH + k0 * 2); al[mt] = *(const LAS bf16x8*)(TL + (16 * mt + fr) * RT_PITCH + k0 * 2); }
#pragma unroll
            for (int nt = 0; nt < 3; ++nt) { bh[nt] = *(const bf16x8*)(WRT + (size_t)(16 * nt + fr) * 1024 + k0); bl[nt] = *(const bf16x8*)(WRT + (size_t)(48 + 16 * nt + fr) * 1024 + k0); }
#pragma unroll
            for (int mt = 0; mt < 2; ++mt)
#pragma unroll
                for (int nt = 0; nt < 3; ++nt) {
                    acc[mt][nt] = __builtin_amdgcn_mfma_f32_16x16x32_bf16(ah[mt], bh[nt], acc[mt][nt], 0, 0, 0);
                    acc[mt][nt] = __builtin_amdgcn_mfma_f32_16x16x32_bf16(ah[mt], bl[nt], acc[mt][nt], 0, 0, 0);
                    acc[mt][nt] = __builtin_amdgcn_mfma_f32_16x16x32_bf16(al[mt], bh[nt], acc[mt][nt], 0, 0, 0); } }
        __syncthreads();
#pragma unroll
        for (int mt = 0; mt < 2; ++mt)
#pragma unroll
            for (int nt = 0; nt < 3; ++nt)
#pragma unroll
                for (int reg = 0; reg < 4; ++reg) PART[(wid * 32 + 16 * mt + 4 * fq + reg) * 48 + 16 * nt + fr] = acc[mt][nt][reg];
        __syncthreads();
        for (int idx = F.tid; idx < 32 * 36; idx += NTHREADS) { const int r = idx / 36, o = idx - r * 36; float sacc = o < 4 ? bg[o] : bfp[o - 4];
#pragma unroll
            for (int w = 0; w < 8; ++w) sacc += PART[(w * 32 + r) * 48 + o];
            LOG[r * 36 + o] = sacc; }
        __syncthreads();
        if (F.tid < 32) { const int r = F.tid, row = tile * 32 + r; const LAS float* L = LOG + r * 36;
            const float g0 = L[0], g1 = L[1], g2 = L[2], g3 = L[3];
            int gi = 0; float gm = g0;
            if (g1 > gm) { gm = g1; gi = 1; }
            if (g2 > gm) { gm = g2; gi = 2; }
            if (g3 > gm) { gm = g3; gi = 3; }
            const float pg = 1.f / (expf(g0 - gm) + expf(g1 - gm) + expf(g2 - gm) + expf(g3 - gm));
            int i0 = 0; float v0 = -INFINITY; int i1 = 0; float v1 = -INFINITY;
#pragma unroll
            for (int j = 0; j < 8; ++j) { const float vv = L[4 + gi * 8 + j];
                if (vv > v0) { v1 = v0; i1 = i0; v0 = vv; i0 = j; } else if (vv > v1) { v1 = vv; i1 = j; } }
            const float e1 = expf(v1 - v0); const float w0 = 1.f / (1.f + e1), w1 = e1 / (1.f + e1);
            const int ea = gi * 8 + i0, eb = gi * 8 + i1; eidx[row * 2] = ea; eidx[row * 2 + 1] = eb; ew[row * 2] = w0 * pg; ew[row * 2 + 1] = w1 * pg;
            __hip_atomic_fetch_add(hist + ea, 1u, __ATOMIC_RELAXED, __HIP_MEMORY_SCOPE_WORKGROUP); __hip_atomic_fetch_add(hist + eb, 1u, __ATOMIC_RELAXED, __HIP_MEMORY_SCOPE_WORKGROUP); }
        __syncthreads();
    }
    if (F.tid < 32) { const unsigned c = hist[F.tid]; atomicAdd(cnt + F.tid, c); bcnt[(size_t)blockIdx.x * 32 + F.tid] = c; }
}
__device__ __forceinline__ void row_phase_b(Frame& F, int layer, bool make_h) {
    const int gw = F.vcu * NWAVES + F.wave, NGW = F.G * NWAVES; const float* mods = (const float*)(F.ws + WS_MODS) + (size_t)layer * 9 * 6144;
    const float* modn = (const float*)(F.ws + WS_MODS) + (size_t)(layer + 1) * 9 * 6144;
    const bf16_t* MO = (const bf16_t*)(F.ws + WS_R1); bf16_t* H = (bf16_t*)(F.ws + WS_R0); float* X = F.out;
    const float* lg = F.in[6] + (size_t)(layer * 2 + 1) * D; const float* lb = F.in[7] + (size_t)(layer * 2 + 1) * D;
    for (int row = gw; row < NLAT; row += NGW) {
        const int b = row >> 12; const float* mr = mods + (size_t)b * 6144;
        f32x4 v[4];
#pragma unroll
        for (int j = 0; j < 4; ++j) { const int q = F.lane + 64 * j; const u32x2 m0 = ((const u32x2*)(MO + (size_t)row * D))[q], m1 = ((const u32x2*)(MO + ((size_t)NLAT + row) * D))[q];
            const f32x4 m = (f32x4){bflo(m0.x) + bflo(m1.x), bfhi(m0.x) + bfhi(m1.x), bflo(m0.y) + bflo(m1.y), bfhi(m0.y) + bfhi(m1.y)};
            v[j] = ((const f32x4*)(X + (size_t)row * D))[q] * ALPHA + ((const f32x4*)(mr + 5 * 1024))[q] * m; }
        float mean, rstd; ln_stats(v, mean, rstd);
#pragma unroll
        for (int j = 0; j < 4; ++j) { const int q = F.lane + 64 * j; v[j] = (v[j] - mean) * rstd * ((const f32x4*)lg)[q] + ((const f32x4*)lb)[q]; ((f32x4*)(X + (size_t)row * D))[q] = v[j]; }
        if (make_h) { const float* mn = modn + (size_t)b * 6144;
            ln_stats(v, mean, rstd);
#pragma unroll
            for (int j = 0; j < 4; ++j) { const int q = F.lane + 64 * j; const f32x4 o = (v[j] - mean) * rstd * (((const f32x4*)(mn + 1024))[q] + 1.f) + ((const f32x4*)mn)[q];
                ((u32x2*)(H + (size_t)row * D))[q] = (u32x2){pk2(o.x, o.y), pk2(o.z, o.w)}; } }
    }
}

__device__ __forceinline__ void moe_tile_prefix(Frame& F, int layer) {
    volatile LAS int* ts = (volatile LAS int*)(F.lds + LDSCTL_OFF + LC_TSTART);
    if (F.tid == 0) { int acc = 0; for (int e = 0; e < NE; ++e) { ts[e] = acc; acc += (int)((xb_ld(F.ctl + CW_CNT + layer * 128 + e) + 255u) >> 8); } ts[NE] = acc; }
    __syncthreads();
}
__device__ __forceinline__ void moe_positions(Frame& F, int layer) {
    moe_tile_prefix(F, layer);
    const LAS int* ts = (const LAS int*)(F.lds + LDSCTL_OFF + LC_TSTART);
    const int* eidx = (const int*)(F.ws + WS_MISC + MISC_EIDX); int* rowtok = (int*)(F.ws + WS_MISC + MISC_ROWTOK);
    const unsigned* bcnt = (const unsigned*)(F.ws + WS_MISC + MISC_BCNT); unsigned* cnt = F.ctl + CW_CNT + layer * 128;
    const bf16_t* T = (const bf16_t*)(F.ws + WS_R0); bf16_t* TS = (bf16_t*)(F.ws + WS_R1);
    LAS unsigned* part = (LAS unsigned*)F.lds;
    LAS unsigned* base = (LAS unsigned*)(F.lds + LDSCTL_OFF + LC_BASE); LAS unsigned* lcur = (LAS unsigned*)(F.lds + LDSCTL_OFF + LC_LCUR); LAS int* posl = (LAS int*)(F.lds + LDSCTL_OFF + LC_POS);
    const int blk = (int)blockIdx.x, APB = (2 * NLAT) / F.G;
    { const int e = F.tid & 31, p = F.tid >> 5; unsigned sacc = 0u; for (int bb = p; bb < blk; bb += 16) sacc += bcnt[(size_t)bb * 32 + e]; part[p * 32 + e] = sacc; }
    __syncthreads();
    if (F.tid < 32) { unsigned sacc = 0u;
#pragma unroll
        for (int p = 0; p < 16; ++p) sacc += part[p * 32 + F.tid];
        base[F.tid] = (unsigned)ts[F.tid] * 256u + sacc; lcur[F.tid] = 0u; }
    __syncthreads();
    for (int al = F.tid; al < APB; al += NTHREADS) { const int a = blk * APB + al; const int e = eidx[a];
        const int pos = (int)(base[e] + __hip_atomic_fetch_add(lcur + e, 1u, __ATOMIC_RELAXED, __HIP_MEMORY_SCOPE_WORKGROUP)); rowtok[pos] = a; posl[al] = pos; }
    __syncthreads();
    for (int al = F.wave; al < APB; al += NWAVES) { const int pj = posl[al]; const int tok = (blk * APB + al) >> 1;
        const u32x4* sp = (const u32x4*)(T + (size_t)tok * D); u32x4* dp = (u32x4*)(TS + (size_t)pj * D);
        dp[F.lane] = sp[F.lane]; dp[64 + F.lane] = sp[64 + F.lane]; }
    const int gt = F.vcu * NTHREADS + F.tid;
    if (gt < NE * 256) { const int e = gt >> 8, r = gt & 255; const int c = (int)xb_ld(cnt + e); const int padded = (c + 255) & ~255; if (c + r < padded) rowtok[ts[e] * 256 + c + r] = -1; }
    __syncthreads();
}

struct DenseOrder {
    int nM, nN, nwg, G, c; const char* A; const char* B; size_t strideA, strideB;
    __device__ void init(int nM_, int nN_, int G_, int c_, const void* A_, size_t sA, const void* B_, size_t sB) { nM = nM_; nN = nN_; nwg = nM * nN; G = G_; c = c_; A = (const char*)A_; B = (const char*)B_; strideA = sA; strideB = sB; }
    __device__ bool next(int i, pg8::Unit& u) const {
        const long L = (long)i * G + c; if (L >= nwg) return false;
        int wgid = (int)L; { const int q = nwg / 8, r = nwg % 8, xcd = wgid % 8, off = wgid / 8; wgid = (xcd < r ? xcd * (q + 1) : r * (q + 1) + (xcd - r) * q) + off; }
        const int nig = 8 * nN, gid = wgid / nig, fm = gid * 8, gsz = (nM - fm) < 8 ? (nM - fm) : 8;
        u.pm = fm + ((wgid % nig) % gsz); u.pn = (wgid % nig) / gsz; u.A = A + (size_t)u.pm * strideA; u.B = B + (size_t)u.pn * strideB; return true;
    }
};
struct MoeOrder {
    const LAS int* ts; int G, c; const char* A; const char* W; size_t strideA, strideE, strideN;
    __device__ bool next(int i, pg8::Unit& u) const {
        const int L = i * G + c; const int ntile = ts[NE]; if (L >= ntile * 4) return false;
        const int rt = L >> 2, pn = L & 3; int e = 0;
#pragma unroll 1
        for (int q = 1; q < NE; ++q) e += (ts[q] <= rt) ? 1 : 0;
        u.pm = rt; u.pn = pn; u.A = A + (size_t)rt * strideA; u.B = W + (size_t)e * strideE + (size_t)pn * strideN; return true;
    }
};
struct ChanDftOrder {
    int G, c; const char* A; const char* H;
    __device__ bool next(int i, pg8::Unit& u) const {
        const int L = i * G + c; if (L >= 1024) return false;
        const int nt = L >> 3, g = (L >> 1) & 3, mt = L & 1;
        u.pm = g * 2 + mt; u.pn = nt; u.A = A + (size_t)mt * 256 * 256 * 2; u.B = H + ((size_t)nt * 256 * D + g * 256) * 2; return true;
    }
};
struct SeqDftOrder {
    int G, c; const char* A; const char* GT;
    __device__ bool next(int i, pg8::Unit& u) const {
        const int L = i * G + c; if (L >= 512) return false;
        const int pn = L & 3, mt = (L >> 2) & 15, b = L >> 6;
        u.pm = b * 16 + mt; u.pn = pn; u.A = A + (size_t)mt * 256 * 8192 * 2; u.B = GT + ((size_t)(b * 1024 + pn * 256) * 8192) * 2; return true;
    }
};

struct EpiInProj {
    static constexpr bool PERM = true;
    bf16_t *GX, *QB, *KB, *VB; const float* rope;
    __device__ __forceinline__ void operator()(const f32x4 (&acc)[2][2][4][2], const pg8::Unit& u, int wr, int wc, int fr, int fq) const {
        const int region = u.pn >> 1, cb = (u.pn & 1) * 256 + wc * 32 + 8 * fq; const bool latent = u.pm < (NLAT / 256);
        const bool dorope = latent && (region == 2 || region == 3); const int axis = wc & 1, half = fq >> 1, f0 = 8 * (fq & 1);
        if (region == 2 && !latent) return;
#pragma unroll
        for (int ai = 0; ai < 2; ++ai)
#pragma unroll
            for (int m = 0; m < 4; ++m) { const int row = u.pm * 256 + ai * 128 + wr * 64 + m * 16 + fr;
#pragma unroll
                for (int bj = 0; bj < 2; ++bj) { const int c = cb + bj * 128; float v[8];
#pragma unroll
                    for (int i = 0; i < 4; ++i) { v[i] = acc[ai][bj][m][0][i]; v[4 + i] = acc[ai][bj][m][1][i]; }
                    if (dorope) { const int tn = row & 4095, pos = axis ? (tn & 63) : (tn >> 6); const f32x4* cs = (const f32x4*)(rope + (size_t)(pos * 16 + f0) * 2);
                        const f32x4 c0 = cs[0], c1 = cs[1], c2 = cs[2], c3 = cs[3];
                        const float co[8] = {c0.x, c0.z, c1.x, c1.z, c2.x, c2.z, c3.x, c3.z}, si[8] = {c0.y, c0.w, c1.y, c1.w, c2.y, c2.w, c3.y, c3.w};
#pragma unroll
                        for (int i = 0; i < 8; ++i) { const float pv = __shfl_xor(v[i], 32); v[i] = v[i] * co[i] + (half ? pv : -pv) * si[i]; } }
                    if (region == 2) {
#pragma unroll
                        for (int i = 0; i < 8; ++i) v[i] *= QSCALE; }
                    const u32x4 w = (u32x4){pg8::cvt_pk_bf16(v[0], v[1]), pg8::cvt_pk_bf16(v[2], v[3]), pg8::cvt_pk_bf16(v[4], v[5]), pg8::cvt_pk_bf16(v[6], v[7])};
                    bf16_t* dst = region == 0 ? GX + (size_t)row * D + c : region == 1 ? GX + (size_t)row * D + 512 + c : region == 2 ? QB + (size_t)row * 512 + c : region == 3 ? KB + (size_t)row * 512 + c : VB + (size_t)row * 512 + c;
                    *(u32x4*)dst = w; } }
    }
};
struct EpiF32 {
    static constexpr bool PERM = false;
    float* C;
    __device__ __forceinline__ void operator()(const f32x4 (&acc)[2][2][4][2], const pg8::Unit& u, int wr, int wc, int fr, int fq) const {
        const int row0 = u.pm * 256 + wr * 64 + fr, col0 = u.pn * 256 + wc * 32 + 4 * fq;
#pragma unroll
        for (int ai = 0; ai < 2; ++ai)
#pragma unroll
            for (int m = 0; m < 4; ++m) { float* rowp = C + (size_t)(row0 + ai * 128 + m * 16) * D + col0;
#pragma unroll
                for (int bj = 0; bj < 2; ++bj)
#pragma unroll
                    for (int n = 0; n < 2; ++n) *(f32x4*)(rowp + bj * 128 + n * 16) = acc[ai][bj][m][n]; }
    }
};
struct EpiSwiGLU {
    static constexpr bool PERM = true;
    bf16_t* HID;
    __device__ __forceinline__ void operator()(const f32x4 (&acc)[2][2][4][2], const pg8::Unit& u, int wr, int wc, int fr, int fq) const {
        const int cb = u.pn * 256 + wc * 32 + 8 * fq;
#pragma unroll
        for (int ai = 0; ai < 2; ++ai)
#pragma unroll
            for (int m = 0; m < 4; ++m) { const int row = u.pm * 256 + ai * 128 + wr * 64 + m * 16 + fr;
#pragma unroll
                for (int bj = 0; bj < 2; ++bj) { const int j0 = ((cb + bj * 128) >> 3) * 4; const f32x4 a = acc[ai][bj][m][0], b = acc[ai][bj][m][1];
                    const float h0 = silu_f(a[0]) * b[0], h1 = silu_f(a[1]) * b[1], h2 = silu_f(a[2]) * b[2], h3 = silu_f(a[3]) * b[3];
                    *(u32x2*)(HID + (size_t)row * FF + j0) = (u32x2){pg8::cvt_pk_bf16(h0, h1), pg8::cvt_pk_bf16(h2, h3)}; } }
    }
};
struct EpiScatter {
    static constexpr bool PERM = true;
    bf16_t* MOUT; const int* rowtok; const float* ew;
    __device__ __forceinline__ void operator()(const f32x4 (&acc)[2][2][4][2], const pg8::Unit& u, int wr, int wc, int fr, int fq) const {
        const int cb = u.pn * 256 + wc * 32 + 8 * fq;
#pragma unroll
        for (int ai = 0; ai < 2; ++ai)
#pragma unroll
            for (int m = 0; m < 4; ++m) { const int row = u.pm * 256 + ai * 128 + wr * 64 + m * 16 + fr; const int a = rowtok[row];
                if (a >= 0) { const float w = ew[a]; bf16_t* dst = MOUT + ((size_t)(a & 1) * NLAT + (a >> 1)) * D + cb;
#pragma unroll
                    for (int bj = 0; bj < 2; ++bj) { const f32x4 x = acc[ai][bj][m][0] * w, y = acc[ai][bj][m][1] * w;
                        *(u32x4*)(dst + bj * 128) = (u32x4){pg8::cvt_pk_bf16(x[0], x[1]), pg8::cvt_pk_bf16(x[2], x[3]), pg8::cvt_pk_bf16(y[0], y[1]), pg8::cvt_pk_bf16(y[2], y[3])}; } } }
    }
};
struct EpiGT {
    static constexpr bool PERM = true;
    bf16_t* GT;
    __device__ __forceinline__ void operator()(const f32x4 (&acc)[2][2][4][2], const pg8::Unit& u, int wr, int wc, int fr, int fq) const {
        const int g = u.pm >> 1, mt = u.pm & 1; const int nb = u.pn * 256 + wc * 32 + 8 * fq;
#pragma unroll
        for (int ai = 0; ai < 2; ++ai)
#pragma unroll
            for (int m = 0; m < 4; ++m) { const int mrow = mt * 256 + ai * 128 + wr * 64 + m * 16 + fr; const int chan = g * 256 + (mrow & 255), part = mrow >> 8;
#pragma unroll
                for (int bj = 0; bj < 2; ++bj) { const int n = nb + bj * 128, b = n >> 12, nl = n & 4095; const f32x4 x = acc[ai][bj][m][0], y = acc[ai][bj][m][1];
                    *(u32x4*)(GT + ((size_t)(b * 1024 + chan) * 8192) + part * 4096 + nl) = (u32x4){pg8::cvt_pk_bf16(x[0], x[1]), pg8::cvt_pk_bf16(x[2], x[3]), pg8::cvt_pk_bf16(y[0], y[1]), pg8::cvt_pk_bf16(y[2], y[3])}; } }
    }
};
struct EpiBf16S {
    static constexpr bool PERM = true;
    bf16_t* O; float scale;
    __device__ __forceinline__ void operator()(const f32x4 (&acc)[2][2][4][2], const pg8::Unit& u, int wr, int wc, int fr, int fq) const {
        const int cb = u.pn * 256 + wc * 32 + 8 * fq;
#pragma unroll
        for (int ai = 0; ai < 2; ++ai)
#pragma unroll
            for (int m = 0; m < 4; ++m) { const int row = u.pm * 256 + ai * 128 + wr * 64 + m * 16 + fr;
#pragma unroll
                for (int bj = 0; bj < 2; ++bj) { const f32x4 x = acc[ai][bj][m][0] * scale, y = acc[ai][bj][m][1] * scale;
                    *(u32x4*)(O + (size_t)row * D + cb + bj * 128) = (u32x4){pg8::cvt_pk_bf16(x[0], x[1]), pg8::cvt_pk_bf16(x[2], x[3]), pg8::cvt_pk_bf16(y[0], y[1]), pg8::cvt_pk_bf16(y[2], y[3])}; } }
    }
};
template <class Epi, class Sched> __device__ __forceinline__ void run_gemm(Frame& F, const pg8::Shape g, const Sched& S, const Epi& E) {
#if FAST_GEMM
    pg8::Shape gg = g; asm volatile("" : "+s"(gg.K));
    pg8::gemm_phase<Epi, Sched, true>(F.lds, gg, S, E);
#else
    pg8::gemm_phase_ref<Epi, Sched>(g, S, E);
#endif
}

__device__ __forceinline__ void lru_simple(Frame& F, int b) {
    const bf16_t* GX = (const bf16_t*)(F.ws + WS_R1 + R1_GX); bf16_t* CAT = (bf16_t*)(F.ws + WS_R0); float* YF = (float*)(F.ws + WS_R2);
    const float* cw = F.in[9]; const float* cbp = F.in[10]; const float* sp = (const float*)(F.ws + WS_SMALL) + 64;
    LAS bf16_t* wl = (LAS bf16_t*)F.lds;
    LAS float* xs = (LAS float*)(F.lds + LDSCTL_OFF + LC_XS);
    const int c = F.tid, h = c >> 6, j = c & 63;
    const float w0 = cw[c], w1 = cw[LW + c], w2 = cw[2 * LW + c], w3 = cw[3 * LW + c], cb = cbp[c];
    for (int d = 0; d < 2; ++d) {
        __syncthreads();
        for (int i = F.tid; i < 2 * 8 * 64 * 64; i += NTHREADS) { const int jj = i & 63, ii = (i >> 6) & 63, hh = (i >> 12) & 7, t = i >> 15; const float* w = t ? F.in[13] : F.in[11];
            wl[i] = (bf16_t)f2bf(w[(((size_t)d * 8 + hh) * 64 + ii) * 64 + jj]); }
        __syncthreads();
        const float ba = F.in[12][d * LW + c], bx = F.in[14][d * LW + c], spc = sp[d * LW + c];
        float hst = 0.f;
        for (int step = 0; step < CTX + SEQ; ++step) {
            const bool isctx = step < CTX; const int n = isctx ? (d == 0 ? step : CTX - 1 - step) : (d == 0 ? step - CTX : SEQ - 1 - (step - CTX));
            const int len = isctx ? CTX : SEQ; const size_t row0 = isctx ? (size_t)NLAT + (size_t)b * CTX : (size_t)b * SEQ;
            float xc = cb;
            if (n - 2 >= 0) xc += bf2f(GX[(row0 + n - 2) * D + 512 + c]) * w0;
            if (n - 1 >= 0) xc += bf2f(GX[(row0 + n - 1) * D + 512 + c]) * w1;
            xc += bf2f(GX[(row0 + n) * D + 512 + c]) * w2;
            if (n + 1 < len) xc += bf2f(GX[(row0 + n + 1) * D + 512 + c]) * w3;
            __syncthreads();
            xs[c] = bf2f(f2bf(xc));
            __syncthreads();
            float ra = 0.f, rx = 0.f;
            for (int i = 0; i < 64; ++i) { const float xv = xs[h * 64 + i]; ra += xv * bf2f(wl[((0 * 8 + h) * 64 + i) * 64 + j]); rx += xv * bf2f(wl[((1 * 8 + h) * 64 + i) * 64 + j]); }
            const float r = sigmoid_f(ra + ba), ig = sigmoid_f(rx + bx);
            const float log_a = -8.f * spc * r; const float a = expf(log_a); const float mult = sqrtf(-expm1f(2.f * log_a));
            hst = a * hst + mult * ig * xc;
            if (!isctx) { const size_t o = ((size_t)b * SEQ + n) * LW + c;
                if (d == 0) YF[o] = hst;
                else { const float g = bf2f(GX[((size_t)b * SEQ + n) * D + c]); CAT[((size_t)b * SEQ + n) * D + c] = (bf16_t)f2bf((YF[o] + hst) * gelu_tanh_f(g)); } }
        }
    }
    __syncthreads();
}

__device__ __forceinline__ void attn_simple(Frame& F) {
    const bf16_t* QB = (const bf16_t*)(F.ws + WS_R1 + R1_QB); const bf16_t* KB = (const bf16_t*)(F.ws + WS_R1 + R1_KB); const bf16_t* VB = (const bf16_t*)(F.ws + WS_R1 + R1_VB);
    bf16_t* CAT = (bf16_t*)(F.ws + WS_R0); const float lam = ((const float*)(F.ws + WS_SMALL))[0]; const float* subln = F.in[17];
    LAS float* Qs = (LAS float*)F.lds;
    LAS float* Ks = Qs + 64 * 128;
    LAS float* Vs = Ks + 64 * 129;
    LAS float* Ps = Vs + 64 * 128;
    const int lane = F.lane, wv = F.wave;
    for (int u = F.vcu; u < NB * NH * (SEQ / 64); u += F.G) {
        const int qb = u & 63, h = (u >> 6) & 3, b = u >> 8;
        __syncthreads();
        for (int i = F.tid; i < 64 * 128; i += NTHREADS) { const int r = i >> 7, cc = i & 127; Qs[i] = bf2f(QB[((size_t)b * SEQ + qb * 64 + r) * 512 + h * 128 + cc]); }
        float m1[8], m2[8], l1[8], l2[8], o1a[8], o1b[8], o2a[8], o2b[8];
#pragma unroll
        for (int r = 0; r < 8; ++r) { m1[r] = -INFINITY; m2[r] = -INFINITY; l1[r] = 0.f; l2[r] = 0.f; o1a[r] = 0.f; o1b[r] = 0.f; o2a[r] = 0.f; o2b[r] = 0.f; }
        for (int pass = 0; pass < 2; ++pass) {
            for (int t = 0; t < (CTX + SEQ) / 64; ++t) {
                const size_t krow0 = t < 4 ? (size_t)NLAT + (size_t)b * CTX + t * 64 : (size_t)b * SEQ + (t - 4) * 64;
                __syncthreads();
                for (int i = F.tid; i < 64 * 128; i += NTHREADS) { const int r = i >> 7, cc = i & 127; Ks[r * 129 + cc] = bf2f(KB[(krow0 + r) * 512 + h * 128 + cc]); Vs[i] = bf2f(VB[(krow0 + r) * 512 + h * 128 + cc]); }
                __syncthreads();
#pragma unroll
                for (int r = 0; r < 8; ++r) {
                    const LAS float* q = Qs + (wv * 8 + r) * 128; const LAS float* k = Ks + lane * 129;
                    float s1 = 0.f, s2 = 0.f;
                    for (int dd = 0; dd < 64; ++dd) { s1 += q[dd] * k[dd]; s2 += q[64 + dd] * k[64 + dd]; }
                    if (pass == 0) { m1[r] = fmaxf(m1[r], s1); m2[r] = fmaxf(m2[r], s2); }
                    else {
                        const float p1 = exp2f(s1 - m1[r]), p2 = exp2f(s2 - m2[r]);
                        l1[r] += p1; l2[r] += p2;
                        Ps[(wv * 2 + 0) * 64 + lane] = p1; Ps[(wv * 2 + 1) * 64 + lane] = p2;
                        LDS_WAIT(); asm volatile("" ::: "memory");
                        float a0 = 0.f, a1 = 0.f, c0 = 0.f, c1 = 0.f;
                        for (int kk = 0; kk < 64; ++kk) { const float pp1 = Ps[(wv * 2 + 0) * 64 + kk], pp2 = Ps[(wv * 2 + 1) * 64 + kk]; const float va = Vs[kk * 128 + lane], vb = Vs[kk * 128 + 64 + lane];
                            a0 += pp1 * va; a1 += pp1 * vb; c0 += pp2 * va; c1 += pp2 * vb; }
                        o1a[r] += a0; o1b[r] += a1; o2a[r] += c0; o2b[r] += c1;
                        LDS_WAIT(); asm volatile("" ::: "memory");
                    }
                }
            }
            if (pass == 0) {
#pragma unroll
                for (int r = 0; r < 8; ++r) { m1[r] = wave_max(m1[r]); m2[r] = wave_max(m2[r]); }
            }
        }
#pragma unroll
        for (int r = 0; r < 8; ++r) {
            const float L1 = wave_sum(l1[r]), L2 = wave_sum(l2[r]);
            const float oa = o1a[r] / L1 - lam * o2a[r] / L2, ob = o1b[r] / L1 - lam * o2b[r] / L2;
            const float ms = wave_sum(oa * oa + ob * ob) * (1.f / 128.f); const float rs = 1.f / sqrtf(ms + LN_EPS);
            bf16_t* dst = CAT + ((size_t)b * SEQ + qb * 64 + wv * 8 + r) * D + 512 + h * 128;
            dst[lane] = (bf16_t)f2bf(oa * rs * subln[lane] * 0.8f); dst[64 + lane] = (bf16_t)f2bf(ob * rs * subln[64 + lane] * 0.8f);
        }
    }
    __syncthreads();
}

namespace att {
typedef float f32x16 __attribute__((ext_vector_type(16)));
typedef short s16x4 __attribute__((ext_vector_type(4)));
typedef short v4i16_t __attribute__((ext_vector_type(4)));
constexpr int KSLOT = 8192, VSLOT = 16384, NSLOT = 3, NT = (CTX + SEQ) / 64;
constexpr int L_K = 0, L_V = NSLOT * KSLOT, L_WS = L_V + NSLOT * VSLOT;
__device__ __forceinline__ int crow(int r, int hi) { return (r & 3) + 8 * (r >> 2) + 4 * hi; }
#define ATT_WAITBAR(N) asm volatile("s_waitcnt vmcnt(" #N ") lgkmcnt(0)\n\ts_barrier" ::: "memory")
__device__ __forceinline__ unsigned cvtpk(float lo, float hi) { unsigned r; asm("v_cvt_pk_bf16_f32 %0, %1, %2" : "=v"(r) : "v"(lo), "v"(hi)); return r; }
__device__ __forceinline__ s16x4 vtr(const LAS unsigned char* p) { return __builtin_bit_cast(s16x4, __builtin_amdgcn_ds_read_tr16_b64_v4i16((LAS v4i16_t*)p)); }

__device__ __forceinline__ void attn_fast(Frame& F) {
    const bf16_t* QB = (const bf16_t*)(F.ws + WS_R1 + R1_QB); const bf16_t* KB = (const bf16_t*)(F.ws + WS_R1 + R1_KB); const bf16_t* VB = (const bf16_t*)(F.ws + WS_R1 + R1_VB);
    bf16_t* CAT = (bf16_t*)(F.ws + WS_R0); const float lam = ((const float*)(F.ws + WS_SMALL))[0]; const float* subln = F.in[17];
    LAS unsigned char* lds = F.lds;
    const int lane = F.lane, r32 = lane & 31, hi = lane >> 5, wid = F.wave;
    LAS float* wsf = (LAS float*)(lds + L_WS) + wid * 64;
    for (int u = F.vcu; u < NB * NH * (SEQ / 256); u += F.G) {
        const int bh = u >> 4, qb = u & 15, b = bh >> 2, h = bh & 3;
        const size_t qrow = (size_t)b * SEQ + qb * 256 + wid * 32;
        unsigned o2p[4][8];
        f32x16 o[4];
#pragma unroll 1
        for (int pass = 0; pass < 2; ++pass) {
            const int s = 1 - pass;
            bf16x8 qf[4];
#pragma unroll
            for (int d0 = 0; d0 < 4; ++d0) qf[d0] = *(const bf16x8*)(QB + (qrow + r32) * 512 + h * 128 + s * 64 + d0 * 16 + hi * 8);
#pragma unroll
            for (int dq = 0; dq < 4; ++dq)
#pragma unroll
                for (int r = 0; r < 16; ++r) o[dq][r] = 0.f;
            float lsum = 0.f;
            const bf16_t* ksrc = KB + (size_t)lane * 512 + h * 128 + s * 64 + wid * 8;
            const bf16_t* vsrc0 = VB + (size_t)(16 * ((wid * 2) & 3) + (lane >> 2)) * 512 + h * 128 + ((wid * 2) >> 2) * 32 + (lane & 3) * 8;
            const bf16_t* vsrc1 = VB + (size_t)(16 * ((wid * 2 + 1) & 3) + (lane >> 2)) * 512 + h * 128 + ((wid * 2 + 1) >> 2) * 32 + (lane & 3) * 8;
#define ATT_DMA(t, slot) do { const size_t r0_ = ((t) < 4 ? (size_t)NLAT + (size_t)b * CTX + (t) * 64 : (size_t)b * SEQ + ((t) - 4) * 64) * 512; \
        __builtin_amdgcn_global_load_lds((const unsigned*)(ksrc + r0_), (LAS unsigned*)(lds + L_K + (slot) * KSLOT + wid * 1024), 16, 0, 0); \
        __builtin_amdgcn_global_load_lds((const unsigned*)(vsrc0 + r0_), (LAS unsigned*)(lds + L_V + (slot) * VSLOT + (wid * 2) * 1024), 16, 0, 0); \
        __builtin_amdgcn_global_load_lds((const unsigned*)(vsrc1 + r0_), (LAS unsigned*)(lds + L_V + (slot) * VSLOT + (wid * 2 + 1) * 1024), 16, 0, 0); } while (0)
            ATT_DMA(0, 0); ATT_DMA(1, 1);
            ATT_WAITBAR(3);
            int slot = 0;
#pragma unroll 1
            for (int t = 0; t < NT; ++t) {
                const int s2 = slot == 0 ? 2 : slot - 1;
                if (t + 2 < NT) ATT_DMA(t + 2, s2);
                f32x16 p0, p1;
#pragma unroll
                for (int r = 0; r < 16; ++r) { p0[r] = 0.f; p1[r] = 0.f; }
                const LAS unsigned char* kb = lds + L_K + slot * KSLOT + hi * 1024 + r32 * 16;
#pragma unroll
                for (int d0 = 0; d0 < 4; ++d0) {
                    const bf16x8 k0 = *(const LAS bf16x8*)(kb + d0 * 2048), k1 = *(const LAS bf16x8*)(kb + d0 * 2048 + 512);
                    p0 = __builtin_amdgcn_mfma_f32_32x32x16_bf16(k0, qf[d0], p0, 0, 0, 0);
                    p1 = __builtin_amdgcn_mfma_f32_32x32x16_bf16(k1, qf[d0], p1, 0, 0, 0);
                }
                float sa = 0.f, sb = 0.f;
#pragma unroll
                for (int r = 0; r < 16; ++r) { p0[r] = __builtin_amdgcn_exp2f(p0[r]); p1[r] = __builtin_amdgcn_exp2f(p1[r]); sa += p0[r]; sb += p1[r]; }
                lsum += sa + sb;
                u32x4 pk[4];
#pragma unroll
                for (int i = 0; i < 4; ++i) { pk[0][i] = cvtpk(p0[2 * i], p0[2 * i + 1]); pk[1][i] = cvtpk(p0[8 + 2 * i], p0[8 + 2 * i + 1]); pk[2][i] = cvtpk(p1[2 * i], p1[2 * i + 1]); pk[3][i] = cvtpk(p1[8 + 2 * i], p1[8 + 2 * i + 1]); }
                const LAS unsigned char* vb = lds + L_V + slot * VSLOT + ((lane >> 4) & 1) * 32 + (lane & 3) * 8 + (4 * hi + ((lane & 15) >> 2)) * 64;
#pragma unroll
                for (int dq = 0; dq < 4; ++dq)
#pragma unroll
                    for (int ks = 0; ks < 4; ++ks) {
                        const s16x4 vlo = vtr(vb + dq * 4096 + ks * 1024), vhi = vtr(vb + dq * 4096 + ks * 1024 + 512);
                        const bf16x8 vf = (bf16x8){vlo[0], vlo[1], vlo[2], vlo[3], vhi[0], vhi[1], vhi[2], vhi[3]};
                        o[dq] = __builtin_amdgcn_mfma_f32_32x32x16_bf16(__builtin_bit_cast(bf16x8, pk[ks]), vf, o[dq], 0, 0, 0);
                    }
                if (t + 2 < NT) ATT_WAITBAR(3); else ATT_WAITBAR(0);
                slot = slot == 2 ? 0 : slot + 1;
            }
#undef ATT_DMA
            { auto rr = __builtin_amdgcn_permlane32_swap(__float_as_uint(lsum), __float_as_uint(lsum), false, false); lsum = __uint_as_float(rr[0]) + __uint_as_float(rr[1]); }
            if (hi == 0) wsf[r32] = 1.0f / lsum;
            asm volatile("s_waitcnt lgkmcnt(0)" ::: "memory");
            float rl[16];
#pragma unroll
            for (int r = 0; r < 16; ++r) rl[r] = wsf[crow(r, hi)];
            asm volatile("s_waitcnt lgkmcnt(0)" ::: "memory");
            if (pass == 0) {
#pragma unroll
                for (int dq = 0; dq < 4; ++dq)
#pragma unroll
                    for (int i = 0; i < 8; ++i) o2p[dq][i] = cvtpk(lam * o[dq][2 * i] * rl[2 * i], lam * o[dq][2 * i + 1] * rl[2 * i + 1]);
            } else {
#pragma unroll
                for (int dq = 0; dq < 4; ++dq)
#pragma unroll
                    for (int r = 0; r < 16; ++r) o[dq][r] *= rl[r];
            }
        }
        float ss[16];
#pragma unroll
        for (int r = 0; r < 16; ++r) ss[r] = 0.f;
#pragma unroll
        for (int dq = 0; dq < 4; ++dq)
#pragma unroll
            for (int i = 0; i < 8; ++i) { const unsigned w = o2p[dq][i]; o[dq][2 * i] -= bflo(w); o[dq][2 * i + 1] -= bfhi(w); ss[2 * i] += o[dq][2 * i] * o[dq][2 * i]; ss[2 * i + 1] += o[dq][2 * i + 1] * o[dq][2 * i + 1]; }
#pragma unroll
        for (int r = 0; r < 16; ++r) {
#pragma unroll
            for (int off = 1; off < 32; off <<= 1) ss[r] += __shfl_xor(ss[r], off);
            ss[r] = 0.8f / sqrtf(ss[r] * (1.f / 128.f) + LN_EPS);
        }
#pragma unroll
        for (int dq = 0; dq < 4; ++dq) { const float g = subln[dq * 32 + r32];
#pragma unroll
            for (int r = 0; r < 16; ++r) CAT[(qrow + crow(r, hi)) * D + 512 + h * 128 + dq * 32 + r32] = (bf16_t)f2bf(o[dq][r] * ss[r] * g); }
    }
    asm volatile("s_waitcnt vmcnt(0) lgkmcnt(0)\n\ts_barrier" ::: "memory");
}
}

namespace lru {
constexpr int NCHUNK = 68, XCB_PITCH = 272;
constexpr int L_XCB = 0, L_XCF = 17408, L_Y0 = L_XCF + 33280, L_Y1 = L_Y0 + 33280, L_HIN = L_Y1 + 33280;
template <int K> __device__ __forceinline__ float dpp_shr(float v, float ident) { return __int_as_float(__builtin_amdgcn_update_dpp(__float_as_int(ident), __float_as_int(v), 0x110 + K, 0xf, 0xf, false)); }
template <int K> __device__ __forceinline__ float dpp_shl(float v, float ident) { return __int_as_float(__builtin_amdgcn_update_dpp(__float_as_int(ident), __float_as_int(v), 0x100 + K, 0xf, 0xf, false)); }
__device__ __forceinline__ float rcp_f(float x) { return __builtin_amdgcn_rcpf(x); }
__device__ __forceinline__ float sigm(float x) { return rcp_f(1.f + __expf(-x)); }

template <int MODE>
__device__ __forceinline__ void lru_unit(Frame& F, int b, int chunk, int quarter) {
    const bf16_t* GX = (const bf16_t*)(F.ws + WS_R1 + R1_GX); bf16_t* CAT = (bf16_t*)(F.ws + WS_R0);
    const bf16_t* GW = (const bf16_t*)(F.ws + WS_GATEW); const float* SP = (const float*)(F.ws + WS_SMALL) + 64; float* SUMM = (float*)(F.ws + WS_MISC + MISC_SUMM);
    LAS unsigned char* lds = F.lds; const int tid = F.tid, lane = F.lane, wid = F.wave;
    const bool isctx = chunk < 4; const int tok0 = isctx ? chunk * 64 : (chunk - 4) * 64, len = isctx ? CTX : SEQ; const size_t row0 = isctx ? (size_t)NLAT + (size_t)b * CTX : (size_t)b * SEQ;
    { const int cp = tid & 63, tg = tid >> 6, c0 = quarter * 128 + 2 * cp;
      const float w00 = F.in[9][c0], w01 = F.in[9][c0 + 1], w10 = F.in[9][LW + c0], w11 = F.in[9][LW + c0 + 1], w20 = F.in[9][2 * LW + c0], w21 = F.in[9][2 * LW + c0 + 1], w30 = F.in[9][3 * LW + c0], w31 = F.in[9][3 * LW + c0 + 1];
      const float cb0 = F.in[10][c0], cb1 = F.in[10][c0 + 1];
      unsigned x[11];
#pragma unroll
      for (int i = 0; i < 11; ++i) { const int n = tok0 + 8 * tg - 2 + i; x[i] = (n >= 0 && n < len) ? *(const unsigned*)(GX + (row0 + n) * D + 512 + c0) : 0u; }
#pragma unroll
      for (int i = 0; i < 8; ++i) { const int tl = 8 * tg + i;
          const float a0 = cb0 + bflo(x[i]) * w00 + bflo(x[i + 1]) * w10 + bflo(x[i + 2]) * w20 + bflo(x[i + 3]) * w30;
          const float a1 = cb1 + bfhi(x[i]) * w01 + bfhi(x[i + 1]) * w11 + bfhi(x[i + 2]) * w21 + bfhi(x[i + 3]) * w31;
          *(LAS unsigned*)(lds + L_XCB + tl * XCB_PITCH + cp * 4) = pk2(a0, a1);
          ((LAS float*)(lds + L_XCF))[(2 * cp) * 65 + tl] = a0; ((LAS float*)(lds + L_XCF))[(2 * cp + 1) * 65 + tl] = a1; } }
    if (MODE == 1) {
        if (tid < 256) { const int d = tid >> 7, cl = tid & 127, c = quarter * 128 + cl; const float* S = SUMM + ((size_t)(b * 2 + d) * NCHUNK) * 1024 + c; float hcar = 0.f;
            if (d == 0) { for (int j = 0; j < chunk; ++j) hcar = S[(size_t)j * 1024] * hcar + S[(size_t)j * 1024 + 512]; }
            else { for (int j = 3; j >= 0; --j) hcar = S[(size_t)j * 1024] * hcar + S[(size_t)j * 1024 + 512];
                   for (int j = NCHUNK - 1; j > chunk; --j) hcar = S[(size_t)j * 1024] * hcar + S[(size_t)j * 1024 + 512]; }
            ((LAS float*)(lds + L_HIN))[tid] = hcar; } }
    __syncthreads();
    { const int pr = wid >> 1, d = pr & 1, hl = pr >> 1, h = quarter * 2 + hl, fr = lane & 15, fq = lane >> 4;
      bf16x8 bfr[4][2];
#pragma unroll
      for (int nt = 0; nt < 4; ++nt)
#pragma unroll
          for (int ks = 0; ks < 2; ++ks) bfr[nt][ks] = *(const LAS bf16x8*)(lds + L_XCB + (16 * nt + fr) * XCB_PITCH + (hl * 64 + 32 * ks + 8 * fq) * 2);
      const LAS float* xcf = (const LAS float*)(lds + L_XCF); LAS float* Yd = (LAS float*)(lds + (d ? L_Y1 : L_Y0));
#pragma unroll 1
      for (int mi = 0; mi < 2; ++mi) { const int mt = (wid & 1) * 2 + mi;
          f32x4 acc[2][4];
#pragma unroll
          for (int t = 0; t < 2; ++t) { bf16x8 af[2];
#pragma unroll
              for (int ks = 0; ks < 2; ++ks) af[ks] = *(const bf16x8*)(GW + ((((size_t)(d * 2 + t) * 8 + h) * 64 + 16 * mt + fr) * 64 + 32 * ks + 8 * fq));
#pragma unroll
              for (int nt = 0; nt < 4; ++nt) { acc[t][nt] = (f32x4){0.f, 0.f, 0.f, 0.f};
#pragma unroll
                  for (int ks = 0; ks < 2; ++ks) acc[t][nt] = __builtin_amdgcn_mfma_f32_16x16x32_bf16(af[ks], bfr[nt][ks], acc[t][nt], 0, 0, 0); } }
#pragma unroll
          for (int reg = 0; reg < 4; ++reg) { const int cl = hl * 64 + 16 * mt + 4 * fq + reg, c = quarter * 128 + cl;
              const float ba = F.in[12][d * LW + c], bx = F.in[14][d * LW + c], spc = SP[d * LW + c];
              float A[4], Bv[4];
#pragma unroll
              for (int nt = 0; nt < 4; ++nt) { const float xcv = xcf[cl * 65 + 16 * nt + fr];
                  const float r = sigm(acc[0][nt][reg] + ba), ig = sigm(acc[1][nt][reg] + bx);
                  const float la = -8.f * spc * r, a = __expf(la), x2 = 2.f * la;
                  const float m2 = x2 > -0.3f ? -x2 * (1.f + x2 * (0.5f + x2 * (1.f / 6.f + x2 * (1.f / 24.f + x2 * (1.f / 120.f + x2 * (1.f / 720.f + x2 * (1.f / 5040.f))))))) : 1.f - __expf(x2);
                  A[nt] = a; Bv[nt] = sqrtf(m2) * ig * xcv; }
              if (d == 0) {
#pragma unroll
                  for (int nt = 0; nt < 4; ++nt) {
                      { const float ap = dpp_shr<1>(A[nt], 1.f), bp = dpp_shr<1>(Bv[nt], 0.f); Bv[nt] = A[nt] * bp + Bv[nt]; A[nt] *= ap; }
                      { const float ap = dpp_shr<2>(A[nt], 1.f), bp = dpp_shr<2>(Bv[nt], 0.f); Bv[nt] = A[nt] * bp + Bv[nt]; A[nt] *= ap; }
                      { const float ap = dpp_shr<4>(A[nt], 1.f), bp = dpp_shr<4>(Bv[nt], 0.f); Bv[nt] = A[nt] * bp + Bv[nt]; A[nt] *= ap; }
                      { const float ap = dpp_shr<8>(A[nt], 1.f), bp = dpp_shr<8>(Bv[nt], 0.f); Bv[nt] = A[nt] * bp + Bv[nt]; A[nt] *= ap; } }
                  if (MODE == 0) { float Ac = 1.f, Bc = 0.f;
#pragma unroll
                      for (int nt = 0; nt < 4; ++nt) { const float At = __shfl(A[nt], (lane & 48) | 15), Bt = __shfl(Bv[nt], (lane & 48) | 15); Bc = At * Bc + Bt; Ac *= At; }
                      if (fr == 0) { float* S = SUMM + ((size_t)(b * 2 + d) * NCHUNK + chunk) * 1024 + c; S[0] = Ac; S[512] = Bc; } }
                  else { float hc = ((const LAS float*)(lds + L_HIN))[d * 128 + cl];
#pragma unroll
                      for (int nt = 0; nt < 4; ++nt) { const float hv = A[nt] * hc + Bv[nt]; Yd[cl * 65 + 16 * nt + fr] = hv; hc = __shfl(hv, (lane & 48) | 15); } }
              } else {
#pragma unroll
                  for (int nt = 0; nt < 4; ++nt) {
                      { const float ap = dpp_shl<1>(A[nt], 1.f), bp = dpp_shl<1>(Bv[nt], 0.f); Bv[nt] = A[nt] * bp + Bv[nt]; A[nt] *= ap; }
                      { const float ap = dpp_shl<2>(A[nt], 1.f), bp = dpp_shl<2>(Bv[nt], 0.f); Bv[nt] = A[nt] * bp + Bv[nt]; A[nt] *= ap; }
                      { const float ap = dpp_shl<4>(A[nt], 1.f), bp = dpp_shl<4>(Bv[nt], 0.f); Bv[nt] = A[nt] * bp + Bv[nt]; A[nt] *= ap; }
                      { const float ap = dpp_shl<8>(A[nt], 1.f), bp = dpp_shl<8>(Bv[nt], 0.f); Bv[nt] = A[nt] * bp + Bv[nt]; A[nt] *= ap; } }
                  if (MODE == 0) { float Ac = 1.f, Bc = 0.f;
#pragma unroll
                      for (int nt = 3; nt >= 0; --nt) { const float At = __shfl(A[nt], lane & 48), Bt = __shfl(Bv[nt], lane & 48); Bc = At * Bc + Bt; Ac *= At; }
                      if (fr == 0) { float* S = SUMM + ((size_t)(b * 2 + d) * NCHUNK + chunk) * 1024 + c; S[0] = Ac; S[512] = Bc; } }
                  else { float hc = ((const LAS float*)(lds + L_HIN))[d * 128 + cl];
#pragma unroll
                      for (int nt = 3; nt >= 0; --nt) { const float hv = A[nt] * hc + Bv[nt]; Yd[cl * 65 + 16 * nt + fr] = hv; hc = __shfl(hv, lane & 48); } }
              }
          } } }
    __syncthreads();
    if (MODE == 1) {
        const int cp = tid & 63, tg = tid >> 6, c0 = quarter * 128 + 2 * cp; const LAS float* Y0 = (const LAS float*)(lds + L_Y0); const LAS float* Y1 = (const LAS float*)(lds + L_Y1);
#pragma unroll
        for (int i = 0; i < 8; ++i) { const int tl = 8 * tg + i; const size_t row = row0 + tok0 + tl; const unsigned g = *(const unsigned*)(GX + row * D + c0);
            const float y0 = Y0[(2 * cp) * 65 + tl] + Y1[(2 * cp) * 65 + tl], y1 = Y0[(2 * cp + 1) * 65 + tl] + Y1[(2 * cp + 1) * 65 + tl];
            *(unsigned*)(CAT + row * D + c0) = pk2(y0 * gelu_tanh_f(bflo(g)), y1 * gelu_tanh_f(bfhi(g))); }
        __syncthreads();
    }
}
}

constexpr int NPHASE = 18;
__global__ void __launch_bounds__(NTHREADS, 2) mk_fwd(Args args) {
    extern __shared__ __attribute__((aligned(16))) unsigned char lds_raw[];
    Frame F;
    F.lds = (LAS unsigned char*)lds_raw; F.ws = args.ws; F.ctl = (unsigned*)(args.ws + WS_CTL); F.out = args.out;
#pragma unroll
    for (int i = 0; i < 28; ++i) F.in[i] = args.in[i];
    F.tid = threadIdx.x; F.lane = F.tid & 63; F.wave = __builtin_amdgcn_readfirstlane(F.tid >> 6);
    F.G = gridDim.x; { const int bx = blockIdx.x; F.vcu = (F.G % 8 == 0) ? (bx % 8) * (F.G / 8) + bx / 8 : bx; }
    for (int u = F.tid; u < (LDS_BYTES - LDSCTL_OFF) / 4; u += NTHREADS) ((LAS unsigned*)(F.lds + LDSCTL_OFF))[u] = 0u;
    __syncthreads();
    XcdBarrier bar = xcd_barrier_post(F.ctl + CW_BAR, (volatile LAS unsigned*)(F.lds + LDSCTL_OFF + LC_BAR));
#if defined(PH_RUNTIME)
    const int lo = args.ph_lo, hi = args.ph_hi;
#else
    constexpr int lo = 0, hi = NPHASE;
#endif
#ifndef REP_MASK
#define REP_MASK 0u
#endif
#define REPS(k) for (int rep_ = 0; rep_ <= (int)((REP_MASK >> (k)) & 1u); ++rep_)
#define REPBAR() do { if (rep_ > 0) xcd_barrier(bar); } while (0)
#ifndef SKIP_MASK
#define SKIP_MASK 0u
#endif
#define IN(k) (!((SKIP_MASK >> (k)) & 1u) && lo <= (k) && (k) < hi)
#define SEAM(k) do { if (IN(k) && IN((k) + 1)) xcd_barrier(bar); } while (0)
#define PHB() do { int t_ = threadIdx.x; asm volatile("" : "+v"(t_)); F.tid = t_; F.lane = t_ & 63; F.wave = __builtin_amdgcn_readfirstlane(t_ >> 6); } while (0)
    unsigned char* ws = args.ws;
    bf16_t* R0 = (bf16_t*)(ws + WS_R0); unsigned char* R1 = ws + WS_R1;

    if (IN(0)) REPS(0) { REPBAR(); PHB(); p0_prologue(F); } SEAM(0);
    if (IN(1)) REPS(1) { REPBAR(); PHB(); p1_lnmod(F); } SEAM(1);
    if (IN(2)) REPS(2) { REPBAR();
        DenseOrder S; S.init(MALL / 256, INE / 256, F.G, (int)blockIdx.x, R0, (size_t)256 * D * 2, ws + WS_WIN, (size_t)256 * D * 2);
        EpiInProj E{(bf16_t*)(R1 + R1_GX), (bf16_t*)(R1 + R1_QB), (bf16_t*)(R1 + R1_KB), (bf16_t*)(R1 + R1_VB), (const float*)(ws + WS_ROPE)};
        run_gemm(F, pg8::Shape{D, D, D}, S, E);
    } SEAM(2);
    if (IN(3)) REPS(3) { REPBAR();
#if FAST_LRU
        PHB(); for (int u = F.vcu; u < NB * lru::NCHUNK * 4; u += F.G) lru::lru_unit<0>(F, (u >> 2) / lru::NCHUNK, (u >> 2) % lru::NCHUNK, u & 3);
        xcd_barrier(bar);
        PHB(); for (int u = F.vcu; u < NB * 64 * 4; u += F.G) lru::lru_unit<1>(F, u >> 8, 4 + ((u >> 2) & 63), u & 3);
#else
        PHB(); if ((int)blockIdx.x < NB) lru_simple(F, (int)blockIdx.x);
#endif
#if FAST_ATTN
        PHB(); att::attn_fast(F);
#else
        PHB(); attn_simple(F);
#endif
    } SEAM(3);
    if (IN(4)) REPS(4) { REPBAR();
        DenseOrder S; S.init(NLAT / 256, D / 256, F.G, (int)blockIdx.x, R0, (size_t)256 * D * 2, ws + WS_WOUT, (size_t)256 * D * 2);
        EpiF32 E{(float*)R1};
        run_gemm(F, pg8::Shape{D, D, D}, S, E);
    } SEAM(4);
    if (IN(5)) { PHB(); row_phase_a(F, 0, F.in[0], nullptr); } SEAM(5);
#pragma unroll
    for (int layer = 0; layer < 2; ++layer) {
        const int pb = layer == 0 ? 6 : 14;
        unsigned char* moew = ws + WS_MOEW + (size_t)layer * MOEW_LAYER;
        if (IN(pb)) { PHB(); moe_positions(F, layer); } SEAM(pb);
        if (IN(pb + 1)) REPS(pb + 1) { REPBAR();
            PHB(); moe_tile_prefix(F, layer);
            MoeOrder S{(const LAS int*)(F.lds + LDSCTL_OFF + LC_TSTART), F.G, (int)blockIdx.x, (const char*)R1, (const char*)moew, (size_t)256 * D * 2, (size_t)D * D * 2, (size_t)256 * D * 2};
            EpiSwiGLU E{(bf16_t*)(ws + WS_R2)};
            run_gemm(F, pg8::Shape{D, D, D}, S, E);
        } SEAM(pb + 1);
        if (IN(pb + 2)) REPS(pb + 2) { REPBAR();
            PHB(); moe_tile_prefix(F, layer);
            MoeOrder S{(const LAS int*)(F.lds + LDSCTL_OFF + LC_TSTART), F.G, (int)blockIdx.x, (const char*)(ws + WS_R2), (const char*)(moew + MOEW_W2), (size_t)256 * FF * 2, (size_t)D * FF * 2, (size_t)256 * FF * 2};
            EpiScatter E{(bf16_t*)R1, (const int*)(ws + WS_MISC + MISC_ROWTOK), (const float*)(ws + WS_MISC + MISC_EW)};
            run_gemm(F, pg8::Shape{FF, FF, FF}, S, E);
        } SEAM(pb + 2);
        if (IN(pb + 3)) { PHB(); row_phase_b(F, layer, layer == 0); } SEAM(pb + 3);
        if (layer == 0) {
            if (IN(10)) REPS(10) { REPBAR();
                ChanDftOrder S{F.G, (int)blockIdx.x, (const char*)(ws + WS_CDFT), (const char*)R0};
                EpiGT E{(bf16_t*)R1};
                run_gemm(F, pg8::Shape{256, 256, D}, S, E);
            } SEAM(10);
            if (IN(11)) REPS(11) { REPBAR();
                SeqDftOrder S{F.G, (int)blockIdx.x, (const char*)(ws + WS_CMAT), (const char*)R1};
                EpiBf16S E{R0, 1.f / 1024.f};
                run_gemm(F, pg8::Shape{8192, 8192, 8192}, S, E);
            } SEAM(11);
            if (IN(12)) REPS(12) { REPBAR();
                DenseOrder S; S.init(NLAT / 256, D / 256, F.G, (int)blockIdx.x, R0, (size_t)256 * D * 2, ws + WS_ODW, (size_t)256 * D * 2);
                EpiF32 E{(float*)R1};
                run_gemm(F, pg8::Shape{D, D, D}, S, E);
            } SEAM(12);
            if (IN(13)) { PHB(); row_phase_a(F, 1, F.out, F.in[20]); } SEAM(13);
        }
    }
#undef IN
#undef SEAM
}

extern "C" void kernel_launch(void* const* d_in, const int* in_sizes, int n_in, void* d_out, int out_size, void* d_ws, size_t ws_size, hipStream_t stream) {
    static int grid = 0;
    if (grid == 0) {
        if (n_in != 28 || out_size != NLAT * D || ws_size < WS_END) { fprintf(stderr, "kernel_launch: unexpected problem (n_in %d, out %d, ws %zu < %zu)\n", n_in, out_size, ws_size, (size_t)WS_END); grid = -1; return; }
        int dev = 0, cus = 0, per_cu = 0;
        if (hipGetDevice(&dev) != hipSuccess || hipDeviceGetAttribute(&cus, hipDeviceAttributeMultiprocessorCount, dev) != hipSuccess) { grid = -1; return; }
        if (hipFuncSetAttribute((const void*)mk_fwd, hipFuncAttributeMaxDynamicSharedMemorySize, LDS_BYTES) != hipSuccess) { fprintf(stderr, "kernel_launch: hipFuncSetAttribute failed\n"); grid = -1; return; }
        if (hipOccupancyMaxActiveBlocksPerMultiprocessor(&per_cu, (const void*)mk_fwd, NTHREADS, LDS_BYTES) != hipSuccess || per_cu < 1) fprintf(stderr, "kernel_launch: occupancy query reports %d\n", per_cu);
        (void)hipGetLastError();
        grid = cus;
        if (grid > 256) grid = 256;
        if ((NLAT / 32) % grid != 0) { fprintf(stderr, "kernel_launch: %d CUs: the row phases need a workgroup count dividing 1024\n", cus); grid = -1; return; }
    }
    if (grid < 0) return;
    if (hipMemsetAsync((char*)d_ws + WS_CTL, 0, CTL_ZERO_BYTES, stream) != hipSuccess) return;
    Args a{};
    for (int i = 0; i < 28; ++i) a.in[i] = (const float*)d_in[i];
    a.out = (float*)d_out; a.ws = (unsigned char*)d_ws; a.ph_lo = 0; a.ph_hi = NPHASE;
    hipLaunchKernelGGL(mk_fwd, dim3(grid), dim3(NTHREADS), LDS_BYTES, stream, a);
}
```

```cpp
#include <hip/hip_runtime.h>
#include <stdio.h>
#include <stdint.h>
#include <math.h>

#ifndef FAST_LRU
#define FAST_LRU 1
#endif
#ifndef FAST_ATTN
#define FAST_ATTN 1
#endif
#ifndef FAST_GEMM
#define FAST_GEMM 1
#endif

constexpr int D = 1024, NB = 8, SEQ = 4096, CTX = 256, NLAT = NB * SEQ, NCTX = NB * CTX, MALL = NLAT + NCTX;
constexpr int INE = 2560, LW = 512, NH = 4, NE = 32, FF = 512;
constexpr int MOE_ROWS = 2 * NLAT + NE * 256, MOE_TILES = MOE_ROWS / 256;
constexpr float LN_EPS = 1e-6f, ALPHA = 1.41421356237309515f;
constexpr float QSCALE = 0.125f * 1.4426950408889634f;
constexpr int NWAVES = 8, NTHREADS = 512;

constexpr size_t MiB = 1u << 20;
constexpr size_t WS_CTL = 0, CTL_ZERO_BYTES = 1 * MiB;
constexpr size_t WS_MODS = 1 * MiB;
constexpr size_t WS_ROPE = WS_MODS + 512 * 1024;
constexpr size_t WS_SMALL = WS_ROPE + 16 * 1024;
constexpr size_t WS_GATEW = WS_MODS + 768 * 1024;
constexpr size_t WS_CDFT = 2 * MiB;
constexpr size_t WS_WIN = 3 * MiB, WS_WOUT = 8 * MiB, WS_ODW = 10 * MiB;
constexpr size_t WS_U = 12 * MiB;
constexpr size_t WS_M1 = WS_CDFT + 256 * 1024, WS_M3 = WS_M1 + 64 * 1024;
constexpr size_t WS_TW = WS_M3 + 64 * 1024;
constexpr size_t WS_MOEW = 76 * MiB, MOEW_LAYER = 96 * MiB, MOEW_W2 = 64 * MiB;
constexpr size_t WS_R0 = 268 * MiB;
constexpr size_t WS_R1 = 336 * MiB;
constexpr size_t R1_GX = 0, R1_QB = 68 * MiB, R1_KB = 100 * MiB, R1_VB = 134 * MiB;
constexpr size_t WS_R2 = 504 * MiB;
constexpr size_t WS_MISC = 576 * MiB;
constexpr size_t MISC_EIDX = 0, MISC_EW = 256 * 1024, MISC_ROWTOK = 512 * 1024;
constexpr size_t MISC_BCNT = 896 * 1024;
constexpr size_t MISC_WRT = 5632 * 1024;
constexpr size_t MISC_SUMM = 1 * MiB;
constexpr size_t WS_END = 582 * MiB;
constexpr int CW_BAR = 4096;
constexpr int CW_CNT = 16384;
constexpr int RING_BYTES = 131072, LDSCTL_OFF = 139264, LDS_BYTES = 147456;
constexpr int LC_BAR = 0;
constexpr int LC_TSTART = 64;
constexpr int LC_XS = 1024;
constexpr int LC_HIST = 3072, LC_BASE = 3200, LC_LCUR = 3328;
constexpr int LC_TP = 3456;
constexpr int LC_POS = 4096;

#define GAS __attribute__((address_space(1)))
#define LAS __attribute__((address_space(3)))
typedef unsigned short bf16_t;
typedef short bf16x8 __attribute__((ext_vector_type(8)));
typedef float f32x4 __attribute__((ext_vector_type(4)));
typedef float f32x2 __attribute__((ext_vector_type(2)));
typedef unsigned u32x4 __attribute__((ext_vector_type(4)));
typedef unsigned u32x2 __attribute__((ext_vector_type(2)));

__device__ __forceinline__ unsigned f2bf(float f) { unsigned u = __float_as_uint(f); return (u + 0x7fffu + ((u >> 16) & 1u)) >> 16; }
__device__ __forceinline__ float bf2f(unsigned b) { return __uint_as_float(b << 16); }
__device__ __forceinline__ unsigned pk2(float lo, float hi) { return f2bf(lo) | (f2bf(hi) << 16); }
__device__ __forceinline__ float bflo(unsigned w) { return __uint_as_float(w << 16); }
__device__ __forceinline__ float bfhi(unsigned w) { return __uint_as_float(w & 0xffff0000u); }
__device__ __forceinline__ float wave_sum(float v) {
#pragma unroll
    for (int o = 1; o < 64; o <<= 1) v += __shfl_xor(v, o);
    return v;
}
__device__ __forceinline__ float wave_max(float v) {
#pragma unroll
    for (int o = 1; o < 64; o <<= 1) v = fmaxf(v, __shfl_xor(v, o));
    return v;
}
__device__ __forceinline__ float sigmoid_f(float x) { return 1.f / (1.f + __expf(-x)); }
__device__ __forceinline__ float silu_f(float x) { return x / (1.f + __expf(-x)); }
__device__ __forceinline__ float gelu_tanh_f(float x) { const float u = 0.7978845608028654f * (x + 0.044715f * x * x * x); return x / (1.f + __expf(-2.f * u)); }

#define XB_TMO      128
#define XB_XCNT(j)  (256  + 64 * (j))
#define XB_XSUB(j)  (1280 + 64 * (j))
#define XB_XGEN(j)  (2304 + 64 * (j))
#define XB_TOP      3328
#define XB_TOPGEN   3392
#define XCD_BAR_WORDS 3456
#define XB_SPIN_CAP (1u << 18)
__device__ __forceinline__ unsigned xb_ld(unsigned* p)              { return __hip_atomic_load(p, __ATOMIC_RELAXED, __HIP_MEMORY_SCOPE_AGENT); }
__device__ __forceinline__ unsigned xb_add(unsigned* p, unsigned v) { return __hip_atomic_fetch_add(p, v, __ATOMIC_RELAXED, __HIP_MEMORY_SCOPE_AGENT); }
__device__ __forceinline__ unsigned xb_xcc_id() { return (unsigned)__builtin_amdgcn_s_getreg((3 << 11) | 20) & 0xFu; }
#define XB_SPIN(cond, bar) do { unsigned _sp = 0; while (cond) { __builtin_amdgcn_s_sleep(1); \
    if ((++_sp & 255u) == 0u) { if (xb_ld(&(bar)[XB_TMO])) break; if (_sp > XB_SPIN_CAP) { atomicAdd(&(bar)[XB_TMO], 1u); break; } } } } while (0)
struct XcdBarrier { unsigned* bar; unsigned x; volatile LAS unsigned* st; };
__device__ __forceinline__ XcdBarrier xcd_barrier_post(unsigned* bar, volatile LAS unsigned* st) {
    XcdBarrier b; b.bar = bar; b.x = xb_xcc_id(); b.st = st;
    if (threadIdx.x == 0) (void)xb_add(&bar[XB_XCNT(b.x)], 1u);
    return b;
}
__device__ __forceinline__ void xcd_barrier_complete(unsigned* bar, unsigned x, unsigned& nloc, unsigned& nx) {
    const unsigned G = gridDim.x * gridDim.y * gridDim.z;
    unsigned sum, cnt, mine, sp = 0u;
    for (;;) {
        sum = 0u; cnt = 0u; mine = 0u;
#pragma unroll
        for (unsigned j = 0; j < 16; ++j) { const unsigned c = xb_ld(&bar[XB_XCNT(j)]); sum += c; cnt += (c > 0u) ? 1u : 0u; mine = (j == x) ? c : mine; }
        if (sum == G) break;
        __builtin_amdgcn_s_sleep(1);
        if ((++sp & 255u) == 0u) { if (xb_ld(&bar[XB_TMO])) break; if (sp > XB_SPIN_CAP) { atomicAdd(&bar[XB_TMO], 1u); break; } }
    }
    nloc = mine > 0u ? mine : 1u; nx = cnt > 0u ? cnt : 1u;
}
__device__ __forceinline__ void xcd_barrier(const XcdBarrier& b) {
    asm volatile("s_waitcnt vmcnt(0)" ::: "memory");
    __syncthreads();
    if (threadIdx.x == 0) {
        unsigned* bar = b.bar;
        __builtin_amdgcn_s_waitcnt(0);
        unsigned nloc = b.st[0], nx = b.st[1];
        if (nloc == 0u) { xcd_barrier_complete(bar, b.x, nloc, nx); b.st[0] = nloc; b.st[1] = nx; }
        const unsigned old = xb_add(&bar[XB_XSUB(b.x)], 1u);
        const unsigned gen = old / nloc;
        if (old + 1u == (gen + 1u) * nloc) {
            __builtin_amdgcn_fence(__ATOMIC_RELEASE, "agent");
            asm volatile("s_waitcnt vmcnt(0)" ::: "memory");
            const unsigned og = xb_add(&bar[XB_TOP], 1u);
            const unsigned tg = og / nx;
            if (og + 1u == (tg + 1u) * nx) xb_add(&bar[XB_TOPGEN], 1u);
            else XB_SPIN(xb_ld(&bar[XB_TOPGEN]) == tg, bar);
            __builtin_amdgcn_fence(__ATOMIC_ACQUIRE, "agent");
            xb_add(&bar[XB_XGEN(b.x)], 1u);
            asm volatile("s_waitcnt vmcnt(0)" ::: "memory");
        } else {
            XB_SPIN(xb_ld(&bar[XB_XGEN(b.x)]) == gen, bar);
            __builtin_amdgcn_fence(__ATOMIC_ACQUIRE, "agent");
            asm volatile("s_waitcnt vmcnt(0)" ::: "memory");
        }
    }
    __syncthreads();
}

namespace pg8 {
constexpr int BM = 256, BK = 64, HALF = 128, HTB = HALF * BK * 2, STAGE_BYTES = 8 * HTB, NXCD = 8, WGM = 8;
__host__ __device__ __forceinline__ int lds_byte(int r, int c) { const int st = (r >> 4) * 2 + (c >> 5), rr = r & 15, cc = c & 31, ob = rr * 64 + cc * 2; return st * 1024 + (ob ^ (((ob >> 9) & 1) << 5)); }
__host__ __device__ __forceinline__ void stage_rc(int b, int& R, int& C) { const int st = b / 1024, sb = b % 1024, swz = sb ^ (((sb >> 9) & 1) << 5); R = (st >> 1) * 16 + swz / 64; C = (st & 1) * 32 + (swz % 64) / 2; }
__host__ __device__ __forceinline__ int perm32(int rho) { const int n = rho >> 4, i = rho & 15; return 8 * (i >> 2) + 4 * n + (i & 3); }
struct Unit { int pm, pn; const char* A; const char* B; };
struct Shape { int K, pitchA, pitchB; unsigned kstepB, hstepB; };
__device__ __forceinline__ unsigned cvt_pk_bf16(float lo, float hi) { unsigned r; asm volatile("v_cvt_pk_bf16_f32 %0, %1, %2" : "=v"(r) : "v"(lo), "v"(hi)); return r; }

template <class Epi, class Sched, bool ALIGN_EPI = true>
__device__ __forceinline__ void gemm_phase(LAS unsigned char* lds, const Shape g, const Sched& S, const Epi& E) {
    int tid_ = threadIdx.x; asm volatile("" : "+v"(tid_));
    const int tid = tid_, wid = __builtin_amdgcn_readfirstlane(tid >> 6), lane = tid & 63, wr = wid >> 2, wc = wid & 3, fr = lane & 15, fq = lane >> 4;
    const int K = g.K, nt = K / BK;
    unsigned voffA[2], voffB[2];
#pragma unroll
    for (int i = 0; i < 2; ++i) { int R, C; stage_rc(tid * 16 + i * 8192, R, C); const int Rb = Epi::PERM ? ((R & ~31) + perm32(R & 31)) : R;
        voffA[i] = (unsigned)(R * g.pitchA + C) * 2u; voffB[i] = (unsigned)(S.rowoffB(Rb, g.pitchB) + C) * 2u; }
    const size_t kstep = (size_t)(BK * 2), kstepB = g.kstepB ? (size_t)g.kstepB : kstep;
    const size_t hstepA = (size_t)HALF * g.pitchA * 2, hstepB = g.hstepB ? (size_t)g.hstepB : (size_t)HALF * g.pitchB * 2;
    const unsigned ldsw = (unsigned)wid * 1024u;
    const int aoff = lds_byte(wr * 64 + fr, fq * 8), boff = lds_byte(wc * 32 + fr, fq * 8);
#define PG8_SA(b, h) (((b) * 2 + (h)) * HTB)
#define PG8_SB(b, h) ((4 + (b) * 2 + (h)) * HTB)
#define PG8_STAGE(bufoff, gbase, voff) do { _Pragma("unroll") for (int _i = 0; _i < 2; ++_i) \
        __builtin_amdgcn_global_load_lds((const unsigned*)((const char*)(gbase) + (voff)[_i]), (LAS unsigned*)(lds + (bufoff) + ldsw + _i * 8192), 16, 0, 0); } while (0)
#define PG8_LDA(dst, b, h) do { _Pragma("unroll") for (int m = 0; m < 4; ++m) _Pragma("unroll") for (int k = 0; k < 2; ++k) dst[m][k] = *(const LAS bf16x8*)(lds + PG8_SA(b, h) + aoff + m * 2048 + k * 1024); } while (0)
#define PG8_LDB(dst, b, h) do { _Pragma("unroll") for (int n = 0; n < 2; ++n) _Pragma("unroll") for (int k = 0; k < 2; ++k) dst[n][k] = *(const LAS bf16x8*)(lds + PG8_SB(b, h) + boff + n * 2048 + k * 1024); } while (0)
#define PG8_MMA(ai, bj, At, Bt) do { __builtin_amdgcn_s_setprio(1); _Pragma("unroll") for (int m = 0; m < 4; ++m) _Pragma("unroll") for (int n = 0; n < 2; ++n) _Pragma("unroll") for (int k = 0; k < 2; ++k) \
        acc[ai][bj][m][n] = __builtin_amdgcn_mfma_f32_16x16x32_bf16(Bt[n][k], At[m][k], acc[ai][bj][m][n], 0, 0, 0); __builtin_amdgcn_s_setprio(0); } while (0)
#define PG8_WAIT_V(n) asm volatile("s_waitcnt vmcnt(" #n ")" ::: "memory")
#define PG8_WAIT_L(n) asm volatile("s_waitcnt lgkmcnt(" #n ")" ::: "memory")
#define PG8_BAR __builtin_amdgcn_s_barrier()
#define PG8_SCHED __builtin_amdgcn_sched_barrier(0)
    Unit cur, nxt; int ui = 0;
    if (!S.next(0, cur)) return;
    f32x4 acc[2][2][4][2];
#pragma unroll
    for (int a = 0; a < 2; ++a)
#pragma unroll
        for (int b = 0; b < 2; ++b)
#pragma unroll
            for (int m = 0; m < 4; ++m)
#pragma unroll
                for (int n = 0; n < 2; ++n) acc[a][b][m][n] = (f32x4){0.f, 0.f, 0.f, 0.f};
    bf16x8 At[4][2], B0[2][2], B1[2][2];
    const char* cA = cur.A; const char* cB = cur.B;
    PG8_STAGE(PG8_SB(0, 0), cB, voffB); PG8_STAGE(PG8_SB(0, 1), cB + hstepB, voffB); PG8_STAGE(PG8_SA(0, 0), cA, voffA); PG8_STAGE(PG8_SA(0, 1), cA + hstepA, voffA);
    if (wr == 1) PG8_BAR;
    PG8_WAIT_V(2); PG8_BAR;
    PG8_STAGE(PG8_SB(1, 0), cB + kstepB, voffB); PG8_STAGE(PG8_SA(1, 0), cA + kstep, voffA); PG8_STAGE(PG8_SB(1, 1), cB + hstepB + kstepB, voffB);
    PG8_WAIT_V(6); PG8_BAR;
    for (;;) {
        const bool has_next = S.next(ui + 1, nxt);
        const char* nA = has_next ? nxt.A : cA; const char* nB = has_next ? nxt.B : cB;
        for (int t = 0; t < nt; t += 2) {
            const bool last = (t == nt - 2);
            const char* a1 = cA + (size_t)(t + 1) * kstep;
            const char* a2 = last ? nA : cA + (size_t)(t + 2) * kstep; const char* b2 = last ? nB : cB + (size_t)(t + 2) * kstepB;
            const char* a3 = a2 + kstep; const char* b3 = b2 + kstepB;
            PG8_LDB(B0, 0, 0); PG8_LDB(B1, 0, 1); PG8_SCHED; PG8_LDA(At, 0, 0); PG8_STAGE(PG8_SA(1, 1), a1 + hstepA, voffA);
            PG8_WAIT_V(8); PG8_WAIT_L(0); PG8_BAR; PG8_MMA(0, 0, At, B0); PG8_MMA(0, 1, At, B1); PG8_BAR; PG8_SCHED;
            PG8_LDA(At, 0, 1); PG8_STAGE(PG8_SB(0, 0), b2, voffB); PG8_STAGE(PG8_SB(0, 1), b2 + hstepB, voffB); PG8_STAGE(PG8_SA(0, 0), a2, voffA);
            PG8_WAIT_V(8); PG8_WAIT_L(0); PG8_BAR; PG8_MMA(1, 0, At, B0); PG8_MMA(1, 1, At, B1); PG8_BAR; PG8_SCHED;
            PG8_LDB(B0, 1, 0); PG8_LDB(B1, 1, 1); PG8_SCHED; PG8_LDA(At, 1, 0); PG8_STAGE(PG8_SA(0, 1), a2 + hstepA, voffA);
            PG8_WAIT_V(8); PG8_WAIT_L(0); PG8_BAR; PG8_MMA(0, 0, At, B0); PG8_MMA(0, 1, At, B1); PG8_BAR; PG8_SCHED;
            PG8_LDA(At, 1, 1); PG8_STAGE(PG8_SB(1, 0), b3, voffB); PG8_STAGE(PG8_SB(1, 1), b3 + hstepB, voffB); PG8_STAGE(PG8_SA(1, 0), a3, voffA);
            PG8_WAIT_V(8); PG8_WAIT_L(0); PG8_BAR; PG8_MMA(1, 0, At, B0); PG8_MMA(1, 1, At, B1); PG8_BAR; PG8_SCHED;
        }
        if constexpr (ALIGN_EPI) { if (wr == 0) PG8_BAR; }
        E(acc, cur, wr, wc, fr, fq);
        if (!has_next) break;
#pragma unroll
        for (int a = 0; a < 2; ++a)
#pragma unroll
            for (int b = 0; b < 2; ++b)
#pragma unroll
                for (int m = 0; m < 4; ++m)
#pragma unroll
                    for (int n = 0; n < 2; ++n) acc[a][b][m][n] = (f32x4){0.f, 0.f, 0.f, 0.f};
        cur = nxt; cA = nA; cB = nB; ++ui;
        if constexpr (ALIGN_EPI) { if (wr == 1) PG8_BAR; }
    }
    PG8_WAIT_V(0);
    if constexpr (!ALIGN_EPI) { if (wr == 0) PG8_BAR; }
    PG8_BAR;
#undef PG8_SA
#undef PG8_SB
#undef PG8_STAGE
#undef PG8_LDA
#undef PG8_LDB
#undef PG8_MMA
#undef PG8_WAIT_V
#undef PG8_WAIT_L
#undef PG8_BAR
#undef PG8_SCHED
}

template <class Epi, class Sched>
__device__ __forceinline__ void gemm_phase_ref(const Shape g, const Sched& S, const Epi& E) {
    const int tid = threadIdx.x, wid = __builtin_amdgcn_readfirstlane(tid >> 6), lane = tid & 63, wr = wid >> 2, wc = wid & 3, fr = lane & 15, fq = lane >> 4;
    Unit u;
    for (int it = 0; S.next(it, u); ++it) {
        f32x4 acc[2][2][4][2];
#pragma unroll
        for (int a = 0; a < 2; ++a)
#pragma unroll
            for (int b = 0; b < 2; ++b)
#pragma unroll
                for (int m = 0; m < 4; ++m)
#pragma unroll
                    for (int n = 0; n < 2; ++n) acc[a][b][m][n] = (f32x4){0.f, 0.f, 0.f, 0.f};
#pragma unroll
        for (int ai = 0; ai < 2; ++ai) {
            for (int k8 = 0; k8 < g.K / 8; ++k8) {
                float a[4][8];
#pragma unroll
                for (int m = 0; m < 4; ++m) { const u32x4 w = *(const u32x4*)(u.A + ((size_t)(ai * 128 + wr * 64 + m * 16 + fr) * g.pitchA + k8 * 8) * 2);
                    a[m][0] = bflo(w.x); a[m][1] = bfhi(w.x); a[m][2] = bflo(w.y); a[m][3] = bfhi(w.y); a[m][4] = bflo(w.z); a[m][5] = bfhi(w.z); a[m][6] = bflo(w.w); a[m][7] = bfhi(w.w); }
#pragma unroll
                for (int bj = 0; bj < 2; ++bj)
#pragma unroll
                    for (int n = 0; n < 2; ++n)
#pragma unroll
                        for (int ii = 0; ii < 4; ++ii) {
                            const int col = bj * 128 + wc * 32 + (Epi::PERM ? 8 * fq + 4 * n + ii : 16 * n + 4 * fq + ii);
                            const size_t kb_ = g.kstepB ? (size_t)(k8 >> 3) * g.kstepB + (size_t)(k8 & 7) * 16 : (size_t)k8 * 16;
                            const u32x4 w = *(const u32x4*)(u.B + (size_t)(col >> 7) * (g.hstepB ? (size_t)g.hstepB : (size_t)HALF * g.pitchB * 2) + (size_t)S.rowoffB(col & 127, g.pitchB) * 2 + kb_);
                            const float b0 = bflo(w.x), b1 = bfhi(w.x), b2 = bflo(w.y), b3 = bfhi(w.y), b4 = bflo(w.z), b5 = bfhi(w.z), b6 = bflo(w.w), b7 = bfhi(w.w);
#pragma unroll
                            for (int m = 0; m < 4; ++m)
                                acc[ai][bj][m][n][ii] += a[m][0] * b0 + a[m][1] * b1 + a[m][2] * b2 + a[m][3] * b3 + a[m][4] * b4 + a[m][5] * b5 + a[m][6] * b6 + a[m][7] * b7;
                        }
            }
        }
        E(acc, u, wr, wc, fr, fq);
    }
}
}

struct Args { const float* in[28]; float* out; unsigned char* ws; int ph_lo, ph_hi; };
struct Frame {
    LAS unsigned char* lds; unsigned* ctl; unsigned char* ws;
    int tid, lane, wave, G, vcu;
    const float* in[28]; float* out;
};
#define LDS_WAIT() asm volatile("s_waitcnt lgkmcnt(0)" ::: "memory")
#ifndef TIME_SUB
#define TIME_SUB -1
#endif
#define TSB(id) do { if ((id) == TIME_SUB && blockIdx.x == 0 && threadIdx.x == 0) ((volatile LAS unsigned long long*)(F.lds + LDSCTL_OFF + LC_TP))[0] = __builtin_amdgcn_s_memrealtime(); } while (0)
#define TSE(id) do { if ((id) == TIME_SUB && blockIdx.x == 0 && threadIdx.x == 0) { volatile LAS unsigned long long* tp_ = (volatile LAS unsigned long long*)(F.lds + LDSCTL_OFF + LC_TP); tp_[1] = tp_[1] + (__builtin_amdgcn_s_memrealtime() - tp_[0]); } } while (0)

template <class RowMap>
__device__ __forceinline__ void p0_transpose_item(const float* W, int K, int N, bf16_t* WT, RowMap rowmap, LAS float* scr, int item, int lane) {
    const int nblk = N / 32, kb = item / nblk, nb = item % nblk, k0 = 64 * kb, n0 = 32 * nb;
    float v[32];
#pragma unroll
    for (int i = 0; i < 32; ++i) v[i] = __builtin_nontemporal_load(W + (size_t)(k0 + 2 * i + (lane >> 5)) * N + n0 + (lane & 31));
#pragma unroll
    for (int i = 0; i < 32; ++i) scr[(2 * i + (lane >> 5)) * 33 + (lane & 31)] = v[i];
    LDS_WAIT(); asm volatile("" ::: "memory");
    const int c = lane & 7;
#pragma unroll
    for (int j = 0; j < 4; ++j) { const int n = (lane >> 3) + 8 * j; const LAS float* s = scr + (8 * c) * 33 + n;
        u32x4 o; o.x = pk2(s[0 * 33], s[1 * 33]); o.y = pk2(s[2 * 33], s[3 * 33]); o.z = pk2(s[4 * 33], s[5 * 33]); o.w = pk2(s[6 * 33], s[7 * 33]);
        *(u32x4*)(WT + (size_t)rowmap(n0 + n) * K + k0 + 8 * c) = o; }
    LDS_WAIT(); asm volatile("" ::: "memory");
}
struct RmId { __device__ int operator()(int n) const { return n; } };
struct RmW1 { __device__ int operator()(int j) const { return (j >> 2) * 8 + (j & 3); } };
struct RmW3 { __device__ int operator()(int j) const { return (j >> 2) * 8 + 4 + (j & 3); } };

__device__ __forceinline__ void p0_prologue(Frame& F) {
    unsigned char* ws = F.ws;
    LAS float* scr = (LAS float*)(F.lds + F.wave * 16384);
    const int gw = F.vcu * NWAVES + F.wave, NGW = F.G * NWAVES;
    constexpr int I_WIN = 16 * 80, I_SQ = 16 * 32, I_W13 = 16 * 16, I_W2 = 8 * 32;
    constexpr int N0 = I_WIN, N1 = N0 + I_SQ, N2 = N1 + I_SQ, N3 = N2 + 2 * NE * I_W13  , N4 = N3 + 2 * NE * I_W13  , N5 = N4 + 2 * NE * I_W2;
    for (int it = gw; it < N5; it += NGW) {
        if (it < N0) { p0_transpose_item(F.in[8], D, INE, (bf16_t*)(ws + WS_WIN), RmId(), scr, it, F.lane); continue; }
        if (it < N1) { p0_transpose_item(F.in[18], D, D, (bf16_t*)(ws + WS_WOUT), RmId(), scr, it - N0, F.lane); continue; }
        if (it < N2) { p0_transpose_item(F.in[19], D, D, (bf16_t*)(ws + WS_ODW), RmId(), scr, it - N1, F.lane); continue; }
        if (it < N3) { const int r = it - N2, le = r / I_W13, l = le / NE, e = le % NE;
            p0_transpose_item(F.in[25] + (size_t)le * D * FF, D, FF, (bf16_t*)(ws + WS_MOEW + l * MOEW_LAYER) + (size_t)e * D * D, RmW1(), scr, r % I_W13, F.lane); continue; }
        if (it < N4) { const int r = it - N3, le = r / I_W13, l = le / NE, e = le % NE;
            p0_transpose_item(F.in[26] + (size_t)le * D * FF, D, FF, (bf16_t*)(ws + WS_MOEW + l * MOEW_LAYER) + (size_t)e * D * D, RmW3(), scr, r % I_W13, F.lane); continue; }
        { const int r = it - N4, le = r / I_W2, l = le / NE, e = le % NE;
            p0_transpose_item(F.in[27] + (size_t)le * FF * D, FF, D, (bf16_t*)(ws + WS_MOEW + l * MOEW_LAYER + MOEW_W2) + (size_t)e * D * FF, RmId(), scr, r % I_W2, F.lane); }
    }
    const int gt = F.vcu * NTHREADS + F.tid, NGT = F.G * NTHREADS;
    { bf16_t* gwt = (bf16_t*)(ws + WS_GATEW);
      for (int i = gt; i < 2 * 2 * 8 * 64 * 64; i += NGT) { const int k = i & 63, n = (i >> 6) & 63, h = (i >> 12) & 7, t = (i >> 15) & 1, d = i >> 16;
          const float* w = t ? F.in[13] : F.in[11]; gwt[i] = (bf16_t)f2bf(w[(((size_t)d * 8 + h) * 64 + k) * 64 + n]); } }
    { bf16_t* wrt = (bf16_t*)(ws + WS_MISC + MISC_WRT);
      for (int i = gt; i < 2 * 48 * 1024; i += NGT) { const int k = i & 1023, n = (i >> 10) % 48, l = i / (48 * 1024);
          const float w = n < 4 ? F.in[21][((size_t)l * D + k) * 4 + n] : n < 36 ? F.in[23][((size_t)l * D + k) * 32 + (n - 4)] : 0.f;
          const unsigned hi = f2bf(w); const unsigned lo = f2bf(w - bf2f(hi));
          wrt[((size_t)(l * 2 + 0) * 48 + n) * 1024 + k] = (bf16_t)hi; wrt[((size_t)(l * 2 + 1) * 48 + n) * 1024 + k] = (bf16_t)lo; } }
    { float* rope = (float*)(ws + WS_ROPE);
      for (int i = gt; i < 64 * 16; i += NGT) { const int f = i & 15, pos = i >> 4; const float freq = powf(10000.f, -(float)f / 16.f); const float ang = (float)pos * freq;
          rope[i * 2] = (float)cos((double)ang); rope[i * 2 + 1] = (float)sin((double)ang); }
      float* sm = (float*)(ws + WS_SMALL);
      for (int i = gt; i < 2 * LW; i += NGT) { const float l = F.in[15][i]; sm[64 + i] = (-l > 20.f) ? -l : log1pf(expf(-l)); }
      if (blockIdx.x == 0 && F.wave == 0) { const float* dl = F.in[16]; const float a = wave_sum(dl[F.lane] * dl[64 + F.lane]), b = wave_sum(dl[128 + F.lane] * dl[192 + F.lane]);
          if (F.lane == 0) sm[0] = expf(a) - expf(b) + 0.2f; } }
    __syncthreads();
    { LAS float* tab = (LAS float*)F.lds;
      for (int i = F.tid; i < 4096; i += NTHREADS) tab[i] = (float)cos(2.0 * 3.14159265358979323846 * (double)i / 4096.0);
      __syncthreads();
      bf16_t* cd = (bf16_t*)(ws + WS_CDFT);
      for (int i = gt; i < 512 * 256; i += NGT) { const int c = i & 255, m = i >> 8; const int j = ((m & 255) * c) & 255; cd[i] = (bf16_t)f2bf(m < 256 ? tab[j * 16] : tab[(j * 16 + 3072) & 4095]); }
      bf16_t* m1 = (bf16_t*)(ws + WS_M1); bf16_t* m3 = (bf16_t*)(ws + WS_M3); float* twp = (float*)(ws + WS_TW);
      for (int i = gt; i < 256 * 128; i += NGT) { const int k = i & 127, r = i >> 7, n = k & 63, im_in = k >> 6;
          float v1 = 0.f; if (r < 128) { const int ka = 32 * (r >> 6) + 16 * ((r >> 4) & 1) + (r & 15), im_out = (r >> 5) & 1; const int j = ((ka * n) & 63) * 64; const float cc = tab[j], ss = tab[(j + 3072) & 4095];
              v1 = im_out == 0 ? (im_in == 0 ? cc : -ss) : (im_in == 0 ? -ss : -cc); }
          m1[i] = (bf16_t)f2bf(v1);
          float v3 = 0.f; if (r < 64) { const int j = ((r * n) & 63) * 64; v3 = im_in == 0 ? tab[j] : tab[(j + 3072) & 4095]; }
          m3[i] = (bf16_t)f2bf(v3); }
      for (int i = gt; i < 64 * 64; i += NGT) { const int n2 = i & 63, ka = i >> 6; const int j = (ka * n2) & 4095; twp[2 * i] = tab[j]; twp[2 * i + 1] = tab[(j + 3072) & 4095]; }
      __syncthreads(); }
    { LAS float* sc = (LAS float*)F.lds;
      LAS float* red = sc + 9 * 1024;
      for (int i = F.tid; i < 9 * 1024; i += NTHREADS) { const int r = i >> 10, k = i & 1023; const float v = r < 8 ? F.in[1][r * D + k] : F.in[3][k]; sc[i] = v / (1.f + expf(-v)); }
      __syncthreads();
      float* mods = (float*)(ws + WS_MODS);
      for (int u = F.vcu; u < 2 * 96; u += F.G) { const int l = u / 96, n0 = (u % 96) * 64, col = F.tid & 63, kc = F.tid >> 6;
          float a9[9];
#pragma unroll
          for (int r = 0; r < 9; ++r) a9[r] = 0.f;
          const float* w = F.in[4] + ((size_t)l * D + kc * 128) * 6144 + n0 + col;
#pragma unroll 1
          for (int k0 = 0; k0 < 128; k0 += 16) { float wv[16];
#pragma unroll
              for (int k = 0; k < 16; ++k) wv[k] = __builtin_nontemporal_load(w + (size_t)(k0 + k) * 6144);
#pragma unroll
              for (int k = 0; k < 16; ++k)
#pragma unroll
                  for (int r = 0; r < 9; ++r) a9[r] += sc[r * 1024 + kc * 128 + k0 + k] * wv[k]; }
#pragma unroll
          for (int r = 0; r < 9; ++r) red[(kc * 9 + r) * 64 + col] = a9[r];
          __syncthreads();
          for (int i = F.tid; i < 9 * 64; i += NTHREADS) { const int r = i >> 6, c = i & 63; float s = 0.f;
#pragma unroll
              for (int q = 0; q < 8; ++q) s += red[(q * 9 + r) * 64 + c];
              mods[((size_t)l * 9 + r) * 6144 + n0 + c] = s + F.in[5][l * 6144 + n0 + c]; }
          __syncthreads(); } }
}

template <int CTRL> __device__ __forceinline__ float dpp_f(float v) { return __int_as_float(__builtin_amdgcn_update_dpp(0, __float_as_int(v), CTRL, 0xf, 0xf, true)); }
__device__ __forceinline__ float row16_sum(float v) { v += dpp_f<0x128>(v); v += dpp_f<0x124>(v); v += dpp_f<0x122>(v); v += dpp_f<0x121>(v); v += __shfl_xor(v, 16); return v; }
__device__ __forceinline__ void ln_stats16(f32x4 (&v)[8], float& mean, float& rstd) {
    float s = 0.f;
#pragma unroll
    for (int j = 0; j < 8; ++j) s += (v[j].x + v[j].y) + (v[j].z + v[j].w);
    mean = row16_sum(s) * (1.f / D); float q = 0.f;
#pragma unroll
    for (int j = 0; j < 8; ++j) { const f32x4 d = v[j] - mean; q += (d.x * d.x + d.y * d.y) + (d.z * d.z + d.w * d.w); }
    rstd = 1.f / sqrtf(row16_sum(q) * (1.f / D) + LN_EPS);
}
__device__ __forceinline__ void p1_lnmod(Frame& F) {
    const int gw = F.vcu * NWAVES + F.wave, NGW = F.G * NWAVES, r4 = F.lane >> 5, sub = F.lane & 31; const float* mods = (const float*)(F.ws + WS_MODS); bf16_t* H = (bf16_t*)(F.ws + WS_R0);
    for (int quad = gw; quad < MALL / 2; quad += NGW) { const int row = quad * 2 + r4;
        const float* src = row < NLAT ? F.in[0] + (size_t)row * D : F.in[2] + (size_t)(row - NLAT) * D; const int r = row < NLAT ? (row >> 12) : 8;
        f32x4 v[8];
#pragma unroll
        for (int j = 0; j < 8; ++j) v[j] = ((const f32x4*)src)[sub + 32 * j];
        float mean, rstd; ln_stats16(v, mean, rstd);
        const f32x4* sh = (const f32x4*)(mods + (size_t)r * 6144); const f32x4* sc = (const f32x4*)(mods + (size_t)r * 6144 + 1024);
#pragma unroll
        for (int j = 0; j < 8; ++j) { const f32x4 a = sh[sub + 32 * j], bb = sc[sub + 32 * j]; const f32x4 o = (v[j] - mean) * rstd * (bb + 1.f) + a;
            ((u32x2*)(H + (size_t)row * D))[sub + 32 * j] = (u32x2){pk2(o.x, o.y), pk2(o.z, o.w)}; }
    }
}
constexpr int RT_PITCH = 2064;
__device__ __forceinline__ void row_phase_a(Frame& F, int layer, const float* xin, const float* bias) {
    const float* mods = (const float*)(F.ws + WS_MODS) + (size_t)layer * 9 * 6144;
    const float* Y = (const float*)(F.ws + WS_R1); bf16_t* T = (bf16_t*)(F.ws + WS_R0); float* X = F.out;
    const float* lg = F.in[6] + (size_t)(layer * 2) * D; const float* lb = F.in[7] + (size_t)(layer * 2) * D;
    const float* bg = F.in[22] + layer * 4; const float* bfp = F.in[24] + layer * 32;
    const bf16_t* WRT = (const bf16_t*)(F.ws + WS_MISC + MISC_WRT) + (size_t)layer * 2 * 48 * 1024;
    int* eidx = (int*)(F.ws + WS_MISC + MISC_EIDX); float* ew = (float*)(F.ws + WS_MISC + MISC_EW); unsigned* cnt = F.ctl + CW_CNT + layer * 128;
    unsigned* bcnt = (unsigned*)(F.ws + WS_MISC + MISC_BCNT);
    LAS unsigned char* lds = F.lds; LAS unsigned char* TH = lds; LAS unsigned char* TL = lds + 32 * RT_PITCH;
    LAS float* PART = (LAS float*)lds; LAS float* LOG = (LAS float*)(lds + 8 * 32 * 48 * 4);
    LAS unsigned* hist = (LAS unsigned*)(lds + LDSCTL_OFF + LC_HIST);
    const int lane = F.lane, wid = F.wave, fr = lane & 15, fq = lane >> 4;
    if (F.tid < 32) hist[F.tid] = 0u;
    __syncthreads();
    const int TPB = (NLAT / 32) / F.G;
    for (int ti = 0; ti < TPB; ++ti) { const int tile = (int)blockIdx.x * TPB + ti;
        TSB(100);
#pragma unroll 1
        for (int hh = 0; hh < 2; ++hh) { const int r4 = lane >> 5, sub = lane & 31, rl = wid * 4 + 2 * hh + r4, row = tile * 32 + rl; const int b = row >> 12; const float* mr = mods + (size_t)b * 6144;
            f32x4 v[8];
#pragma unroll
            for (int j = 0; j < 8; ++j) { const int q = sub + 32 * j; f32x4 y = ((const f32x4*)(Y + (size_t)row * D))[q]; if (bias) y = y + ((const f32x4*)bias)[q];
                v[j] = ((const f32x4*)(xin + (size_t)row * D))[q] * ALPHA + ((const f32x4*)(mr + 2 * 1024))[q] * y; }
            float mean, rstd; ln_stats16(v, mean, rstd);
#pragma unroll
            for (int j = 0; j < 8; ++j) { const int q = sub + 32 * j; v[j] = (v[j] - mean) * rstd * ((const f32x4*)lg)[q] + ((const f32x4*)lb)[q]; ((f32x4*)(X + (size_t)row * D))[q] = v[j]; }
            ln_stats16(v, mean, rstd);
#pragma unroll
            for (int j = 0; j < 8; ++j) { const int q = sub + 32 * j; const f32x4 t = (v[j] - mean) * rstd * (((const f32x4*)(mr + 4 * 1024))[q] + 1.f) + ((const f32x4*)(mr + 3 * 1024))[q];
                const unsigned h0 = f2bf(t.x), h1 = f2bf(t.y), h2 = f2bf(t.z), h3 = f2bf(t.w);
                const u32x2 hw = (u32x2){h0 | (h1 << 16), h2 | (h3 << 16)};
                const u32x2 lw = (u32x2){pk2(t.x - bf2f(h0), t.y - bf2f(h1)), pk2(t.z - bf2f(h2), t.w - bf2f(h3))};
                ((u32x2*)(T + (size_t)row * D))[q] = hw;
                *(LAS u32x2*)(TH + rl * RT_PITCH + q * 8) = hw; *(LAS u32x2*)(TL + rl * RT_PITCH + q * 8) = lw; } }
        __syncthreads();
        TSE(100); TSB(101);
        f32x4 acc[2][3];
#pragma unroll
        for (int mt = 0; mt < 2; ++mt)
#pragma unroll
            for (int nt = 0; nt < 3; ++nt) acc[mt][nt] = (f32x4){0.f, 0.f, 0.f, 0.f};
#pragma unroll
        for (int ks = 0; ks < 4; ++ks) { const int k0 = wid * 128 + ks * 32 + 8 * fq;
            bf16x8 ah[2], al[2], bh[3], bl[3];
#pragma unroll
            for (int mt = 0; mt < 2; ++mt) { ah[mt] = *(const LAS bf16x8*)(TH + (16 * mt + fr) * RT_PITCH + k0 * 2); al[mt] = *(const LAS bf16x8*)(TL + (16 * mt + fr) * RT_PITCH + k0 * 2); }
#pragma unroll
            for (int nt = 0; nt < 3; ++nt) { bh[nt] = *(const bf16x8*)(WRT + (size_t)(16 * nt + fr) * 1024 + k0); bl[nt] = *(const bf16x8*)(WRT + (size_t)(48 + 16 * nt + fr) * 1024 + k0); }
#pragma unroll
            for (int mt = 0; mt < 2; ++mt)
#pragma unroll
                for (int nt = 0; nt < 3; ++nt) {
                    acc[mt][nt] = __builtin_amdgcn_mfma_f32_16x16x32_bf16(ah[mt], bh[nt], acc[mt][nt], 0, 0, 0);
                    acc[mt][nt] = __builtin_amdgcn_mfma_f32_16x16x32_bf16(ah[mt], bl[nt], acc[mt][nt], 0, 0, 0);
                    acc[mt][nt] = __builtin_amdgcn_mfma_f32_16x16x32_bf16(al[mt], bh[nt], acc[mt][nt], 0, 0, 0); } }
        __syncthreads();
        TSE(101); TSB(102);
#pragma unroll
        for (int mt = 0; mt < 2; ++mt)
#pragma unroll
            for (int nt = 0; nt < 3; ++nt)
#pragma unroll
                for (int reg = 0; reg < 4; ++reg) PART[(wid * 32 + 16 * mt + 4 * fq + reg) * 48 + 16 * nt + fr] = acc[mt][nt][reg];
        __syncthreads();
        for (int idx = F.tid; idx < 32 * 36; idx += NTHREADS) { const int r = idx / 36, o = idx - r * 36; float sacc = o < 4 ? bg[o] : bfp[o - 4];
#pragma unroll
            for (int w = 0; w < 8; ++w) sacc += PART[(w * 32 + r) * 48 + o];
            LOG[r * 36 + o] = sacc; }
        __syncthreads();
        if (F.tid < 32) { const int r = F.tid, row = tile * 32 + r; const LAS float* L = LOG + r * 36;
            const float g0 = L[0], g1 = L[1], g2 = L[2], g3 = L[3];
            int gi = 0; float gm = g0;
            if (g1 > gm) { gm = g1; gi = 1; }
            if (g2 > gm) { gm = g2; gi = 2; }
            if (g3 > gm) { gm = g3; gi = 3; }
            const float pg = 1.f / (expf(g0 - gm) + expf(g1 - gm) + expf(g2 - gm) + expf(g3 - gm));
            int i0 = 0; float v0 = -INFINITY; int i1 = 0; float v1 = -INFINITY;
#pragma unroll
            for (int j = 0; j < 8; ++j) { const float vv = L[4 + gi * 8 + j];
                if (vv > v0) { v1 = v0; i1 = i0; v0 = vv; i0 = j; } else if (vv > v1) { v1 = vv; i1 = j; } }
            const float e1 = expf(v1 - v0); const float w0 = 1.f / (1.f + e1), w1 = e1 / (1.f + e1);
            const int ea = gi * 8 + i0, eb = gi * 8 + i1; eidx[row * 2] = ea; eidx[row * 2 + 1] = eb; ew[row * 2] = w0 * pg; ew[row * 2 + 1] = w1 * pg;
            __hip_atomic_fetch_add(hist + ea, 1u, __ATOMIC_RELAXED, __HIP_MEMORY_SCOPE_WORKGROUP); __hip_atomic_fetch_add(hist + eb, 1u, __ATOMIC_RELAXED, __HIP_MEMORY_SCOPE_WORKGROUP); }
        __syncthreads();
        TSE(102);
    }
    if (F.tid < 32) { const unsigned c = hist[F.tid]; atomicAdd(cnt + F.tid, c); bcnt[(size_t)blockIdx.x * 32 + F.tid] = c; }
}
__device__ __forceinline__ void row_phase_b(Frame& F, int layer, bool make_h) {
    const int gw = F.vcu * NWAVES + F.wave, NGW = F.G * NWAVES, r4 = F.lane >> 5, sub = F.lane & 31; const float* mods = (const float*)(F.ws + WS_MODS) + (size_t)layer * 9 * 6144;
    const float* modn = (const float*)(F.ws + WS_MODS) + (size_t)(layer + 1) * 9 * 6144;
    const bf16_t* MO = (const bf16_t*)(F.ws + WS_R1); bf16_t* H = (bf16_t*)(F.ws + WS_R0); float* X = F.out;
    const float* lg = F.in[6] + (size_t)(layer * 2 + 1) * D; const float* lb = F.in[7] + (size_t)(layer * 2 + 1) * D;
    for (int quad = gw; quad < NLAT / 2; quad += NGW) { const int row = quad * 2 + r4;
        const int b = row >> 12; const float* mr = mods + (size_t)b * 6144;
        f32x4 v[8];
#pragma unroll
        for (int j = 0; j < 8; ++j) { const int q = sub + 32 * j; const u32x2 m0 = ((const u32x2*)(MO + (size_t)row * D))[q], m1 = ((const u32x2*)(MO + ((size_t)NLAT + row) * D))[q];
            const f32x4 m = (f32x4){bflo(m0.x) + bflo(m1.x), bfhi(m0.x) + bfhi(m1.x), bflo(m0.y) + bflo(m1.y), bfhi(m0.y) + bfhi(m1.y)};
            v[j] = ((const f32x4*)(X + (size_t)row * D))[q] * ALPHA + ((const f32x4*)(mr + 5 * 1024))[q] * m; }
        float mean, rstd; ln_stats16(v, mean, rstd);
#pragma unroll
        for (int j = 0; j < 8; ++j) { const int q = sub + 32 * j; v[j] = (v[j] - mean) * rstd * ((const f32x4*)lg)[q] + ((const f32x4*)lb)[q]; ((f32x4*)(X + (size_t)row * D))[q] = v[j]; }
        if (make_h) { const float* mn = modn + (size_t)b * 6144;
            ln_stats16(v, mean, rstd);
#pragma unroll
            for (int j = 0; j < 8; ++j) { const int q = sub + 32 * j; const f32x4 o = (v[j] - mean) * rstd * (((const f32x4*)(mn + 1024))[q] + 1.f) + ((const f32x4*)mn)[q];
                ((u32x2*)(H + (size_t)row * D))[q] = (u32x2){pk2(o.x, o.y), pk2(o.z, o.w)}; } }
    }
}

__device__ __forceinline__ void moe_tile_prefix(Frame& F, int layer) {
    volatile LAS int* ts = (volatile LAS int*)(F.lds + LDSCTL_OFF + LC_TSTART);
    if (F.tid == 0) { int acc = 0; for (int e = 0; e < NE; ++e) { ts[e] = acc; acc += (int)((xb_ld(F.ctl + CW_CNT + layer * 128 + e) + 255u) >> 8); } ts[NE] = acc; }
    __syncthreads();
}
__device__ __forceinline__ void moe_positions(Frame& F, int layer) {
    moe_tile_prefix(F, layer);
    const LAS int* ts = (const LAS int*)(F.lds + LDSCTL_OFF + LC_TSTART);
    const int* eidx = (const int*)(F.ws + WS_MISC + MISC_EIDX); int* rowtok = (int*)(F.ws + WS_MISC + MISC_ROWTOK);
    const unsigned* bcnt = (const unsigned*)(F.ws + WS_MISC + MISC_BCNT); unsigned* cnt = F.ctl + CW_CNT + layer * 128;
    const bf16_t* T = (const bf16_t*)(F.ws + WS_R0); bf16_t* TS = (bf16_t*)(F.ws + WS_R1);
    LAS unsigned* part = (LAS unsigned*)F.lds;
    LAS unsigned* base = (LAS unsigned*)(F.lds + LDSCTL_OFF + LC_BASE); LAS unsigned* lcur = (LAS unsigned*)(F.lds + LDSCTL_OFF + LC_LCUR); LAS int* posl = (LAS int*)(F.lds + LDSCTL_OFF + LC_POS);
    const int blk = (int)blockIdx.x, APB = (2 * NLAT) / F.G;
    { const int e = F.tid & 31, p = F.tid >> 5; unsigned sacc = 0u; for (int bb = p; bb < blk; bb += 16) sacc += bcnt[(size_t)bb * 32 + e]; part[p * 32 + e] = sacc; }
    __syncthreads();
    if (F.tid < 32) { unsigned sacc = 0u;
#pragma unroll
        for (int p = 0; p < 16; ++p) sacc += part[p * 32 + F.tid];
        base[F.tid] = (unsigned)ts[F.tid] * 256u + sacc; lcur[F.tid] = 0u; }
    __syncthreads();
    for (int al = F.tid; al < APB; al += NTHREADS) { const int a = blk * APB + al; const int e = eidx[a];
        const int pos = (int)(base[e] + __hip_atomic_fetch_add(lcur + e, 1u, __ATOMIC_RELAXED, __HIP_MEMORY_SCOPE_WORKGROUP)); rowtok[pos] = a; posl[al] = pos; }
    __syncthreads();
    for (int al = F.wave; al < APB; al += NWAVES) { const int pj = posl[al]; const int tok = (blk * APB + al) >> 1;
        const u32x4* sp = (const u32x4*)(T + (size_t)tok * D); u32x4* dp = (u32x4*)(TS + (size_t)pj * D);
        dp[F.lane] = sp[F.lane]; dp[64 + F.lane] = sp[64 + F.lane]; }
    const int gt = F.vcu * NTHREADS + F.tid;
    if (gt < NE * 256) { const int e = gt >> 8, r = gt & 255; const int c = (int)xb_ld(cnt + e); const int padded = (c + 255) & ~255; if (c + r < padded) rowtok[ts[e] * 256 + c + r] = -1; }
    __syncthreads();
}

struct DenseOrder {            __device__ __forceinline__ int rowoffB(int R, int pitch) const { return R * pitch; }
    int nM, nN, nwg, G, c; const char* A; const char* B; size_t strideA, strideB;
    __device__ void init(int nM_, int nN_, int G_, int c_, const void* A_, size_t sA, const void* B_, size_t sB) { nM = nM_; nN = nN_; nwg = nM * nN; G = G_; c = c_; A = (const char*)A_; B = (const char*)B_; strideA = sA; strideB = sB; }
    __device__ bool next(int i, pg8::Unit& u) const {
        const long L = (long)i * G + c; if (L >= nwg) return false;
        int wgid = (int)L; { const int q = nwg / 8, r = nwg % 8, xcd = wgid % 8, off = wgid / 8; wgid = (xcd < r ? xcd * (q + 1) : r * (q + 1) + (xcd - r) * q) + off; }
        const int nig = 8 * nN, gid = wgid / nig, fm = gid * 8, gsz = (nM - fm) < 8 ? (nM - fm) : 8;
        u.pm = fm + ((wgid % nig) % gsz); u.pn = (wgid % nig) / gsz; u.A = A + (size_t)u.pm * strideA; u.B = B + (size_t)u.pn * strideB; return true;
    }
};
struct MoeOrder {              __device__ __forceinline__ int rowoffB(int R, int pitch) const { return R * pitch; }
    const LAS int* ts; int G, c; const char* A; const char* W; size_t strideA, strideE, strideN;
    __device__ bool next(int i, pg8::Unit& u) const {
        const int L = i * G + c; const int ntile = ts[NE]; if (L >= ntile * 4) return false;
        const int rt = L >> 2, pn = L & 3; int e = 0;
#pragma unroll 1
        for (int q = 1; q < NE; ++q) e += (ts[q] <= rt) ? 1 : 0;
        u.pm = rt; u.pn = pn; u.A = A + (size_t)rt * strideA; u.B = W + (size_t)e * strideE + (size_t)pn * strideN; return true;
    }
};
struct ChanDftOrder {
    int G, c; const char* A; const char* H;
    __device__ __forceinline__ int rowoffB(int R, int pitch) const { return ((R & 63) * 64 + (R >> 6)) * pitch; }
    __device__ bool next(int i, pg8::Unit& u) const {
        const int L = i * G + c; if (L >= 1024) return false;
        const int nt = L >> 3, g = (L >> 1) & 3, mt = L & 1, b = nt >> 4, t2 = nt & 15;
        u.pm = g * 2 + mt; u.pn = nt; u.A = A + (size_t)mt * 256 * 256 * 2; u.B = H + ((size_t)(b * SEQ + 4 * t2) * D + g * 256) * 2; return true;
    }
};
struct Dft1Order {
    int G, c; const char* A; const char* GT1;
    __device__ __forceinline__ int rowoffB(int R, int pitch) const { return (R >> 6) * 8192 + (R & 63) * 64; }
    __device__ bool next(int i, pg8::Unit& u) const {
        const int L = i * G + c; if (L >= NB * 256) return false;
        u.pm = 0; u.pn = L; u.A = A; u.B = GT1 + (size_t)L * 4 * 8192 * 2; return true;
    }
};
struct Dft2Order {
    int G, c; const char* A; const char* U;
    __device__ __forceinline__ int rowoffB(int R, int pitch) const { return R * pitch; }
    __device__ bool next(int i, pg8::Unit& u) const {
        const int L = i * G + c; if (L >= NB * 64 * 4) return false;
        const int pn = L & 3, ka = (L >> 2) & 63, b = L >> 8;
        u.pm = b * 64 + ka; u.pn = pn; u.A = A; u.B = U + ((size_t)(b * 1024 + pn * 256) * 8192 + ka * 64) * 2; return true;
    }
};

struct EpiInProj {
    static constexpr bool PERM = true;
    bf16_t *GX, *QB, *KB, *VB; const float* rope;
    __device__ __forceinline__ void operator()(const f32x4 (&acc)[2][2][4][2], const pg8::Unit& u, int wr, int wc, int fr, int fq) const {
        const int region = u.pn >> 1, cb = (u.pn & 1) * 256 + wc * 32 + 8 * fq; const bool latent = u.pm < (NLAT / 256);
        const bool dorope = latent && (region == 2 || region == 3); const int axis = wc & 1, half = fq >> 1, f0 = 8 * (fq & 1);
        if (region == 2 && !latent) return;
#pragma unroll
        for (int ai = 0; ai < 2; ++ai)
#pragma unroll
            for (int m = 0; m < 4; ++m) { const int row = u.pm * 256 + ai * 128 + wr * 64 + m * 16 + fr;
#pragma unroll
                for (int bj = 0; bj < 2; ++bj) { const int c = cb + bj * 128; float v[8];
#pragma unroll
                    for (int i = 0; i < 4; ++i) { v[i] = acc[ai][bj][m][0][i]; v[4 + i] = acc[ai][bj][m][1][i]; }
                    if (dorope) { const int tn = row & 4095, pos = axis ? (tn & 63) : (tn >> 6); const f32x4* cs = (const f32x4*)(rope + (size_t)(pos * 16 + f0) * 2);
                        const f32x4 c0 = cs[0], c1 = cs[1], c2 = cs[2], c3 = cs[3];
                        const float co[8] = {c0.x, c0.z, c1.x, c1.z, c2.x, c2.z, c3.x, c3.z}, si[8] = {c0.y, c0.w, c1.y, c1.w, c2.y, c2.w, c3.y, c3.w};
#pragma unroll
                        for (int i = 0; i < 8; ++i) { const float pv = __shfl_xor(v[i], 32); v[i] = v[i] * co[i] + (half ? pv : -pv) * si[i]; } }
                    if (region == 2) {
#pragma unroll
                        for (int i = 0; i < 8; ++i) v[i] *= QSCALE; }
                    const u32x4 w = (u32x4){pg8::cvt_pk_bf16(v[0], v[1]), pg8::cvt_pk_bf16(v[2], v[3]), pg8::cvt_pk_bf16(v[4], v[5]), pg8::cvt_pk_bf16(v[6], v[7])};
                    bf16_t* dst = region == 0 ? GX + (size_t)row * D + c : region == 1 ? GX + (size_t)row * D + 512 + c : region == 2 ? QB + (size_t)row * 512 + c : region == 3 ? KB + (size_t)row * 512 + c : VB + (size_t)row * 512 + c;
                    *(u32x4*)dst = w; } }
    }
};
struct EpiF32 {
    static constexpr bool PERM = false;
    float* C;
    __device__ __forceinline__ void operator()(const f32x4 (&acc)[2][2][4][2], const pg8::Unit& u, int wr, int wc, int fr, int fq) const {
        const int row0 = u.pm * 256 + wr * 64 + fr, col0 = u.pn * 256 + wc * 32 + 4 * fq;
#pragma unroll
        for (int ai = 0; ai < 2; ++ai)
#pragma unroll
            for (int m = 0; m < 4; ++m) { float* rowp = C + (size_t)(row0 + ai * 128 + m * 16) * D + col0;
#pragma unroll
                for (int bj = 0; bj < 2; ++bj)
#pragma unroll
                    for (int n = 0; n < 2; ++n) *(f32x4*)(rowp + bj * 128 + n * 16) = acc[ai][bj][m][n]; }
    }
};
struct EpiSwiGLU {
    static constexpr bool PERM = true;
    bf16_t* HID;
    __device__ __forceinline__ void operator()(const f32x4 (&acc)[2][2][4][2], const pg8::Unit& u, int wr, int wc, int fr, int fq) const {
        const int cb = u.pn * 256 + wc * 32 + 8 * fq;
#pragma unroll
        for (int ai = 0; ai < 2; ++ai)
#pragma unroll
            for (int m = 0; m < 4; ++m) { const int row = u.pm * 256 + ai * 128 + wr * 64 + m * 16 + fr;
#pragma unroll
                for (int bj = 0; bj < 2; ++bj) { const int j0 = ((cb + bj * 128) >> 3) * 4; const f32x4 a = acc[ai][bj][m][0], b = acc[ai][bj][m][1];
                    const float h0 = silu_f(a[0]) * b[0], h1 = silu_f(a[1]) * b[1], h2 = silu_f(a[2]) * b[2], h3 = silu_f(a[3]) * b[3];
                    *(u32x2*)(HID + (size_t)row * FF + j0) = (u32x2){pg8::cvt_pk_bf16(h0, h1), pg8::cvt_pk_bf16(h2, h3)}; } }
    }
};
struct EpiScatter {
    static constexpr bool PERM = true;
    bf16_t* MOUT; const int* rowtok; const float* ew;
    __device__ __forceinline__ void operator()(const f32x4 (&acc)[2][2][4][2], const pg8::Unit& u, int wr, int wc, int fr, int fq) const {
        const int cb = u.pn * 256 + wc * 32 + 8 * fq;
#pragma unroll
        for (int ai = 0; ai < 2; ++ai)
#pragma unroll
            for (int m = 0; m < 4; ++m) { const int row = u.pm * 256 + ai * 128 + wr * 64 + m * 16 + fr; const int a = rowtok[row];
                if (a >= 0) { const float w = ew[a]; bf16_t* dst = MOUT + ((size_t)(a & 1) * NLAT + (a >> 1)) * D + cb;
#pragma unroll
                    for (int bj = 0; bj < 2; ++bj) { const f32x4 x = acc[ai][bj][m][0] * w, y = acc[ai][bj][m][1] * w;
                        *(u32x4*)(dst + bj * 128) = (u32x4){pg8::cvt_pk_bf16(x[0], x[1]), pg8::cvt_pk_bf16(x[2], x[3]), pg8::cvt_pk_bf16(y[0], y[1]), pg8::cvt_pk_bf16(y[2], y[3])}; } } }
    }
};
struct EpiGT1 {
    static constexpr bool PERM = true;
    bf16_t* GT1;
    __device__ __forceinline__ void operator()(const f32x4 (&acc)[2][2][4][2], const pg8::Unit& u, int wr, int wc, int fr, int fq) const {
        const int g = u.pm >> 1, mt = u.pm & 1, b = u.pn >> 4, t2 = u.pn & 15; const int cl0 = wc * 32 + 8 * fq;
#pragma unroll
        for (int ai = 0; ai < 2; ++ai)
#pragma unroll
            for (int m = 0; m < 4; ++m) { const int mrow = mt * 256 + ai * 128 + wr * 64 + m * 16 + fr; const int chan = g * 256 + (mrow & 255), part = mrow >> 8;
#pragma unroll
                for (int bj = 0; bj < 2; ++bj) { const int cl = cl0 + bj * 128, n2 = 4 * t2 + (cl >> 6), n1 = cl & 63; const f32x4 x = acc[ai][bj][m][0], y = acc[ai][bj][m][1];
                    *(u32x4*)(GT1 + ((size_t)((b * 1024 + chan) * 2 + part) * 4096) + n2 * 64 + n1) = (u32x4){pg8::cvt_pk_bf16(x[0], x[1]), pg8::cvt_pk_bf16(x[2], x[3]), pg8::cvt_pk_bf16(y[0], y[1]), pg8::cvt_pk_bf16(y[2], y[3])}; } }
    }
};
struct EpiTw {
    static constexpr bool PERM = true;
    bf16_t* U; const float* tw;
    __device__ __forceinline__ void operator()(const f32x4 (&acc)[2][2][4][2], const pg8::Unit& u, int wr, int wc, int fr, int fq) const {
        const int b = u.pn >> 8, q = u.pn & 255; const int cl0 = wc * 32 + 8 * fq;
#pragma unroll
        for (int mp = 0; mp < 2; ++mp) { const int ka = 32 * wr + 16 * mp + fr;
#pragma unroll
            for (int bj = 0; bj < 2; ++bj) { const int cl = cl0 + bj * 128, chan = 4 * q + (cl >> 6), n2 = cl & 63;
                const f32x4* t4 = (const f32x4*)(tw + ((size_t)ka * 64 + n2) * 2); const f32x4 w0 = t4[0], w1 = t4[1], w2 = t4[2], w3 = t4[3];
                const float co[8] = {w0.x, w0.z, w1.x, w1.z, w2.x, w2.z, w3.x, w3.z}, si[8] = {w0.y, w0.w, w1.y, w1.w, w2.y, w2.w, w3.y, w3.w};
                float ur[8], ui[8];
#pragma unroll
                for (int i = 0; i < 8; ++i) { const float tr = acc[0][bj][mp][i >> 2][i & 3], ti = acc[0][bj][mp + 2][i >> 2][i & 3]; ur[i] = tr * co[i] + ti * si[i]; ui[i] = ti * co[i] - tr * si[i]; }
                bf16_t* dst = U + ((size_t)((b * 1024 + chan) * 2) * 4096) + ka * 64 + n2;
                *(u32x4*)dst = (u32x4){pg8::cvt_pk_bf16(ur[0], ur[1]), pg8::cvt_pk_bf16(ur[2], ur[3]), pg8::cvt_pk_bf16(ur[4], ur[5]), pg8::cvt_pk_bf16(ur[6], ur[7])};
                *(u32x4*)(dst + 4096) = (u32x4){pg8::cvt_pk_bf16(ui[0], ui[1]), pg8::cvt_pk_bf16(ui[2], ui[3]), pg8::cvt_pk_bf16(ui[4], ui[5]), pg8::cvt_pk_bf16(ui[6], ui[7])}; } }
    }
};
struct EpiYF2 {
    static constexpr bool PERM = true;
    bf16_t* YF;
    __device__ __forceinline__ void operator()(const f32x4 (&acc)[2][2][4][2], const pg8::Unit& u, int wr, int wc, int fr, int fq) const {
        if (wr != 0) return;
        const int b = u.pm >> 6, ka = u.pm & 63; const int cb = u.pn * 256 + wc * 32 + 8 * fq;
#pragma unroll
        for (int m = 0; m < 4; ++m) { const int kb = 16 * m + fr; bf16_t* dst = YF + ((size_t)b * SEQ + ka + 64 * kb) * D + cb;
#pragma unroll
            for (int bj = 0; bj < 2; ++bj) { const f32x4 x = acc[0][bj][m][0] * (1.f / 1024.f), y = acc[0][bj][m][1] * (1.f / 1024.f);
                *(u32x4*)(dst + bj * 128) = (u32x4){pg8::cvt_pk_bf16(x[0], x[1]), pg8::cvt_pk_bf16(x[2], x[3]), pg8::cvt_pk_bf16(y[0], y[1]), pg8::cvt_pk_bf16(y[2], y[3])}; } }
    }
};
struct EpiBf16S {
    static constexpr bool PERM = true;
    bf16_t* O; float scale;
    __device__ __forceinline__ void operator()(const f32x4 (&acc)[2][2][4][2], const pg8::Unit& u, int wr, int wc, int fr, int fq) const {
        const int cb = u.pn * 256 + wc * 32 + 8 * fq;
#pragma unroll
        for (int ai = 0; ai < 2; ++ai)
#pragma unroll
            for (int m = 0; m < 4; ++m) { const int row = u.pm * 256 + ai * 128 + wr * 64 + m * 16 + fr;
#pragma unroll
                for (int bj = 0; bj < 2; ++bj) { const f32x4 x = acc[ai][bj][m][0] * scale, y = acc[ai][bj][m][1] * scale;
                    *(u32x4*)(O + (size_t)row * D + cb + bj * 128) = (u32x4){pg8::cvt_pk_bf16(x[0], x[1]), pg8::cvt_pk_bf16(x[2], x[3]), pg8::cvt_pk_bf16(y[0], y[1]), pg8::cvt_pk_bf16(y[2], y[3])}; } }
    }
};
template <class Epi, class Sched> __device__ __forceinline__ void run_gemm(Frame& F, const pg8::Shape g, const Sched& S, const Epi& E) {
#if FAST_GEMM
    pg8::Shape gg = g; asm volatile("" : "+s"(gg.K));
    pg8::gemm_phase<Epi, Sched, true>(F.lds, gg, S, E);
#else
    pg8::gemm_phase_ref<Epi, Sched>(g, S, E);
#endif
}

__device__ __forceinline__ void lru_simple(Frame& F, int b) {
    const bf16_t* GX = (const bf16_t*)(F.ws + WS_R1 + R1_GX); bf16_t* CAT = (bf16_t*)(F.ws + WS_R0); float* YF = (float*)(F.ws + WS_R2);
    const float* cw = F.in[9]; const float* cbp = F.in[10]; const float* sp = (const float*)(F.ws + WS_SMALL) + 64;
    LAS bf16_t* wl = (LAS bf16_t*)F.lds;
    LAS float* xs = (LAS float*)(F.lds + LDSCTL_OFF + LC_XS);
    const int c = F.tid, h = c >> 6, j = c & 63;
    const float w0 = cw[c], w1 = cw[LW + c], w2 = cw[2 * LW + c], w3 = cw[3 * LW + c], cb = cbp[c];
    for (int d = 0; d < 2; ++d) {
        __syncthreads();
        for (int i = F.tid; i < 2 * 8 * 64 * 64; i += NTHREADS) { const int jj = i & 63, ii = (i >> 6) & 63, hh = (i >> 12) & 7, t = i >> 15; const float* w = t ? F.in[13] : F.in[11];
            wl[i] = (bf16_t)f2bf(w[(((size_t)d * 8 + hh) * 64 + ii) * 64 + jj]); }
        __syncthreads();
        const float ba = F.in[12][d * LW + c], bx = F.in[14][d * LW + c], spc = sp[d * LW + c];
        float hst = 0.f;
        for (int step = 0; step < CTX + SEQ; ++step) {
            const bool isctx = step < CTX; const int n = isctx ? (d == 0 ? step : CTX - 1 - step) : (d == 0 ? step - CTX : SEQ - 1 - (step - CTX));
            const int len = isctx ? CTX : SEQ; const size_t row0 = isctx ? (size_t)NLAT + (size_t)b * CTX : (size_t)b * SEQ;
            float xc = cb;
            if (n - 2 >= 0) xc += bf2f(GX[(row0 + n - 2) * D + 512 + c]) * w0;
            if (n - 1 >= 0) xc += bf2f(GX[(row0 + n - 1) * D + 512 + c]) * w1;
            xc += bf2f(GX[(row0 + n) * D + 512 + c]) * w2;
            if (n + 1 < len) xc += bf2f(GX[(row0 + n + 1) * D + 512 + c]) * w3;
            __syncthreads();
            xs[c] = bf2f(f2bf(xc));
            __syncthreads();
            float ra = 0.f, rx = 0.f;
            for (int i = 0; i < 64; ++i) { const float xv = xs[h * 64 + i]; ra += xv * bf2f(wl[((0 * 8 + h) * 64 + i) * 64 + j]); rx += xv * bf2f(wl[((1 * 8 + h) * 64 + i) * 64 + j]); }
            const float r = sigmoid_f(ra + ba), ig = sigmoid_f(rx + bx);
            const float log_a = -8.f * spc * r; const float a = expf(log_a); const float mult = sqrtf(-expm1f(2.f * log_a));
            hst = a * hst + mult * ig * xc;
            if (!isctx) { const size_t o = ((size_t)b * SEQ + n) * LW + c;
                if (d == 0) YF[o] = hst;
                else { const float g = bf2f(GX[((size_t)b * SEQ + n) * D + c]); CAT[((size_t)b * SEQ + n) * D + c] = (bf16_t)f2bf((YF[o] + hst) * gelu_tanh_f(g)); } }
        }
    }
    __syncthreads();
}

__device__ __forceinline__ void attn_simple(Frame& F) {
    const bf16_t* QB = (const bf16_t*)(F.ws + WS_R1 + R1_QB); const bf16_t* KB = (const bf16_t*)(F.ws + WS_R1 + R1_KB); const bf16_t* VB = (const bf16_t*)(F.ws + WS_R1 + R1_VB);
    bf16_t* CAT = (bf16_t*)(F.ws + WS_R0); const float lam = ((const float*)(F.ws + WS_SMALL))[0]; const float* subln = F.in[17];
    LAS float* Qs = (LAS float*)F.lds;
    LAS float* Ks = Qs + 64 * 128;
    LAS float* Vs = Ks + 64 * 129;
    LAS float* Ps = Vs + 64 * 128;
    const int lane = F.lane, wv = F.wave;
    for (int u = F.vcu; u < NB * NH * (SEQ / 64); u += F.G) {
        const int qb = u & 63, h = (u >> 6) & 3, b = u >> 8;
        __syncthreads();
        for (int i = F.tid; i < 64 * 128; i += NTHREADS) { const int r = i >> 7, cc = i & 127; Qs[i] = bf2f(QB[((size_t)b * SEQ + qb * 64 + r) * 512 + h * 128 + cc]); }
        float m1[8], m2[8], l1[8], l2[8], o1a[8], o1b[8], o2a[8], o2b[8];
#pragma unroll
        for (int r = 0; r < 8; ++r) { m1[r] = -INFINITY; m2[r] = -INFINITY; l1[r] = 0.f; l2[r] = 0.f; o1a[r] = 0.f; o1b[r] = 0.f; o2a[r] = 0.f; o2b[r] = 0.f; }
        for (int pass = 0; pass < 2; ++pass) {
            for (int t = 0; t < (CTX + SEQ) / 64; ++t) {
                const size_t krow0 = t < 4 ? (size_t)NLAT + (size_t)b * CTX + t * 64 : (size_t)b * SEQ + (t - 4) * 64;
                __syncthreads();
                for (int i = F.tid; i < 64 * 128; i += NTHREADS) { const int r = i >> 7, cc = i & 127; Ks[r * 129 + cc] = bf2f(KB[(krow0 + r) * 512 + h * 128 + cc]); Vs[i] = bf2f(VB[(krow0 + r) * 512 + h * 128 + cc]); }
                __syncthreads();
#pragma unroll
                for (int r = 0; r < 8; ++r) {
                    const LAS float* q = Qs + (wv * 8 + r) * 128; const LAS float* k = Ks + lane * 129;
                    float s1 = 0.f, s2 = 0.f;
                    for (int dd = 0; dd < 64; ++dd) { s1 += q[dd] * k[dd]; s2 += q[64 + dd] * k[64 + dd]; }
                    if (pass == 0) { m1[r] = fmaxf(m1[r], s1); m2[r] = fmaxf(m2[r], s2); }
                    else {
                        const float p1 = exp2f(s1 - m1[r]), p2 = exp2f(s2 - m2[r]);
                        l1[r] += p1; l2[r] += p2;
                        Ps[(wv * 2 + 0) * 64 + lane] = p1; Ps[(wv * 2 + 1) * 64 + lane] = p2;
                        LDS_WAIT(); asm volatile("" ::: "memory");
                        float a0 = 0.f, a1 = 0.f, c0 = 0.f, c1 = 0.f;
                        for (int kk = 0; kk < 64; ++kk) { const float pp1 = Ps[(wv * 2 + 0) * 64 + kk], pp2 = Ps[(wv * 2 + 1) * 64 + kk]; const float va = Vs[kk * 128 + lane], vb = Vs[kk * 128 + 64 + lane];
                            a0 += pp1 * va; a1 += pp1 * vb; c0 += pp2 * va; c1 += pp2 * vb; }
                        o1a[r] += a0; o1b[r] += a1; o2a[r] += c0; o2b[r] += c1;
                        LDS_WAIT(); asm volatile("" ::: "memory");
                    }
                }
            }
            if (pass == 0) {
#pragma unroll
                for (int r = 0; r < 8; ++r) { m1[r] = wave_max(m1[r]); m2[r] = wave_max(m2[r]); }
            }
        }
#pragma unroll
        for (int r = 0; r < 8; ++r) {
            const float L1 = wave_sum(l1[r]), L2 = wave_sum(l2[r]);
            const float oa = o1a[r] / L1 - lam * o2a[r] / L2, ob = o1b[r] / L1 - lam * o2b[r] / L2;
            const float ms = wave_sum(oa * oa + ob * ob) * (1.f / 128.f); const float rs = 1.f / sqrtf(ms + LN_EPS);
            bf16_t* dst = CAT + ((size_t)b * SEQ + qb * 64 + wv * 8 + r) * D + 512 + h * 128;
            dst[lane] = (bf16_t)f2bf(oa * rs * subln[lane] * 0.8f); dst[64 + lane] = (bf16_t)f2bf(ob * rs * subln[64 + lane] * 0.8f);
        }
    }
    __syncthreads();
}

namespace att {
typedef float f32x16 __attribute__((ext_vector_type(16)));
typedef short s16x4 __attribute__((ext_vector_type(4)));
typedef short v4i16_t __attribute__((ext_vector_type(4)));
constexpr int KSLOT = 8192, VSLOT = 16384, NSLOT = 3, NT = (CTX + SEQ) / 64;
constexpr int L_K = 0, L_V = NSLOT * KSLOT, L_WS = L_V + NSLOT * VSLOT;
__device__ __forceinline__ int crow(int r, int hi) { return (r & 3) + 8 * (r >> 2) + 4 * hi; }
#define ATT_WAITBAR(N) asm volatile("s_waitcnt vmcnt(" #N ") lgkmcnt(0)\n\ts_barrier" ::: "memory")
__device__ __forceinline__ unsigned cvtpk(float lo, float hi) { unsigned r; asm("v_cvt_pk_bf16_f32 %0, %1, %2" : "=v"(r) : "v"(lo), "v"(hi)); return r; }
__device__ __forceinline__ s16x4 vtr(const LAS unsigned char* p) { return __builtin_bit_cast(s16x4, __builtin_amdgcn_ds_read_tr16_b64_v4i16((LAS v4i16_t*)p)); }

__device__ __forceinline__ void attn_fast(Frame& F) {
    const bf16_t* QB = (const bf16_t*)(F.ws + WS_R1 + R1_QB); const bf16_t* KB = (const bf16_t*)(F.ws + WS_R1 + R1_KB); const bf16_t* VB = (const bf16_t*)(F.ws + WS_R1 + R1_VB);
    bf16_t* CAT = (bf16_t*)(F.ws + WS_R0); const float lam = ((const float*)(F.ws + WS_SMALL))[0]; const float* subln = F.in[17];
    LAS unsigned char* lds = F.lds;
    const int lane = F.lane, r32 = lane & 31, hi = lane >> 5, wid = F.wave;
    LAS float* wsf = (LAS float*)(lds + L_WS) + wid * 64;
    for (int u = F.vcu; u < NB * NH * (SEQ / 256); u += F.G) {
        const int bh = u >> 4, qb = u & 15, b = bh >> 2, h = bh & 3;
        const size_t qrow = (size_t)b * SEQ + qb * 256 + wid * 32;
        unsigned o2p[4][8];
        f32x16 o[4];
#pragma unroll 1
        for (int pass = 0; pass < 2; ++pass) {
            const int s = 1 - pass;
            bf16x8 qf[4];
#pragma unroll
            for (int d0 = 0; d0 < 4; ++d0) qf[d0] = *(const bf16x8*)(QB + (qrow + r32) * 512 + h * 128 + s * 64 + d0 * 16 + hi * 8);
#pragma unroll
            for (int dq = 0; dq < 4; ++dq)
#pragma unroll
                for (int r = 0; r < 16; ++r) o[dq][r] = 0.f;
            float lsum = 0.f;
            const bf16_t* ksrc = KB + (size_t)lane * 512 + h * 128 + s * 64 + wid * 8;
            const bf16_t* vsrc0 = VB + (size_t)(16 * ((wid * 2) & 3) + (lane >> 2)) * 512 + h * 128 + ((wid * 2) >> 2) * 32 + (lane & 3) * 8;
            const bf16_t* vsrc1 = VB + (size_t)(16 * ((wid * 2 + 1) & 3) + (lane >> 2)) * 512 + h * 128 + ((wid * 2 + 1) >> 2) * 32 + (lane & 3) * 8;
#define ATT_DMA(t, slot) do { const size_t r0_ = ((t) < 4 ? (size_t)NLAT + (size_t)b * CTX + (t) * 64 : (size_t)b * SEQ + ((t) - 4) * 64) * 512; \
        __builtin_amdgcn_global_load_lds((const unsigned*)(ksrc + r0_), (LAS unsigned*)(lds + L_K + (slot) * KSLOT + wid * 1024), 16, 0, 0); \
        __builtin_amdgcn_global_load_lds((const unsigned*)(vsrc0 + r0_), (LAS unsigned*)(lds + L_V + (slot) * VSLOT + (wid * 2) * 1024), 16, 0, 0); \
        __builtin_amdgcn_global_load_lds((const unsigned*)(vsrc1 + r0_), (LAS unsigned*)(lds + L_V + (slot) * VSLOT + (wid * 2 + 1) * 1024), 16, 0, 0); } while (0)
            ATT_DMA(0, 0); ATT_DMA(1, 1);
            ATT_WAITBAR(3);
            int slot = 0;
#pragma unroll 1
            for (int t = 0; t < NT; ++t) {
                const int s2 = slot == 0 ? 2 : slot - 1;
                if (t + 2 < NT) ATT_DMA(t + 2, s2);
                f32x16 p0, p1;
#pragma unroll
                for (int r = 0; r < 16; ++r) { p0[r] = 0.f; p1[r] = 0.f; }
                const LAS unsigned char* kb = lds + L_K + slot * KSLOT + hi * 1024 + r32 * 16;
#pragma unroll
                for (int d0 = 0; d0 < 4; ++d0) {
                    const bf16x8 k0 = *(const LAS bf16x8*)(kb + d0 * 2048), k1 = *(const LAS bf16x8*)(kb + d0 * 2048 + 512);
                    p0 = __builtin_amdgcn_mfma_f32_32x32x16_bf16(k0, qf[d0], p0, 0, 0, 0);
                    p1 = __builtin_amdgcn_mfma_f32_32x32x16_bf16(k1, qf[d0], p1, 0, 0, 0);
                }
                float sa = 0.f, sb = 0.f;
#pragma unroll
                for (int r = 0; r < 16; ++r) { p0[r] = __builtin_amdgcn_exp2f(p0[r]); p1[r] = __builtin_amdgcn_exp2f(p1[r]); sa += p0[r]; sb += p1[r]; }
                lsum += sa + sb;
                u32x4 pk[4];
#pragma unroll
                for (int i = 0; i < 4; ++i) { pk[0][i] = cvtpk(p0[2 * i], p0[2 * i + 1]); pk[1][i] = cvtpk(p0[8 + 2 * i], p0[8 + 2 * i + 1]); pk[2][i] = cvtpk(p1[2 * i], p1[2 * i + 1]); pk[3][i] = cvtpk(p1[8 + 2 * i], p1[8 + 2 * i + 1]); }
                const LAS unsigned char* vb = lds + L_V + slot * VSLOT + ((lane >> 4) & 1) * 32 + (lane & 3) * 8 + (4 * hi + ((lane & 15) >> 2)) * 64;
#pragma unroll
                for (int dq = 0; dq < 4; ++dq)
#pragma unroll
                    for (int ks = 0; ks < 4; ++ks) {
                        const s16x4 vlo = vtr(vb + dq * 4096 + ks * 1024), vhi = vtr(vb + dq * 4096 + ks * 1024 + 512);
                        const bf16x8 vf = (bf16x8){vlo[0], vlo[1], vlo[2], vlo[3], vhi[0], vhi[1], vhi[2], vhi[3]};
                        o[dq] = __builtin_amdgcn_mfma_f32_32x32x16_bf16(__builtin_bit_cast(bf16x8, pk[ks]), vf, o[dq], 0, 0, 0);
                    }
                if (t + 2 < NT) ATT_WAITBAR(3); else ATT_WAITBAR(0);
                slot = slot == 2 ? 0 : slot + 1;
            }
#undef ATT_DMA
            { auto rr = __builtin_amdgcn_permlane32_swap(__float_as_uint(lsum), __float_as_uint(lsum), false, false); lsum = __uint_as_float(rr[0]) + __uint_as_float(rr[1]); }
            if (hi == 0) wsf[r32] = 1.0f / lsum;
            asm volatile("s_waitcnt lgkmcnt(0)" ::: "memory");
            float rl[16];
#pragma unroll
            for (int r = 0; r < 16; ++r) rl[r] = wsf[crow(r, hi)];
            asm volatile("s_waitcnt lgkmcnt(0)" ::: "memory");
            if (pass == 0) {
#pragma unroll
                for (int dq = 0; dq < 4; ++dq)
#pragma unroll
                    for (int i = 0; i < 8; ++i) o2p[dq][i] = cvtpk(lam * o[dq][2 * i] * rl[2 * i], lam * o[dq][2 * i + 1] * rl[2 * i + 1]);
            } else {
#pragma unroll
                for (int dq = 0; dq < 4; ++dq)
#pragma unroll
                    for (int r = 0; r < 16; ++r) o[dq][r] *= rl[r];
            }
        }
        float ss[16];
#pragma unroll
        for (int r = 0; r < 16; ++r) ss[r] = 0.f;
#pragma unroll
        for (int dq = 0; dq < 4; ++dq)
#pragma unroll
            for (int i = 0; i < 8; ++i) { const unsigned w = o2p[dq][i]; o[dq][2 * i] -= bflo(w); o[dq][2 * i + 1] -= bfhi(w); ss[2 * i] += o[dq][2 * i] * o[dq][2 * i]; ss[2 * i + 1] += o[dq][2 * i + 1] * o[dq][2 * i + 1]; }
#pragma unroll
        for (int r = 0; r < 16; ++r) {
#pragma unroll
            for (int off = 1; off < 32; off <<= 1) ss[r] += __shfl_xor(ss[r], off);
            ss[r] = 0.8f / sqrtf(ss[r] * (1.f / 128.f) + LN_EPS);
        }
#pragma unroll
        for (int dq = 0; dq < 4; ++dq) { const float g = subln[dq * 32 + r32];
#pragma unroll
            for (int r = 0; r < 16; ++r) CAT[(qrow + crow(r, hi)) * D + 512 + h * 128 + dq * 32 + r32] = (bf16_t)f2bf(o[dq][r] * ss[r] * g); }
    }
    asm volatile("s_waitcnt vmcnt(0) lgkmcnt(0)\n\ts_barrier" ::: "memory");
}
}

namespace lru {
constexpr int NCHUNK = 68, XCB_PITCH = 272;
constexpr int L_XCB = 0, L_XCF = 17408, L_Y0 = L_XCF + 33280, L_Y1 = L_Y0 + 33280;
constexpr int L_SUM = L_Y0, L_HIN = L_SUM + (NCHUNK + 4) * 1024;
constexpr int L_BIAS = L_HIN + 1024;
static_assert(L_BIAS + 3072 <= LDSCTL_OFF && L_HIN >= L_Y1 + 33280, "LRU LDS map");
template <int K> __device__ __forceinline__ float dpp_shr(float v, float ident) { return __int_as_float(__builtin_amdgcn_update_dpp(__float_as_int(ident), __float_as_int(v), 0x110 + K, 0xf, 0xf, false)); }
template <int K> __device__ __forceinline__ float dpp_shl(float v, float ident) { return __int_as_float(__builtin_amdgcn_update_dpp(__float_as_int(ident), __float_as_int(v), 0x100 + K, 0xf, 0xf, false)); }
__device__ __forceinline__ float rcp_f(float x) { return __builtin_amdgcn_rcpf(x); }
__device__ __forceinline__ float sigm(float x) { return rcp_f(1.f + __expf(-x)); }

template <int MODE>
__device__ __forceinline__ void lru_phase(Frame& F) {
    const bf16_t* GX = (const bf16_t*)(F.ws + WS_R1 + R1_GX); bf16_t* CAT = (bf16_t*)(F.ws + WS_R0);
    const bf16_t* GW = (const bf16_t*)(F.ws + WS_GATEW); const float* SP = (const float*)(F.ws + WS_SMALL) + 64; float* SUMM = (float*)(F.ws + WS_MISC + MISC_SUMM);
    LAS unsigned char* lds = F.lds; const int tid = F.tid, lane = F.lane, wid = F.wave;
    const int quarter = F.vcu & 3;
    const int cp = tid & 63, tg = tid >> 6, c0 = quarter * 128 + 2 * cp;
    const float w00 = F.in[9][c0], w01 = F.in[9][c0 + 1], w10 = F.in[9][LW + c0], w11 = F.in[9][LW + c0 + 1], w20 = F.in[9][2 * LW + c0], w21 = F.in[9][2 * LW + c0 + 1], w30 = F.in[9][3 * LW + c0], w31 = F.in[9][3 * LW + c0 + 1];
    const float cb0 = F.in[10][c0], cb1 = F.in[10][c0 + 1];
    const int pr = wid >> 1, d = pr & 1, hl = pr >> 1, h = quarter * 2 + hl, fr = lane & 15, fq = lane >> 4;
    bf16x8 af[2][2][2];
    for (int i = tid; i < 3 * 256; i += NTHREADS) { const int cl = i & 127, dd = (i >> 7) & 1, arr = i >> 8, c = quarter * 128 + cl;
        ((LAS float*)(lds + L_BIAS))[i] = arr == 0 ? F.in[12][dd * LW + c] : arr == 1 ? F.in[14][dd * LW + c] : SP[dd * LW + c]; }
#pragma unroll
    for (int mi = 0; mi < 2; ++mi) { const int mt = (wid & 1) * 2 + mi;
#pragma unroll
        for (int t = 0; t < 2; ++t)
#pragma unroll
            for (int ks = 0; ks < 2; ++ks) af[mi][t][ks] = *(const bf16x8*)(GW + ((((size_t)(d * 2 + t) * 8 + h) * 64 + 16 * mt + fr) * 64 + 32 * ks + 8 * fq));
    }
    const int nunit = MODE == 0 ? NB * NCHUNK * 4 : NB * 64 * 4;
    for (int u = F.vcu; u < nunit; u += F.G) {
        const int b = MODE == 0 ? (u >> 2) / NCHUNK : u >> 8, chunk = MODE == 0 ? (u >> 2) % NCHUNK : 4 + ((u >> 2) & 63);
        const bool isctx = chunk < 4; const int tok0 = isctx ? chunk * 64 : (chunk - 4) * 64, len = isctx ? CTX : SEQ; const size_t row0 = isctx ? (size_t)NLAT + (size_t)b * CTX : (size_t)b * SEQ;
        { unsigned x[11];
#pragma unroll
          for (int i = 0; i < 11; ++i) { const int n = tok0 + 8 * tg - 2 + i; x[i] = (n >= 0 && n < len) ? *(const unsigned*)(GX + (row0 + n) * D + 512 + c0) : 0u; }
          if (MODE == 1) {
              const float* S = SUMM + (size_t)b * 2 * NCHUNK * 1024 + quarter * 128; LAS float* LS = (LAS float*)(lds + L_SUM);
              for (int i = tid; i < (NCHUNK + 4) * 256; i += NTHREADS) { const int cc = i & 127, ab = (i >> 7) & 1, jj = i >> 8; const int j = jj < NCHUNK ? jj : jj - NCHUNK, dd = jj < NCHUNK ? (j < chunk ? 0 : 1) : 1;
                  LS[i] = S[((size_t)dd * NCHUNK + j) * 1024 + ab * 512 + cc]; } }
#pragma unroll
          for (int i = 0; i < 8; ++i) { const int tl = 8 * tg + i;
              const float a0 = cb0 + bflo(x[i]) * w00 + bflo(x[i + 1]) * w10 + bflo(x[i + 2]) * w20 + bflo(x[i + 3]) * w30;
              const float a1 = cb1 + bfhi(x[i]) * w01 + bfhi(x[i + 1]) * w11 + bfhi(x[i + 2]) * w21 + bfhi(x[i + 3]) * w31;
              *(LAS unsigned*)(lds + L_XCB + tl * XCB_PITCH + cp * 4) = pk2(a0, a1);
              ((LAS float*)(lds + L_XCF))[(2 * cp) * 65 + tl] = a0; ((LAS float*)(lds + L_XCF))[(2 * cp + 1) * 65 + tl] = a1; } }
        __syncthreads();
        if (MODE == 1) {
            if (tid < 256) { const int dd = tid >> 7, cl = tid & 127; const LAS float* LS = (const LAS float*)(lds + L_SUM) + cl; float hcar = 0.f;
                if (dd == 0) { for (int j = 0; j < chunk; ++j) hcar = LS[j * 256] * hcar + LS[j * 256 + 128]; }
                else { for (int j = 3; j >= 0; --j) hcar = LS[(NCHUNK + j) * 256] * hcar + LS[(NCHUNK + j) * 256 + 128];
                       for (int j = NCHUNK - 1; j > chunk; --j) hcar = LS[j * 256] * hcar + LS[j * 256 + 128]; }
                ((LAS float*)(lds + L_HIN))[tid] = hcar; }
            __syncthreads(); }
        { bf16x8 bfr[4][2];
#pragma unroll
          for (int nt = 0; nt < 4; ++nt)
#pragma unroll
              for (int ks = 0; ks < 2; ++ks) bfr[nt][ks] = *(const LAS bf16x8*)(lds + L_XCB + (16 * nt + fr) * XCB_PITCH + (hl * 64 + 32 * ks + 8 * fq) * 2);
          const int cbase = hl * 64 + (wid & 1) * 32 + 4 * fq;
          const LAS float* xcf = (const LAS float*)(lds + L_XCF) + cbase * 65 + fr; LAS float* Yd = (LAS float*)(lds + (d ? L_Y1 : L_Y0)) + cbase * 65 + fr;
#pragma unroll
          for (int mi = 0; mi < 2; ++mi) { const int mt = (wid & 1) * 2 + mi;
              f32x4 acc[2][4];
#pragma unroll
              for (int t = 0; t < 2; ++t)
#pragma unroll
                  for (int nt = 0; nt < 4; ++nt) { acc[t][nt] = (f32x4){0.f, 0.f, 0.f, 0.f};
#pragma unroll
                      for (int ks = 0; ks < 2; ++ks) acc[t][nt] = __builtin_amdgcn_mfma_f32_16x16x32_bf16(af[mi][t][ks], bfr[nt][ks], acc[t][nt], 0, 0, 0); }
#pragma unroll
              for (int reg = 0; reg < 4; ++reg) { const int cl = hl * 64 + 16 * mt + 4 * fq + reg, c = quarter * 128 + cl;
                  const LAS float* bb_ = (const LAS float*)(lds + L_BIAS) + d * 128 + cbase + 16 * mi + reg; const float ba = bb_[0], bx = bb_[256], spc = bb_[512];
                  float A[4], Bv[4];
#pragma unroll
                  for (int nt = 0; nt < 4; ++nt) { const float xcv = xcf[(16 * mi + reg) * 65 + 16 * nt];
                      const float r = sigm(acc[0][nt][reg] + ba), ig = sigm(acc[1][nt][reg] + bx);
                      const float la = -8.f * spc * r, a = __expf(la), x2 = 2.f * la;
                      const float m2 = x2 > -0.3f ? -x2 * (1.f + x2 * (0.5f + x2 * (1.f / 6.f + x2 * (1.f / 24.f + x2 * (1.f / 120.f + x2 * (1.f / 720.f + x2 * (1.f / 5040.f))))))) : 1.f - __expf(x2);
                      A[nt] = a; Bv[nt] = sqrtf(m2) * ig * xcv; }
                  if (d == 0) {
#pragma unroll
                      for (int nt = 0; nt < 4; ++nt) {
                          { const float ap = dpp_shr<1>(A[nt], 1.f), bp = dpp_shr<1>(Bv[nt], 0.f); Bv[nt] = A[nt] * bp + Bv[nt]; A[nt] *= ap; }
                          { const float ap = dpp_shr<2>(A[nt], 1.f), bp = dpp_shr<2>(Bv[nt], 0.f); Bv[nt] = A[nt] * bp + Bv[nt]; A[nt] *= ap; }
                          { const float ap = dpp_shr<4>(A[nt], 1.f), bp = dpp_shr<4>(Bv[nt], 0.f); Bv[nt] = A[nt] * bp + Bv[nt]; A[nt] *= ap; }
                          { const float ap = dpp_shr<8>(A[nt], 1.f), bp = dpp_shr<8>(Bv[nt], 0.f); Bv[nt] = A[nt] * bp + Bv[nt]; A[nt] *= ap; } }
                      if (MODE == 0) { float Ac = 1.f, Bc = 0.f;
#pragma unroll
                          for (int nt = 0; nt < 4; ++nt) { const float At = __shfl(A[nt], (lane & 48) | 15), Bt = __shfl(Bv[nt], (lane & 48) | 15); Bc = At * Bc + Bt; Ac *= At; }
                          if (fr == 0) { float* S = SUMM + ((size_t)(b * 2 + d) * NCHUNK + chunk) * 1024 + c; S[0] = Ac; S[512] = Bc; } }
                      else { float hc = ((const LAS float*)(lds + L_HIN))[d * 128 + cl];
#pragma unroll
                          for (int nt = 0; nt < 4; ++nt) { const float hv = A[nt] * hc + Bv[nt]; Yd[(16 * mi + reg) * 65 + 16 * nt] = hv; hc = __shfl(hv, (lane & 48) | 15); } }
                  } else {
#pragma unroll
                      for (int nt = 0; nt < 4; ++nt) {
                          { const float ap = dpp_shl<1>(A[nt], 1.f), bp = dpp_shl<1>(Bv[nt], 0.f); Bv[nt] = A[nt] * bp + Bv[nt]; A[nt] *= ap; }
                          { const float ap = dpp_shl<2>(A[nt], 1.f), bp = dpp_shl<2>(Bv[nt], 0.f); Bv[nt] = A[nt] * bp + Bv[nt]; A[nt] *= ap; }
                          { const float ap = dpp_shl<4>(A[nt], 1.f), bp = dpp_shl<4>(Bv[nt], 0.f); Bv[nt] = A[nt] * bp + Bv[nt]; A[nt] *= ap; }
                          { const float ap = dpp_shl<8>(A[nt], 1.f), bp = dpp_shl<8>(Bv[nt], 0.f); Bv[nt] = A[nt] * bp + Bv[nt]; A[nt] *= ap; } }
                      if (MODE == 0) { float Ac = 1.f, Bc = 0.f;
#pragma unroll
                          for (int nt = 3; nt >= 0; --nt) { const float At = __shfl(A[nt], lane & 48), Bt = __shfl(Bv[nt], lane & 48); Bc = At * Bc + Bt; Ac *= At; }
                          if (fr == 0) { float* S = SUMM + ((size_t)(b * 2 + d) * NCHUNK + chunk) * 1024 + c; S[0] = Ac; S[512] = Bc; } }
                      else { float hc = ((const LAS float*)(lds + L_HIN))[d * 128 + cl];
#pragma unroll
                          for (int nt = 3; nt >= 0; --nt) { const float hv = A[nt] * hc + Bv[nt]; Yd[(16 * mi + reg) * 65 + 16 * nt] = hv; hc = __shfl(hv, lane & 48); } }
                  }
                  __builtin_amdgcn_sched_barrier(0);
              } } }
        __syncthreads();
        if (MODE == 1) {
            const LAS float* Y0 = (const LAS float*)(lds + L_Y0); const LAS float* Y1 = (const LAS float*)(lds + L_Y1);
#pragma unroll
            for (int i = 0; i < 8; ++i) { const int tl = 8 * tg + i; const size_t row = row0 + tok0 + tl; const unsigned g = *(const unsigned*)(GX + row * D + c0);
                const float y0 = Y0[(2 * cp) * 65 + tl] + Y1[(2 * cp) * 65 + tl], y1 = Y0[(2 * cp + 1) * 65 + tl] + Y1[(2 * cp + 1) * 65 + tl];
                *(unsigned*)(CAT + row * D + c0) = pk2(y0 * gelu_tanh_f(bflo(g)), y1 * gelu_tanh_f(bfhi(g))); }
            __syncthreads();
        }
    }
}
}

constexpr int NPHASE = 18;
__global__ void __launch_bounds__(NTHREADS, 2) mk_fwd(Args args) {
    extern __shared__ __attribute__((aligned(16))) unsigned char lds_raw[];
    Frame F;
    F.lds = (LAS unsigned char*)lds_raw; F.ws = args.ws; F.ctl = (unsigned*)(args.ws + WS_CTL); F.out = args.out;
#pragma unroll
    for (int i = 0; i < 28; ++i) F.in[i] = args.in[i];
    F.tid = threadIdx.x; F.lane = F.tid & 63; F.wave = __builtin_amdgcn_readfirstlane(F.tid >> 6);
    F.G = gridDim.x; { const int bx = blockIdx.x; F.vcu = (F.G % 8 == 0) ? (bx % 8) * (F.G / 8) + bx / 8 : bx; }
    for (int u = F.tid; u < (LDS_BYTES - LDSCTL_OFF) / 4; u += NTHREADS) ((LAS unsigned*)(F.lds + LDSCTL_OFF))[u] = 0u;
    __syncthreads();
    XcdBarrier bar = xcd_barrier_post(F.ctl + CW_BAR, (volatile LAS unsigned*)(F.lds + LDSCTL_OFF + LC_BAR));
#if defined(PH_RUNTIME)
    const int lo = args.ph_lo, hi = args.ph_hi;
#else
    constexpr int lo = 0, hi = NPHASE;
#endif
#ifndef TIME_PHASE
#define TIME_PHASE -1
#endif
#ifndef REP3
#define REP3 0u
#endif
#ifndef REP_MASK
#define REP_MASK 0u
#endif
#define REPS(k) for (int rep_ = 0; rep_ <= (int)((REP_MASK >> (k)) & 1u); ++rep_)
#define REPBAR() do { if (rep_ > 0) xcd_barrier(bar); } while (0)
#ifndef SKIP_MASK
#define SKIP_MASK 0u
#endif
#define IN(k) (!((SKIP_MASK >> (k)) & 1u) && lo <= (k) && (k) < hi)
#define SEAM(k) do { if (IN(k) && IN((k) + 1)) xcd_barrier(bar); } while (0)
#define TPB(k) do { if ((k) == TIME_PHASE && blockIdx.x == 0 && threadIdx.x == 0) tp_a = __builtin_amdgcn_s_memrealtime(); } while (0)
#define TPE(k) do { if ((k) == TIME_PHASE && blockIdx.x == 0 && threadIdx.x == 0) tp_acc += __builtin_amdgcn_s_memrealtime() - tp_a; } while (0)
#define PHB() do { int t_ = threadIdx.x; asm volatile("" : "+v"(t_)); F.tid = t_; F.lane = t_ & 63; F.wave = __builtin_amdgcn_readfirstlane(t_ >> 6); } while (0)
    unsigned char* ws = args.ws;
    bf16_t* R0 = (bf16_t*)(ws + WS_R0); unsigned char* R1 = ws + WS_R1;
    unsigned long long tp_a = 0ull, tp_acc = 0ull;

    TPB(0); if (IN(0)) REPS(0) { REPBAR(); PHB(); p0_prologue(F); } SEAM(0); TPE(0);
    TPB(1); if (IN(1)) REPS(1) { REPBAR(); PHB(); p1_lnmod(F); } SEAM(1); TPE(1);
    TPB(2); if (IN(2)) REPS(2) { REPBAR();
        DenseOrder S; S.init(MALL / 256, INE / 256, F.G, (int)blockIdx.x, R0, (size_t)256 * D * 2, ws + WS_WIN, (size_t)256 * D * 2);
        EpiInProj E{(bf16_t*)(R1 + R1_GX), (bf16_t*)(R1 + R1_QB), (bf16_t*)(R1 + R1_KB), (bf16_t*)(R1 + R1_VB), (const float*)(ws + WS_ROPE)};
        run_gemm(F, pg8::Shape{D, D, D, 0u, 0u}, S, E);
    } SEAM(2); TPE(2);
    TPB(3); if (IN(3)) REPS(3) { REPBAR();
#if FAST_LRU
        for (int q_ = 0; q_ <= (int)(REP3 & 1u); ++q_) { PHB(); lru::lru_phase<0>(F); }
        xcd_barrier(bar);
        for (int q_ = 0; q_ <= (int)((REP3 >> 1) & 1u); ++q_) { PHB(); lru::lru_phase<1>(F); }
#else
        PHB(); if ((int)blockIdx.x < NB) lru_simple(F, (int)blockIdx.x);
#endif
#if FAST_ATTN
        for (int q_ = 0; q_ <= (int)((REP3 >> 2) & 1u); ++q_) { PHB(); att::attn_fast(F); }
#else
        PHB(); attn_simple(F);
#endif
    } SEAM(3); TPE(3);
    TPB(4); if (IN(4)) REPS(4) { REPBAR();
        DenseOrder S; S.init(NLAT / 256, D / 256, F.G, (int)blockIdx.x, R0, (size_t)256 * D * 2, ws + WS_WOUT, (size_t)256 * D * 2);
        EpiF32 E{(float*)R1};
        run_gemm(F, pg8::Shape{D, D, D, 0u, 0u}, S, E);
    } SEAM(4); TPE(4);
    TPB(5); if (IN(5)) { PHB(); row_phase_a(F, 0, F.in[0], nullptr); } SEAM(5); TPE(5);
#pragma unroll
    for (int layer = 0; layer < 2; ++layer) {
        const int pb = layer == 0 ? 6 : 14;
        unsigned char* moew = ws + WS_MOEW + (size_t)layer * MOEW_LAYER;
        TPB(pb); if (IN(pb)) { PHB(); moe_positions(F, layer); } SEAM(pb); TPE(pb);
        TPB(pb + 1); if (IN(pb + 1)) REPS(pb + 1) { REPBAR();
            PHB(); moe_tile_prefix(F, layer);
            MoeOrder S{(const LAS int*)(F.lds + LDSCTL_OFF + LC_TSTART), F.G, (int)blockIdx.x, (const char*)R1, (const char*)moew, (size_t)256 * D * 2, (size_t)D * D * 2, (size_t)256 * D * 2};
            EpiSwiGLU E{(bf16_t*)(ws + WS_R2)};
            run_gemm(F, pg8::Shape{D, D, D, 0u, 0u}, S, E);
        } SEAM(pb + 1); TPE(pb + 1);
        TPB(pb + 2); if (IN(pb + 2)) REPS(pb + 2) { REPBAR();
            PHB(); moe_tile_prefix(F, layer);
            MoeOrder S{(const LAS int*)(F.lds + LDSCTL_OFF + LC_TSTART), F.G, (int)blockIdx.x, (const char*)(ws + WS_R2), (const char*)(moew + MOEW_W2), (size_t)256 * FF * 2, (size_t)D * FF * 2, (size_t)256 * FF * 2};
            EpiScatter E{(bf16_t*)R1, (const int*)(ws + WS_MISC + MISC_ROWTOK), (const float*)(ws + WS_MISC + MISC_EW)};
            run_gemm(F, pg8::Shape{FF, FF, FF, 0u, 0u}, S, E);
        } SEAM(pb + 2); TPE(pb + 2);
        TPB(pb + 3); if (IN(pb + 3)) { PHB(); row_phase_b(F, layer, layer == 0); } SEAM(pb + 3); TPE(pb + 3);
        if (layer == 0) {
            TPB(10); if (IN(10)) REPS(10) { REPBAR();
                { ChanDftOrder S{F.G, (int)blockIdx.x, (const char*)(ws + WS_CDFT), (const char*)R0};
                  EpiGT1 E{(bf16_t*)R1};
                  run_gemm(F, pg8::Shape{256, 256, D, 0u, (unsigned)(2 * D * 2)}, S, E); }
                xcd_barrier(bar);
                { Dft1Order S{F.G, (int)blockIdx.x, (const char*)(ws + WS_M1), (const char*)R1};
                  EpiTw E{(bf16_t*)(ws + WS_U), (const float*)(ws + WS_TW)};
                  run_gemm(F, pg8::Shape{128, 128, 0, (unsigned)(4096 * 2), (unsigned)(2 * 8192 * 2)}, S, E); }
            } SEAM(10); TPE(10);
            TPB(11); if (IN(11)) REPS(11) { REPBAR();
                Dft2Order S{F.G, (int)blockIdx.x, (const char*)(ws + WS_M3), (const char*)(ws + WS_U)};
                EpiYF2 E{R0};
                run_gemm(F, pg8::Shape{128, 128, 8192, (unsigned)(4096 * 2), 0u}, S, E);
            } SEAM(11); TPE(11);
            TPB(12); if (IN(12)) REPS(12) { REPBAR();
                DenseOrder S; S.init(NLAT / 256, D / 256, F.G, (int)blockIdx.x, R0, (size_t)256 * D * 2, ws + WS_ODW, (size_t)256 * D * 2);
                EpiF32 E{(float*)R1};
                run_gemm(F, pg8::Shape{D, D, D, 0u, 0u}, S, E);
            } SEAM(12); TPE(12);
            TPB(13); if (IN(13)) { PHB(); row_phase_a(F, 1, F.out, F.in[20]); } SEAM(13); TPE(13);
        }
    }
    if ((TIME_PHASE >= 0 || TIME_SUB >= 0) && blockIdx.x == 0 && threadIdx.x == 0) { if (TIME_SUB >= 0) tp_acc += ((volatile LAS unsigned long long*)(F.lds + LDSCTL_OFF + LC_TP))[1];
        const unsigned long long t0 = __builtin_amdgcn_s_memrealtime(); while (__builtin_amdgcn_s_memrealtime() - t0 < 8ull * tp_acc) __builtin_amdgcn_s_sleep(8); }
#undef IN
#undef SEAM
}

extern "C" void kernel_launch(void* const* d_in, const int* in_sizes, int n_in, void* d_out, int out_size, void* d_ws, size_t ws_size, hipStream_t stream) {
    static int grid = 0;
    if (grid == 0) {
        if (n_in != 28 || out_size != NLAT * D || ws_size < WS_END) { fprintf(stderr, "kernel_launch: unexpected problem (n_in %d, out %d, ws %zu < %zu)\n", n_in, out_size, ws_size, (size_t)WS_END); grid = -1; return; }
        int dev = 0, cus = 0, per_cu = 0;
        if (hipGetDevice(&dev) != hipSuccess || hipDeviceGetAttribute(&cus, hipDeviceAttributeMultiprocessorCount, dev) != hipSuccess) { grid = -1; return; }
        if (hipFuncSetAttribute((const void*)mk_fwd, hipFuncAttributeMaxDynamicSharedMemorySize, LDS_BYTES) != hipSuccess) { fprintf(stderr, "kernel_launch: hipFuncSetAttribute failed\n"); grid = -1; return; }
        if (hipOccupancyMaxActiveBlocksPerMultiprocessor(&per_cu, (const void*)mk_fwd, NTHREADS, LDS_BYTES) != hipSuccess || per_cu < 1) fprintf(stderr, "kernel_launch: occupancy query reports %d\n", per_cu);
        (void)hipGetLastError();
        grid = cus;
        if (grid > 256) grid = 256;
        if ((NLAT / 32) % grid != 0) { fprintf(stderr, "kernel_launch: %d CUs: the row phases need a workgroup count dividing 1024\n", cus); grid = -1; return; }
    }
    if (grid < 0) return;
    if (hipMemsetAsync((char*)d_ws + WS_CTL, 0, CTL_ZERO_BYTES, stream) != hipSuccess) return;
    Args a{};
    for (int i = 0; i < 28; ++i) a.in[i] = (const float*)d_in[i];
    a.out = (float*)d_out; a.ws = (unsigned char*)d_ws; a.ph_lo = 0; a.ph_hi = NPHASE;
    hipLaunchKernelGGL(mk_fwd, dim3(grid), dim3(NTHREADS), LDS_BYTES, stream, a);
}
```

```cpp
#include <hip/hip_runtime.h>
#include <stdio.h>
#include <stdint.h>
#include <math.h>

#ifndef FAST_LRU
#define FAST_LRU 1
#endif
#ifndef FAST_ATTN
#define FAST_ATTN 1
#endif
#ifndef FAST_GEMM
#define FAST_GEMM 1
#endif

constexpr int D = 1024, NB = 8, SEQ = 4096, CTX = 256, NLAT = NB * SEQ, NCTX = NB * CTX, MALL = NLAT + NCTX;
constexpr int INE = 2560, LW = 512, NH = 4, NE = 32, FF = 512;
constexpr int MOE_ROWS = 2 * NLAT + NE * 256, MOE_TILES = MOE_ROWS / 256;
constexpr float LN_EPS = 1e-6f, ALPHA = 1.41421356237309515f;
constexpr float QSCALE = 0.125f * 1.4426950408889634f;
constexpr int NWAVES = 8, NTHREADS = 512;

constexpr size_t MiB = 1u << 20;
constexpr size_t WS_CTL = 0, CTL_ZERO_BYTES = 1 * MiB;
constexpr size_t WS_MODS = 1 * MiB;
constexpr size_t WS_ROPE = WS_MODS + 512 * 1024;
constexpr size_t WS_SMALL = WS_ROPE + 16 * 1024;
constexpr size_t WS_GATEW = WS_MODS + 768 * 1024;
constexpr size_t WS_CDFT = 2 * MiB;
constexpr size_t WS_WIN = 3 * MiB, WS_WOUT = 8 * MiB, WS_ODW = 10 * MiB;
constexpr size_t WS_U = 12 * MiB;
constexpr size_t WS_M1 = WS_CDFT + 256 * 1024, WS_M3 = WS_M1 + 64 * 1024;
constexpr size_t WS_TW = WS_M3 + 64 * 1024;
constexpr size_t WS_MOEW = 76 * MiB, MOEW_LAYER = 96 * MiB, MOEW_W2 = 64 * MiB;
constexpr size_t WS_R0 = 268 * MiB;
constexpr size_t WS_R1 = 336 * MiB;
constexpr size_t R1_GX = 0, R1_QB = 68 * MiB, R1_KB = 100 * MiB, R1_VB = 134 * MiB;
constexpr size_t WS_R2 = 504 * MiB;
constexpr size_t WS_MISC = 576 * MiB;
constexpr size_t MISC_EIDX = 0, MISC_EW = 256 * 1024, MISC_ROWTOK = 512 * 1024;
constexpr size_t MISC_BCNT = 896 * 1024;
constexpr size_t MISC_WRT = 5632 * 1024;
constexpr size_t MISC_SUMM = 1 * MiB;
constexpr size_t WS_END = 582 * MiB;
constexpr int CW_BAR = 4096;
constexpr int CW_CNT = 16384;
constexpr int RING_BYTES = 131072, LDSCTL_OFF = 139264, LDS_BYTES = 147456;
constexpr int LC_BAR = 0;
constexpr int LC_TSTART = 64;
constexpr int LC_XS = 1024;
constexpr int LC_HIST = 3072, LC_BASE = 3200, LC_LCUR = 3328;
constexpr int LC_TP = 3456;
constexpr int LC_POS = 4096;

#define GAS __attribute__((address_space(1)))
#define LAS __attribute__((address_space(3)))
typedef unsigned short bf16_t;
typedef short bf16x8 __attribute__((ext_vector_type(8)));
typedef float f32x4 __attribute__((ext_vector_type(4)));
typedef float f32x2 __attribute__((ext_vector_type(2)));
typedef unsigned u32x4 __attribute__((ext_vector_type(4)));
typedef unsigned u32x2 __attribute__((ext_vector_type(2)));

__device__ __forceinline__ unsigned f2bf(float f) { unsigned u = __float_as_uint(f); return (u + 0x7fffu + ((u >> 16) & 1u)) >> 16; }
__device__ __forceinline__ float bf2f(unsigned b) { return __uint_as_float(b << 16); }
__device__ __forceinline__ unsigned pk2(float lo, float hi) { return f2bf(lo) | (f2bf(hi) << 16); }
__device__ __forceinline__ float bflo(unsigned w) { return __uint_as_float(w << 16); }
__device__ __forceinline__ float bfhi(unsigned w) { return __uint_as_float(w & 0xffff0000u); }
__device__ __forceinline__ float wave_sum(float v) {
#pragma unroll
    for (int o = 1; o < 64; o <<= 1) v += __shfl_xor(v, o);
    return v;
}
__device__ __forceinline__ float wave_max(float v) {
#pragma unroll
    for (int o = 1; o < 64; o <<= 1) v = fmaxf(v, __shfl_xor(v, o));
    return v;
}
__device__ __forceinline__ float sigmoid_f(float x) { return 1.f / (1.f + __expf(-x)); }
__device__ __forceinline__ float silu_f(float x) { return x / (1.f + __expf(-x)); }
__device__ __forceinline__ float gelu_tanh_f(float x) { const float u = 0.7978845608028654f * (x + 0.044715f * x * x * x); return x / (1.f + __expf(-2.f * u)); }

#define XB_TMO      128
#define XB_XCNT(j)  (256  + 64 * (j))
#define XB_XSUB(j)  (1280 + 64 * (j))
#define XB_XGEN(j)  (2304 + 64 * (j))
#define XB_TOP      3328
#define XB_TOPGEN   3392
#define XCD_BAR_WORDS 3456
#define XB_SPIN_CAP (1u << 18)
__device__ __forceinline__ unsigned xb_ld(unsigned* p)              { return __hip_atomic_load(p, __ATOMIC_RELAXED, __HIP_MEMORY_SCOPE_AGENT); }
__device__ __forceinline__ unsigned xb_add(unsigned* p, unsigned v) { return __hip_atomic_fetch_add(p, v, __ATOMIC_RELAXED, __HIP_MEMORY_SCOPE_AGENT); }
__device__ __forceinline__ unsigned xb_xcc_id() { return (unsigned)__builtin_amdgcn_s_getreg((3 << 11) | 20) & 0xFu; }
#define XB_SPIN(cond, bar) do { unsigned _sp = 0; while (cond) { __builtin_amdgcn_s_sleep(1); \
    if ((++_sp & 255u) == 0u) { if (xb_ld(&(bar)[XB_TMO])) break; if (_sp > XB_SPIN_CAP) { atomicAdd(&(bar)[XB_TMO], 1u); break; } } } } while (0)
struct XcdBarrier { unsigned* bar; unsigned x; volatile LAS unsigned* st; };
__device__ __forceinline__ XcdBarrier xcd_barrier_post(unsigned* bar, volatile LAS unsigned* st) {
    XcdBarrier b; b.bar = bar; b.x = xb_xcc_id(); b.st = st;
    if (threadIdx.x == 0) (void)xb_add(&bar[XB_XCNT(b.x)], 1u);
    return b;
}
__device__ __forceinline__ void xcd_barrier_complete(unsigned* bar, unsigned x, unsigned& nloc, unsigned& nx) {
    const unsigned G = gridDim.x * gridDim.y * gridDim.z;
    unsigned sum, cnt, mine, sp = 0u;
    for (;;) {
        sum = 0u; cnt = 0u; mine = 0u;
#pragma unroll
        for (unsigned j = 0; j < 16; ++j) { const unsigned c = xb_ld(&bar[XB_XCNT(j)]); sum += c; cnt += (c > 0u) ? 1u : 0u; mine = (j == x) ? c : mine; }
        if (sum == G) break;
        __builtin_amdgcn_s_sleep(1);
        if ((++sp & 255u) == 0u) { if (xb_ld(&bar[XB_TMO])) break; if (sp > XB_SPIN_CAP) { atomicAdd(&bar[XB_TMO], 1u); break; } }
    }
    nloc = mine > 0u ? mine : 1u; nx = cnt > 0u ? cnt : 1u;
}
__device__ __forceinline__ void xcd_barrier(const XcdBarrier& b) {
    asm volatile("s_waitcnt vmcnt(0)" ::: "memory");
    __syncthreads();
    if (threadIdx.x == 0) {
        unsigned* bar = b.bar;
        __builtin_amdgcn_s_waitcnt(0);
        unsigned nloc = b.st[0], nx = b.st[1];
        if (nloc == 0u) { xcd_barrier_complete(bar, b.x, nloc, nx); b.st[0] = nloc; b.st[1] = nx; }
        const unsigned old = xb_add(&bar[XB_XSUB(b.x)], 1u);
        const unsigned gen = old / nloc;
        if (old + 1u == (gen + 1u) * nloc) {
            __builtin_amdgcn_fence(__ATOMIC_RELEASE, "agent");
            asm volatile("s_waitcnt vmcnt(0)" ::: "memory");
            const unsigned og = xb_add(&bar[XB_TOP], 1u);
            const unsigned tg = og / nx;
            if (og + 1u == (tg + 1u) * nx) xb_add(&bar[XB_TOPGEN], 1u);
            else XB_SPIN(xb_ld(&bar[XB_TOPGEN]) == tg, bar);
            __builtin_amdgcn_fence(__ATOMIC_ACQUIRE, "agent");
            xb_add(&bar[XB_XGEN(b.x)], 1u);
            asm volatile("s_waitcnt vmcnt(0)" ::: "memory");
        } else {
            XB_SPIN(xb_ld(&bar[XB_XGEN(b.x)]) == gen, bar);
            __builtin_amdgcn_fence(__ATOMIC_ACQUIRE, "agent");
            asm volatile("s_waitcnt vmcnt(0)" ::: "memory");
        }
    }
    __syncthreads();
}

namespace pg8 {
constexpr int BM = 256, BK = 64, HALF = 128, HTB = HALF * BK * 2, STAGE_BYTES = 8 * HTB, NXCD = 8, WGM = 8;
__host__ __device__ __forceinline__ int lds_byte(int r, int c) { const int st = (r >> 4) * 2 + (c >> 5), rr = r & 15, cc = c & 31, ob = rr * 64 + cc * 2; return st * 1024 + (ob ^ (((ob >> 9) & 1) << 5)); }
__host__ __device__ __forceinline__ void stage_rc(int b, int& R, int& C) { const int st = b / 1024, sb = b % 1024, swz = sb ^ (((sb >> 9) & 1) << 5); R = (st >> 1) * 16 + swz / 64; C = (st & 1) * 32 + (swz % 64) / 2; }
__host__ __device__ __forceinline__ int perm32(int rho) { const int n = rho >> 4, i = rho & 15; return 8 * (i >> 2) + 4 * n + (i & 3); }
struct Unit { int pm, pn; const char* A; const char* B; };
struct Shape { int K, pitchA, pitchB; unsigned kstepB, hstepB; };
__device__ __forceinline__ unsigned cvt_pk_bf16(float lo, float hi) { unsigned r; asm volatile("v_cvt_pk_bf16_f32 %0, %1, %2" : "=v"(r) : "v"(lo), "v"(hi)); return r; }

template <class Epi, class Sched, bool ALIGN_EPI = true>
__device__ __forceinline__ void gemm_phase(LAS unsigned char* lds, const Shape g, const Sched& S, const Epi& E) {
    int tid_ = threadIdx.x; asm volatile("" : "+v"(tid_));
    const int tid = tid_, wid = __builtin_amdgcn_readfirstlane(tid >> 6), lane = tid & 63, wr = wid >> 2, wc = wid & 3, fr = lane & 15, fq = lane >> 4;
    const int K = g.K, nt = K / BK;
    unsigned voffA[2], voffB[2];
#pragma unroll
    for (int i = 0; i < 2; ++i) { int R, C; stage_rc(tid * 16 + i * 8192, R, C); const int Rb = Epi::PERM ? ((R & ~31) + perm32(R & 31)) : R;
        voffA[i] = (unsigned)(R * g.pitchA + C) * 2u; voffB[i] = (unsigned)(S.rowoffB(Rb, g.pitchB) + C) * 2u; }
    const size_t kstep = (size_t)(BK * 2), kstepB = g.kstepB ? (size_t)g.kstepB : kstep;
    const size_t hstepA = (size_t)HALF * g.pitchA * 2, hstepB = g.hstepB ? (size_t)g.hstepB : (size_t)HALF * g.pitchB * 2;
    const unsigned ldsw = (unsigned)wid * 1024u;
    const int aoff = lds_byte(wr * 64 + fr, fq * 8), boff = lds_byte(wc * 32 + fr, fq * 8);
    int gR[2], gC[2]; unsigned gcur[2][2], gnxt[2][2];
#pragma unroll
    for (int i = 0; i < 2; ++i) { stage_rc(tid * 16 + i * 8192, gR[i], gC[i]); gcur[0][i] = gcur[1][i] = gnxt[0][i] = gnxt[1][i] = 0u; }
#define PG8_GLOAD(dst, unit) do { _Pragma("unroll") for (int h_ = 0; h_ < 2; ++h_) _Pragma("unroll") for (int i_ = 0; i_ < 2; ++i_) dst[h_][i_] = (unsigned)(S.arow(unit, h_ * 128 + gR[i_]) * g.pitchA + gC[i_]) * 2u; } while (0)
#define PG8_STAGEA(bufoff, half, nextu, koff) do { if constexpr (Sched::GATHER) { const char* gb_ = (const char*)S.abase() + (koff); \
            const unsigned o0_ = (nextu) ? gnxt[half][0] : gcur[half][0], o1_ = (nextu) ? gnxt[half][1] : gcur[half][1]; \
            __builtin_amdgcn_global_load_lds((const unsigned*)(gb_ + o0_), (LAS unsigned*)(lds + (bufoff) + ldsw), 16, 0, 0); \
            __builtin_amdgcn_global_load_lds((const unsigned*)(gb_ + o1_), (LAS unsigned*)(lds + (bufoff) + ldsw + 8192), 16, 0, 0); } \
        else { PG8_STAGE(bufoff, ((nextu) ? nA : cA) + (half) * hstepA + (koff), voffA); } } while (0)
#define PG8_SA(b, h) (((b) * 2 + (h)) * HTB)
#define PG8_SB(b, h) ((4 + (b) * 2 + (h)) * HTB)
#define PG8_STAGE(bufoff, gbase, voff) do { _Pragma("unroll") for (int _i = 0; _i < 2; ++_i) \
        __builtin_amdgcn_global_load_lds((const unsigned*)((const char*)(gbase) + (voff)[_i]), (LAS unsigned*)(lds + (bufoff) + ldsw + _i * 8192), 16, 0, 0); } while (0)
#define PG8_LDA(dst, b, h) do { _Pragma("unroll") for (int m = 0; m < 4; ++m) _Pragma("unroll") for (int k = 0; k < 2; ++k) dst[m][k] = *(const LAS bf16x8*)(lds + PG8_SA(b, h) + aoff + m * 2048 + k * 1024); } while (0)
#define PG8_LDB(dst, b, h) do { _Pragma("unroll") for (int n = 0; n < 2; ++n) _Pragma("unroll") for (int k = 0; k < 2; ++k) dst[n][k] = *(const LAS bf16x8*)(lds + PG8_SB(b, h) + boff + n * 2048 + k * 1024); } while (0)
#define PG8_MMA(ai, bj, At, Bt) do { __builtin_amdgcn_s_setprio(1); _Pragma("unroll") for (int m = 0; m < 4; ++m) _Pragma("unroll") for (int n = 0; n < 2; ++n) _Pragma("unroll") for (int k = 0; k < 2; ++k) \
        acc[ai][bj][m][n] = __builtin_amdgcn_mfma_f32_16x16x32_bf16(Bt[n][k], At[m][k], acc[ai][bj][m][n], 0, 0, 0); __builtin_amdgcn_s_setprio(0); } while (0)
#define PG8_WAIT_V(n) asm volatile("s_waitcnt vmcnt(" #n ")" ::: "memory")
#define PG8_WAIT_L(n) asm volatile("s_waitcnt lgkmcnt(" #n ")" ::: "memory")
#define PG8_BAR __builtin_amdgcn_s_barrier()
#define PG8_SCHED __builtin_amdgcn_sched_barrier(0)
    Unit cur, nxt; int ui = 0;
    if (!S.next(0, cur)) return;
    f32x4 acc[2][2][4][2];
#pragma unroll
    for (int a = 0; a < 2; ++a)
#pragma unroll
        for (int b = 0; b < 2; ++b)
#pragma unroll
            for (int m = 0; m < 4; ++m)
#pragma unroll
                for (int n = 0; n < 2; ++n) acc[a][b][m][n] = (f32x4){0.f, 0.f, 0.f, 0.f};
    bf16x8 At[4][2], B0[2][2], B1[2][2];
    const char* cA = cur.A; const char* cB = cur.B; const char* nA = cA;
    if constexpr (Sched::GATHER) { PG8_GLOAD(gcur, cur); }
    PG8_STAGE(PG8_SB(0, 0), cB, voffB); PG8_STAGE(PG8_SB(0, 1), cB + hstepB, voffB); PG8_STAGEA(PG8_SA(0, 0), 0, false, (size_t)0); PG8_STAGEA(PG8_SA(0, 1), 1, false, (size_t)0);
    if (wr == 1) PG8_BAR;
    PG8_WAIT_V(2); PG8_BAR;
    PG8_STAGE(PG8_SB(1, 0), cB + kstepB, voffB); PG8_STAGEA(PG8_SA(1, 0), 0, false, kstep); PG8_STAGE(PG8_SB(1, 1), cB + hstepB + kstepB, voffB);
    PG8_WAIT_V(6); PG8_BAR;
    for (;;) {
        const bool has_next = S.next(ui + 1, nxt);
        nA = has_next ? nxt.A : cA; const char* nB = has_next ? nxt.B : cB;
        if constexpr (Sched::GATHER) { if (has_next) { PG8_GLOAD(gnxt, nxt); } else {
#pragma unroll
            for (int h_ = 0; h_ < 2; ++h_)
#pragma unroll
                for (int i_ = 0; i_ < 2; ++i_) gnxt[h_][i_] = gcur[h_][i_]; } }
        for (int t = 0; t < nt; t += 2) {
            const bool last = (t == nt - 2);
            const size_t ka1 = (size_t)(t + 1) * kstep, ka2 = last ? (size_t)0 : (size_t)(t + 2) * kstep, ka3 = ka2 + kstep;
            const char* b2 = last ? nB : cB + (size_t)(t + 2) * kstepB;
            const char* b3 = b2 + kstepB;
            PG8_LDB(B0, 0, 0); PG8_LDB(B1, 0, 1); PG8_SCHED; PG8_LDA(At, 0, 0); PG8_STAGEA(PG8_SA(1, 1), 1, false, ka1);
            PG8_WAIT_V(8); PG8_WAIT_L(0); PG8_BAR; PG8_MMA(0, 0, At, B0); PG8_MMA(0, 1, At, B1); PG8_BAR; PG8_SCHED;
            PG8_LDA(At, 0, 1); PG8_STAGE(PG8_SB(0, 0), b2, voffB); PG8_STAGE(PG8_SB(0, 1), b2 + hstepB, voffB); PG8_STAGEA(PG8_SA(0, 0), 0, last, ka2);
            PG8_WAIT_V(8); PG8_WAIT_L(0); PG8_BAR; PG8_MMA(1, 0, At, B0); PG8_MMA(1, 1, At, B1); PG8_BAR; PG8_SCHED;
            PG8_LDB(B0, 1, 0); PG8_LDB(B1, 1, 1); PG8_SCHED; PG8_LDA(At, 1, 0); PG8_STAGEA(PG8_SA(0, 1), 1, last, ka2);
            PG8_WAIT_V(8); PG8_WAIT_L(0); PG8_BAR; PG8_MMA(0, 0, At, B0); PG8_MMA(0, 1, At, B1); PG8_BAR; PG8_SCHED;
            PG8_LDA(At, 1, 1); PG8_STAGE(PG8_SB(1, 0), b3, voffB); PG8_STAGE(PG8_SB(1, 1), b3 + hstepB, voffB); PG8_STAGEA(PG8_SA(1, 0), 0, last, ka3);
            PG8_WAIT_V(8); PG8_WAIT_L(0); PG8_BAR; PG8_MMA(1, 0, At, B0); PG8_MMA(1, 1, At, B1); PG8_BAR; PG8_SCHED;
        }
        if constexpr (ALIGN_EPI) { if (wr == 0) PG8_BAR; }
        E(acc, cur, wr, wc, fr, fq);
        if (!has_next) break;
#pragma unroll
        for (int a = 0; a < 2; ++a)
#pragma unroll
            for (int b = 0; b < 2; ++b)
#pragma unroll
                for (int m = 0; m < 4; ++m)
#pragma unroll
                    for (int n = 0; n < 2; ++n) acc[a][b][m][n] = (f32x4){0.f, 0.f, 0.f, 0.f};
        cur = nxt; cA = nA; cB = nB; ++ui;
        if constexpr (Sched::GATHER) {
#pragma unroll
            for (int h_ = 0; h_ < 2; ++h_)
#pragma unroll
                for (int i_ = 0; i_ < 2; ++i_) gcur[h_][i_] = gnxt[h_][i_]; }
        if constexpr (ALIGN_EPI) { if (wr == 1) PG8_BAR; }
    }
    PG8_WAIT_V(0);
    if constexpr (!ALIGN_EPI) { if (wr == 0) PG8_BAR; }
    PG8_BAR;
#undef PG8_SA
#undef PG8_SB
#undef PG8_STAGE
#undef PG8_STAGEA
#undef PG8_GLOAD
#undef PG8_LDA
#undef PG8_LDB
#undef PG8_MMA
#undef PG8_WAIT_V
#undef PG8_WAIT_L
#undef PG8_BAR
#undef PG8_SCHED
}

template <class Epi, class Sched>
__device__ __forceinline__ void gemm_phase_ref(const Shape g, const Sched& S, const Epi& E) {
    const int tid = threadIdx.x, wid = __builtin_amdgcn_readfirstlane(tid >> 6), lane = tid & 63, wr = wid >> 2, wc = wid & 3, fr = lane & 15, fq = lane >> 4;
    Unit u;
    for (int it = 0; S.next(it, u); ++it) {
        f32x4 acc[2][2][4][2];
#pragma unroll
        for (int a = 0; a < 2; ++a)
#pragma unroll
            for (int b = 0; b < 2; ++b)
#pragma unroll
                for (int m = 0; m < 4; ++m)
#pragma unroll
                    for (int n = 0; n < 2; ++n) acc[a][b][m][n] = (f32x4){0.f, 0.f, 0.f, 0.f};
#pragma unroll
        for (int ai = 0; ai < 2; ++ai) {
            for (int k8 = 0; k8 < g.K / 8; ++k8) {
                float a[4][8];
#pragma unroll
                for (int m = 0; m < 4; ++m) { const u32x4 w = *(const u32x4*)(u.A + ((size_t)(ai * 128 + wr * 64 + m * 16 + fr) * g.pitchA + k8 * 8) * 2);
                    a[m][0] = bflo(w.x); a[m][1] = bfhi(w.x); a[m][2] = bflo(w.y); a[m][3] = bfhi(w.y); a[m][4] = bflo(w.z); a[m][5] = bfhi(w.z); a[m][6] = bflo(w.w); a[m][7] = bfhi(w.w); }
#pragma unroll
                for (int bj = 0; bj < 2; ++bj)
#pragma unroll
                    for (int n = 0; n < 2; ++n)
#pragma unroll
                        for (int ii = 0; ii < 4; ++ii) {
                            const int col = bj * 128 + wc * 32 + (Epi::PERM ? 8 * fq + 4 * n + ii : 16 * n + 4 * fq + ii);
                            const size_t kb_ = g.kstepB ? (size_t)(k8 >> 3) * g.kstepB + (size_t)(k8 & 7) * 16 : (size_t)k8 * 16;
                            const u32x4 w = *(const u32x4*)(u.B + (size_t)(col >> 7) * (g.hstepB ? (size_t)g.hstepB : (size_t)HALF * g.pitchB * 2) + (size_t)S.rowoffB(col & 127, g.pitchB) * 2 + kb_);
                            const float b0 = bflo(w.x), b1 = bfhi(w.x), b2 = bflo(w.y), b3 = bfhi(w.y), b4 = bflo(w.z), b5 = bfhi(w.z), b6 = bflo(w.w), b7 = bfhi(w.w);
#pragma unroll
                            for (int m = 0; m < 4; ++m)
                                acc[ai][bj][m][n][ii] += a[m][0] * b0 + a[m][1] * b1 + a[m][2] * b2 + a[m][3] * b3 + a[m][4] * b4 + a[m][5] * b5 + a[m][6] * b6 + a[m][7] * b7;
                        }
            }
        }
        E(acc, u, wr, wc, fr, fq);
    }
}
}

struct Args { const float* in[28]; float* out; unsigned char* ws; int ph_lo, ph_hi; };
struct InRef { const Args& a; __device__ __forceinline__ const float* operator[](int k) const { return a.in[k]; } };
struct Frame {
    LAS unsigned char* lds; unsigned* ctl; unsigned char* ws;
    int tid, lane, wave, G, vcu;
    InRef in; float* out;
};
#define LDS_WAIT() asm volatile("s_waitcnt lgkmcnt(0)" ::: "memory")
#ifndef TIME_SUB
#define TIME_SUB -1
#endif
#define TSB(id) do { if ((id) == TIME_SUB && blockIdx.x == 0 && threadIdx.x == 0) ((volatile LAS unsigned long long*)(F.lds + LDSCTL_OFF + LC_TP))[0] = __builtin_amdgcn_s_memrealtime(); } while (0)
#define TSE(id) do { if ((id) == TIME_SUB && blockIdx.x == 0 && threadIdx.x == 0) { volatile LAS unsigned long long* tp_ = (volatile LAS unsigned long long*)(F.lds + LDSCTL_OFF + LC_TP); tp_[1] = tp_[1] + (__builtin_amdgcn_s_memrealtime() - tp_[0]); } } while (0)

template <class RowMap>
__device__ __forceinline__ void p0_transpose_item(const float* W, int K, int N, bf16_t* WT, RowMap rowmap, LAS float* scr, int item, int lane) {
    const int nblk = N / 32, kb = item / nblk, nb = item % nblk, k0 = 64 * kb, n0 = 32 * nb;
    float v[32];
#pragma unroll
    for (int i = 0; i < 32; ++i) v[i] = __builtin_nontemporal_load(W + (size_t)(k0 + 2 * i + (lane >> 5)) * N + n0 + (lane & 31));
#pragma unroll
    for (int i = 0; i < 32; ++i) scr[(2 * i + (lane >> 5)) * 33 + (lane & 31)] = v[i];
    LDS_WAIT(); asm volatile("" ::: "memory");
    const int c = lane & 7;
#pragma unroll
    for (int j = 0; j < 4; ++j) { const int n = (lane >> 3) + 8 * j; const LAS float* s = scr + (8 * c) * 33 + n;
        u32x4 o; o.x = pk2(s[0 * 33], s[1 * 33]); o.y = pk2(s[2 * 33], s[3 * 33]); o.z = pk2(s[4 * 33], s[5 * 33]); o.w = pk2(s[6 * 33], s[7 * 33]);
        *(u32x4*)(WT + (size_t)rowmap(n0 + n) * K + k0 + 8 * c) = o; }
    LDS_WAIT(); asm volatile("" ::: "memory");
}
struct RmId { __device__ int operator()(int n) const { return n; } };
struct RmW1 { __device__ int operator()(int j) const { return (j >> 2) * 8 + (j & 3); } };
struct RmW3 { __device__ int operator()(int j) const { return (j >> 2) * 8 + 4 + (j & 3); } };

__device__ __forceinline__ void p0_prologue(Frame& F) {
    unsigned char* ws = F.ws;
    LAS float* scr = (LAS float*)(F.lds + F.wave * 16384);
    const int gw = F.vcu * NWAVES + F.wave, NGW = F.G * NWAVES;
    constexpr int I_WIN = 16 * 80, I_SQ = 16 * 32, I_W13 = 16 * 16, I_W2 = 8 * 32;
    constexpr int N0 = I_WIN, N1 = N0 + I_SQ, N2 = N1 + I_SQ, N3 = N2 + 2 * NE * I_W13  , N4 = N3 + 2 * NE * I_W13  , N5 = N4 + 2 * NE * I_W2;
    for (int it = gw; it < N5; it += NGW) {
        if (it < N0) { p0_transpose_item(F.in[8], D, INE, (bf16_t*)(ws + WS_WIN), RmId(), scr, it, F.lane); continue; }
        if (it < N1) { p0_transpose_item(F.in[18], D, D, (bf16_t*)(ws + WS_WOUT), RmId(), scr, it - N0, F.lane); continue; }
        if (it < N2) { p0_transpose_item(F.in[19], D, D, (bf16_t*)(ws + WS_ODW), RmId(), scr, it - N1, F.lane); continue; }
        if (it < N3) { const int r = it - N2, le = r / I_W13, l = le / NE, e = le % NE;
            p0_transpose_item(F.in[25] + (size_t)le * D * FF, D, FF, (bf16_t*)(ws + WS_MOEW + l * MOEW_LAYER) + (size_t)e * D * D, RmW1(), scr, r % I_W13, F.lane); continue; }
        if (it < N4) { const int r = it - N3, le = r / I_W13, l = le / NE, e = le % NE;
            p0_transpose_item(F.in[26] + (size_t)le * D * FF, D, FF, (bf16_t*)(ws + WS_MOEW + l * MOEW_LAYER) + (size_t)e * D * D, RmW3(), scr, r % I_W13, F.lane); continue; }
        { const int r = it - N4, le = r / I_W2, l = le / NE, e = le % NE;
            p0_transpose_item(F.in[27] + (size_t)le * FF * D, FF, D, (bf16_t*)(ws + WS_MOEW + l * MOEW_LAYER + MOEW_W2) + (size_t)e * D * FF, RmId(), scr, r % I_W2, F.lane); }
    }
    const int gt = F.vcu * NTHREADS + F.tid, NGT = F.G * NTHREADS;
    { bf16_t* gwt = (bf16_t*)(ws + WS_GATEW);
      for (int i = gt; i < 2 * 2 * 8 * 64 * 64; i += NGT) { const int k = i & 63, n = (i >> 6) & 63, h = (i >> 12) & 7, t = (i >> 15) & 1, d = i >> 16;
          const float* w = t ? F.in[13] : F.in[11]; gwt[i] = (bf16_t)f2bf(w[(((size_t)d * 8 + h) * 64 + k) * 64 + n]); } }
    { bf16_t* wrt = (bf16_t*)(ws + WS_MISC + MISC_WRT);
      for (int i = gt; i < 2 * 48 * 1024; i += NGT) { const int k = i & 1023, n = (i >> 10) % 48, l = i / (48 * 1024);
          const float w = n < 4 ? F.in[21][((size_t)l * D + k) * 4 + n] : n < 36 ? F.in[23][((size_t)l * D + k) * 32 + (n - 4)] : 0.f;
          const unsigned hi = f2bf(w); const unsigned lo = f2bf(w - bf2f(hi));
          wrt[((size_t)(l * 2 + 0) * 48 + n) * 1024 + k] = (bf16_t)hi; wrt[((size_t)(l * 2 + 1) * 48 + n) * 1024 + k] = (bf16_t)lo; } }
    { float* rope = (float*)(ws + WS_ROPE);
      for (int i = gt; i < 64 * 16; i += NGT) { const int f = i & 15, pos = i >> 4; const float freq = powf(10000.f, -(float)f / 16.f); const float ang = (float)pos * freq;
          rope[i * 2] = (float)cos((double)ang); rope[i * 2 + 1] = (float)sin((double)ang); }
      float* sm = (float*)(ws + WS_SMALL);
      for (int i = gt; i < 2 * LW; i += NGT) { const float l = F.in[15][i]; sm[64 + i] = (-l > 20.f) ? -l : log1pf(expf(-l)); }
      if (blockIdx.x == 0 && F.wave == 0) { const float* dl = F.in[16]; const float a = wave_sum(dl[F.lane] * dl[64 + F.lane]), b = wave_sum(dl[128 + F.lane] * dl[192 + F.lane]);
          if (F.lane == 0) sm[0] = expf(a) - expf(b) + 0.2f; } }
    __syncthreads();
    { LAS float* tab = (LAS float*)F.lds;
      for (int i = F.tid; i < 4096; i += NTHREADS) tab[i] = (float)cos(2.0 * 3.14159265358979323846 * (double)i / 4096.0);
      __syncthreads();
      bf16_t* cd = (bf16_t*)(ws + WS_CDFT);
      for (int i = gt; i < 512 * 256; i += NGT) { const int c = i & 255, m = i >> 8; const int j = ((m & 255) * c) & 255; cd[i] = (bf16_t)f2bf(m < 256 ? tab[j * 16] : tab[(j * 16 + 3072) & 4095]); }
      bf16_t* m1 = (bf16_t*)(ws + WS_M1); bf16_t* m3 = (bf16_t*)(ws + WS_M3); float* twp = (float*)(ws + WS_TW);
      for (int i = gt; i < 256 * 128; i += NGT) { const int k = i & 127, r = i >> 7, n = k & 63, im_in = k >> 6;
          float v1 = 0.f; if (r < 128) { const int ka = 32 * (r >> 6) + 16 * ((r >> 4) & 1) + (r & 15), im_out = (r >> 5) & 1; const int j = ((ka * n) & 63) * 64; const float cc = tab[j], ss = tab[(j + 3072) & 4095];
              v1 = im_out == 0 ? (im_in == 0 ? cc : -ss) : (im_in == 0 ? -ss : -cc); }
          m1[i] = (bf16_t)f2bf(v1);
          float v3 = 0.f; if (r < 64) { const int j = ((r * n) & 63) * 64; v3 = im_in == 0 ? tab[j] : tab[(j + 3072) & 4095]; }
          m3[i] = (bf16_t)f2bf(v3); }
      for (int i = gt; i < 64 * 64; i += NGT) { const int n2 = i & 63, ka = i >> 6; const int j = (ka * n2) & 4095; twp[2 * i] = tab[j]; twp[2 * i + 1] = tab[(j + 3072) & 4095]; }
      __syncthreads(); }
    { LAS float* sc = (LAS float*)F.lds;
      LAS float* red = sc + 9 * 1024;
      for (int i = F.tid; i < 9 * 1024; i += NTHREADS) { const int r = i >> 10, k = i & 1023; const float v = r < 8 ? F.in[1][r * D + k] : F.in[3][k]; sc[i] = v / (1.f + expf(-v)); }
      __syncthreads();
      float* mods = (float*)(ws + WS_MODS);
      for (int u = F.vcu; u < 2 * 96; u += F.G) { const int l = u / 96, n0 = (u % 96) * 64, col = F.tid & 63, kc = F.tid >> 6;
          float a9[9];
#pragma unroll
          for (int r = 0; r < 9; ++r) a9[r] = 0.f;
          const float* w = F.in[4] + ((size_t)l * D + kc * 128) * 6144 + n0 + col;
#pragma unroll 1
          for (int k0 = 0; k0 < 128; k0 += 16) { float wv[16];
#pragma unroll
              for (int k = 0; k < 16; ++k) wv[k] = __builtin_nontemporal_load(w + (size_t)(k0 + k) * 6144);
#pragma unroll
              for (int k = 0; k < 16; ++k)
#pragma unroll
                  for (int r = 0; r < 9; ++r) a9[r] += sc[r * 1024 + kc * 128 + k0 + k] * wv[k]; }
#pragma unroll
          for (int r = 0; r < 9; ++r) red[(kc * 9 + r) * 64 + col] = a9[r];
          __syncthreads();
          for (int i = F.tid; i < 9 * 64; i += NTHREADS) { const int r = i >> 6, c = i & 63; float s = 0.f;
#pragma unroll
              for (int q = 0; q < 8; ++q) s += red[(q * 9 + r) * 64 + c];
              mods[((size_t)l * 9 + r) * 6144 + n0 + c] = s + F.in[5][l * 6144 + n0 + c]; }
          __syncthreads(); } }
}

template <int CTRL> __device__ __forceinline__ float dpp_f(float v) { return __int_as_float(__builtin_amdgcn_update_dpp(0, __float_as_int(v), CTRL, 0xf, 0xf, true)); }
__device__ __forceinline__ float row16_sum(float v) { v += dpp_f<0x128>(v); v += dpp_f<0x124>(v); v += dpp_f<0x122>(v); v += dpp_f<0x121>(v); v += __shfl_xor(v, 16); return v; }
__device__ __forceinline__ void ln_stats16(f32x4 (&v)[8], float& mean, float& rstd) {
    float s = 0.f;
#pragma unroll
    for (int j = 0; j < 8; ++j) s += (v[j].x + v[j].y) + (v[j].z + v[j].w);
    mean = row16_sum(s) * (1.f / D); float q = 0.f;
#pragma unroll
    for (int j = 0; j < 8; ++j) { const f32x4 d = v[j] - mean; q += (d.x * d.x + d.y * d.y) + (d.z * d.z + d.w * d.w); }
    rstd = 1.f / sqrtf(row16_sum(q) * (1.f / D) + LN_EPS);
}
__device__ __forceinline__ void p1_lnmod(Frame& F) {
    const int gw = F.vcu * NWAVES + F.wave, NGW = F.G * NWAVES, r4 = F.lane >> 5, sub = F.lane & 31; const float* mods = (const float*)(F.ws + WS_MODS); bf16_t* H = (bf16_t*)(F.ws + WS_R0);
    for (int quad = gw; quad < MALL / 2; quad += NGW) { const int row = quad * 2 + r4;
        const float* src = row < NLAT ? F.in[0] + (size_t)row * D : F.in[2] + (size_t)(row - NLAT) * D; const int r = row < NLAT ? (row >> 12) : 8;
        f32x4 v[8];
#pragma unroll
        for (int j = 0; j < 8; ++j) v[j] = ((const f32x4*)src)[sub + 32 * j];
        float mean, rstd; ln_stats16(v, mean, rstd);
        const f32x4* sh = (const f32x4*)(mods + (size_t)r * 6144); const f32x4* sc = (const f32x4*)(mods + (size_t)r * 6144 + 1024);
#pragma unroll
        for (int j = 0; j < 8; ++j) { const f32x4 a = sh[sub + 32 * j], bb = sc[sub + 32 * j]; const f32x4 o = (v[j] - mean) * rstd * (bb + 1.f) + a;
            ((u32x2*)(H + (size_t)row * D))[sub + 32 * j] = (u32x2){pk2(o.x, o.y), pk2(o.z, o.w)}; }
    }
}
constexpr int RT_PITCH = 2064;
__device__ __forceinline__ void row_phase_a(Frame& F, int layer, const float* xin, const float* bias) {
    const float* mods = (const float*)(F.ws + WS_MODS) + (size_t)layer * 9 * 6144;
    const bf16_t* Y = (const bf16_t*)(F.ws + WS_R1); bf16_t* T = (bf16_t*)(F.ws + WS_R0); float* X = F.out;
    const float* lg = F.in[6] + (size_t)(layer * 2) * D; const float* lb = F.in[7] + (size_t)(layer * 2) * D;
    const float* bg = F.in[22] + layer * 4; const float* bfp = F.in[24] + layer * 32;
    const bf16_t* WRT = (const bf16_t*)(F.ws + WS_MISC + MISC_WRT) + (size_t)layer * 2 * 48 * 1024;
    int* eidx = (int*)(F.ws + WS_MISC + MISC_EIDX); float* ew = (float*)(F.ws + WS_MISC + MISC_EW); unsigned* cnt = F.ctl + CW_CNT + layer * 128;
    unsigned* bcnt = (unsigned*)(F.ws + WS_MISC + MISC_BCNT);
    LAS unsigned char* lds = F.lds; LAS unsigned char* TH = lds; LAS unsigned char* TL = lds + 32 * RT_PITCH;
    LAS float* PART = (LAS float*)lds; LAS float* LOG = (LAS float*)(lds + 8 * 32 * 48 * 4);
    LAS unsigned* hist = (LAS unsigned*)(lds + LDSCTL_OFF + LC_HIST);
    const int lane = F.lane, wid = F.wave;
    if (F.tid < 32) hist[F.tid] = 0u;
    __syncthreads();
    const int TPB = (NLAT / 32) / F.G;
    for (int ti = 0; ti < TPB; ++ti) { const int tile = (int)blockIdx.x * TPB + ti;
        TSB(100);
#pragma unroll 1
        for (int hh = 0; hh < 2; ++hh) { int lane_ = lane; asm volatile("" : "+v"(lane_));
            const int r4 = lane_ >> 5, sub = lane_ & 31, rl = wid * 4 + 2 * hh + r4, row = tile * 32 + rl; const int b = row >> 12; const float* mr = mods + (size_t)b * 6144;
            f32x4 v[8];
#pragma unroll
            for (int j = 0; j < 8; ++j) { if (j == 4) __builtin_amdgcn_sched_barrier(0); const int q = sub + 32 * j; const u32x2 yw = ((const u32x2*)(Y + (size_t)row * D))[q]; f32x4 y = (f32x4){bflo(yw.x), bfhi(yw.x), bflo(yw.y), bfhi(yw.y)}; if (bias) y = y + ((const f32x4*)bias)[q];
                v[j] = ((const f32x4*)(xin + (size_t)row * D))[q] * ALPHA + ((const f32x4*)(mr + 2 * 1024))[q] * y; }
            float mean, rstd; ln_stats16(v, mean, rstd);
#pragma unroll
            for (int j = 0; j < 8; ++j) { const int q = sub + 32 * j; v[j] = (v[j] - mean) * rstd * ((const f32x4*)lg)[q] + ((const f32x4*)lb)[q]; ((f32x4*)(X + (size_t)row * D))[q] = v[j]; }
            ln_stats16(v, mean, rstd);
#pragma unroll
            for (int j = 0; j < 8; ++j) { const int q = sub + 32 * j; const f32x4 t = (v[j] - mean) * rstd * (((const f32x4*)(mr + 4 * 1024))[q] + 1.f) + ((const f32x4*)(mr + 3 * 1024))[q];
                const unsigned h0 = f2bf(t.x), h1 = f2bf(t.y), h2 = f2bf(t.z), h3 = f2bf(t.w);
                const u32x2 hw = (u32x2){h0 | (h1 << 16), h2 | (h3 << 16)};
                const u32x2 lw = (u32x2){pk2(t.x - bf2f(h0), t.y - bf2f(h1)), pk2(t.z - bf2f(h2), t.w - bf2f(h3))};
                ((u32x2*)(T + (size_t)row * D))[q] = hw;
                *(LAS u32x2*)(TH + rl * RT_PITCH + q * 8) = hw; *(LAS u32x2*)(TL + rl * RT_PITCH + q * 8) = lw; } }
        __syncthreads();
        TSE(100); TSB(101);
        f32x4 acc[2][3];
        int lane2_ = lane; asm volatile("" : "+v"(lane2_)); const int fr = lane2_ & 15, fq = lane2_ >> 4;
#pragma unroll
        for (int mt = 0; mt < 2; ++mt)
#pragma unroll
            for (int nt = 0; nt < 3; ++nt) acc[mt][nt] = (f32x4){0.f, 0.f, 0.f, 0.f};
#pragma unroll
        for (int ks = 0; ks < 4; ++ks) { const int k0 = wid * 128 + ks * 32 + 8 * fq;
            bf16x8 ah[2], al[2], bh[3], bl[3];
#pragma unroll
            for (int mt = 0; mt < 2; ++mt) { ah[mt] = *(const LAS bf16x8*)(TH + (16 * mt + fr) * RT_PITCH + k0 * 2); al[mt] = *(const LAS bf16x8*)(TL + (16 * mt + fr) * RT_PITCH + k0 * 2); }
#pragma unroll
            for (int nt = 0; nt < 3; ++nt) { bh[nt] = *(const bf16x8*)(WRT + (size_t)(16 * nt + fr) * 1024 + k0); bl[nt] = *(const bf16x8*)(WRT + (size_t)(48 + 16 * nt + fr) * 1024 + k0); }
#pragma unroll
            for (int mt = 0; mt < 2; ++mt)
#pragma unroll
                for (int nt = 0; nt < 3; ++nt) {
                    acc[mt][nt] = __builtin_amdgcn_mfma_f32_16x16x32_bf16(ah[mt], bh[nt], acc[mt][nt], 0, 0, 0);
                    acc[mt][nt] = __builtin_amdgcn_mfma_f32_16x16x32_bf16(ah[mt], bl[nt], acc[mt][nt], 0, 0, 0);
                    acc[mt][nt] = __builtin_amdgcn_mfma_f32_16x16x32_bf16(al[mt], bh[nt], acc[mt][nt], 0, 0, 0); } }
        __syncthreads();
        TSE(101); TSB(102);
#pragma unroll
        for (int mt = 0; mt < 2; ++mt)
#pragma unroll
            for (int nt = 0; nt < 3; ++nt)
#pragma unroll
                for (int reg = 0; reg < 4; ++reg) PART[(wid * 32 + 16 * mt + 4 * fq + reg) * 48 + 16 * nt + fr] = acc[mt][nt][reg];
        __syncthreads();
        for (int idx = F.tid; idx < 32 * 36; idx += NTHREADS) { const int r = idx / 36, o = idx - r * 36; float sacc = o < 4 ? bg[o] : bfp[o - 4];
#pragma unroll
            for (int w = 0; w < 8; ++w) sacc += PART[(w * 32 + r) * 48 + o];
            LOG[r * 36 + o] = sacc; }
        __syncthreads();
        if (F.tid < 32) { const int r = F.tid, row = tile * 32 + r; const LAS float* L = LOG + r * 36;
            const float g0 = L[0], g1 = L[1], g2 = L[2], g3 = L[3];
            int gi = 0; float gm = g0;
            if (g1 > gm) { gm = g1; gi = 1; }
            if (g2 > gm) { gm = g2; gi = 2; }
            if (g3 > gm) { gm = g3; gi = 3; }
            const float pg = 1.f / (expf(g0 - gm) + expf(g1 - gm) + expf(g2 - gm) + expf(g3 - gm));
            int i0 = 0; float v0 = -INFINITY; int i1 = 0; float v1 = -INFINITY;
#pragma unroll
            for (int j = 0; j < 8; ++j) { const float vv = L[4 + gi * 8 + j];
                if (vv > v0) { v1 = v0; i1 = i0; v0 = vv; i0 = j; } else if (vv > v1) { v1 = vv; i1 = j; } }
            const float e1 = expf(v1 - v0); const float w0 = 1.f / (1.f + e1), w1 = e1 / (1.f + e1);
            const int ea = gi * 8 + i0, eb = gi * 8 + i1; eidx[row * 2] = ea; eidx[row * 2 + 1] = eb; ew[row * 2] = w0 * pg; ew[row * 2 + 1] = w1 * pg;
            __hip_atomic_fetch_add(hist + ea, 1u, __ATOMIC_RELAXED, __HIP_MEMORY_SCOPE_WORKGROUP); __hip_atomic_fetch_add(hist + eb, 1u, __ATOMIC_RELAXED, __HIP_MEMORY_SCOPE_WORKGROUP); }
        __syncthreads();
        TSE(102);
    }
    if (F.tid < 32) { const unsigned c = hist[F.tid]; atomicAdd(cnt + F.tid, c); bcnt[(size_t)blockIdx.x * 32 + F.tid] = c; }
}
__device__ __forceinline__ void row_phase_b(Frame& F, int layer, bool make_h) {
    const int gw = F.vcu * NWAVES + F.wave, NGW = F.G * NWAVES, r4 = F.lane >> 5, sub = F.lane & 31; const float* mods = (const float*)(F.ws + WS_MODS) + (size_t)layer * 9 * 6144;
    const float* modn = (const float*)(F.ws + WS_MODS) + (size_t)(layer + 1) * 9 * 6144;
    const bf16_t* MO = (const bf16_t*)(F.ws + WS_R1); bf16_t* H = (bf16_t*)(F.ws + WS_R0); float* X = F.out;
    const float* lg = F.in[6] + (size_t)(layer * 2 + 1) * D; const float* lb = F.in[7] + (size_t)(layer * 2 + 1) * D;
    for (int quad = gw; quad < NLAT / 2; quad += NGW) { const int row = quad * 2 + r4;
        const int b = row >> 12; const float* mr = mods + (size_t)b * 6144;
        f32x4 v[8];
#pragma unroll
        for (int j = 0; j < 8; ++j) { const int q = sub + 32 * j; const u32x2 m0 = ((const u32x2*)(MO + (size_t)row * D))[q], m1 = ((const u32x2*)(MO + ((size_t)NLAT + row) * D))[q];
            const f32x4 m = (f32x4){bflo(m0.x) + bflo(m1.x), bfhi(m0.x) + bfhi(m1.x), bflo(m0.y) + bflo(m1.y), bfhi(m0.y) + bfhi(m1.y)};
            v[j] = ((const f32x4*)(X + (size_t)row * D))[q] * ALPHA + ((const f32x4*)(mr + 5 * 1024))[q] * m; }
        float mean, rstd; ln_stats16(v, mean, rstd);
#pragma unroll
        for (int j = 0; j < 8; ++j) { const int q = sub + 32 * j; v[j] = (v[j] - mean) * rstd * ((const f32x4*)lg)[q] + ((const f32x4*)lb)[q]; ((f32x4*)(X + (size_t)row * D))[q] = v[j]; }
        if (make_h) { const float* mn = modn + (size_t)b * 6144;
            ln_stats16(v, mean, rstd);
#pragma unroll
            for (int j = 0; j < 8; ++j) { const int q = sub + 32 * j; const f32x4 o = (v[j] - mean) * rstd * (((const f32x4*)(mn + 1024))[q] + 1.f) + ((const f32x4*)mn)[q];
                ((u32x2*)(H + (size_t)row * D))[q] = (u32x2){pk2(o.x, o.y), pk2(o.z, o.w)}; } }
    }
}

__device__ __forceinline__ void moe_tile_prefix(Frame& F, int layer) {
    volatile LAS int* ts = (volatile LAS int*)(F.lds + LDSCTL_OFF + LC_TSTART);
    if (F.tid == 0) { int acc = 0; for (int e = 0; e < NE; ++e) { ts[e] = acc; acc += (int)((xb_ld(F.ctl + CW_CNT + layer * 128 + e) + 255u) >> 8); } ts[NE] = acc; }
    __syncthreads();
}
__device__ __forceinline__ void moe_positions(Frame& F, int layer) {
    moe_tile_prefix(F, layer);
    const LAS int* ts = (const LAS int*)(F.lds + LDSCTL_OFF + LC_TSTART);
    const int* eidx = (const int*)(F.ws + WS_MISC + MISC_EIDX); int* rowtok = (int*)(F.ws + WS_MISC + MISC_ROWTOK);
    const unsigned* bcnt = (const unsigned*)(F.ws + WS_MISC + MISC_BCNT); unsigned* cnt = F.ctl + CW_CNT + layer * 128;
    LAS unsigned* part = (LAS unsigned*)F.lds;
    LAS unsigned* base = (LAS unsigned*)(F.lds + LDSCTL_OFF + LC_BASE); LAS unsigned* lcur = (LAS unsigned*)(F.lds + LDSCTL_OFF + LC_LCUR);
    const int blk = (int)blockIdx.x, APB = (2 * NLAT) / F.G;
    { const int e = F.tid & 31, p = F.tid >> 5; unsigned sacc = 0u; for (int bb = p; bb < blk; bb += 16) sacc += bcnt[(size_t)bb * 32 + e]; part[p * 32 + e] = sacc; }
    __syncthreads();
    if (F.tid < 32) { unsigned sacc = 0u;
#pragma unroll
        for (int p = 0; p < 16; ++p) sacc += part[p * 32 + F.tid];
        base[F.tid] = (unsigned)ts[F.tid] * 256u + sacc; lcur[F.tid] = 0u; }
    __syncthreads();
    for (int al = F.tid; al < APB; al += NTHREADS) { const int a = blk * APB + al; const int e = eidx[a];
        const int pos = (int)(base[e] + __hip_atomic_fetch_add(lcur + e, 1u, __ATOMIC_RELAXED, __HIP_MEMORY_SCOPE_WORKGROUP)); rowtok[pos] = a; }
    __syncthreads();
    const int gt = F.vcu * NTHREADS + F.tid;
    if (gt < NE * 256) { const int e = gt >> 8, r = gt & 255; const int c = (int)xb_ld(cnt + e); const int padded = (c + 255) & ~255; if (c + r < padded) rowtok[ts[e] * 256 + c + r] = -1; }
    __syncthreads();
}

struct DenseOrder {            static constexpr bool GATHER = false; __device__ __forceinline__ int rowoffB(int R, int pitch) const { return R * pitch; }
    int nM, nN, nwg, G, c; const char* A; const char* B; size_t strideA, strideB;
    __device__ void init(int nM_, int nN_, int G_, int c_, const void* A_, size_t sA, const void* B_, size_t sB) { nM = nM_; nN = nN_; nwg = nM * nN; G = G_; c = c_; A = (const char*)A_; B = (const char*)B_; strideA = sA; strideB = sB; }
    __device__ bool next(int i, pg8::Unit& u) const {
        const long L = (long)i * G + c; if (L >= nwg) return false;
        int wgid = (int)L; { const int q = nwg / 8, r = nwg % 8, xcd = wgid % 8, off = wgid / 8; wgid = (xcd < r ? xcd * (q + 1) : r * (q + 1) + (xcd - r) * q) + off; }
        const int nig = 8 * nN, gid = wgid / nig, fm = gid * 8, gsz = (nM - fm) < 8 ? (nM - fm) : 8;
        u.pm = fm + ((wgid % nig) % gsz); u.pn = (wgid % nig) / gsz; u.A = A + (size_t)u.pm * strideA; u.B = B + (size_t)u.pn * strideB; return true;
    }
};
template <bool GATHER_> struct MoeOrder {
    static constexpr bool GATHER = GATHER_;
    const LAS int* ts; int G, c; const char* A; const char* W; size_t strideA, strideE, strideN; const int* rowtok;
    __device__ __forceinline__ int rowoffB(int R, int pitch) const { return R * pitch; }
    __device__ __forceinline__ const char* abase() const { return A; }
    __device__ __forceinline__ int arow(const pg8::Unit& u, int r) const { const int a = rowtok[u.pm * 256 + r]; return a < 0 ? 0 : (a >> 1); }
    __device__ bool next(int i, pg8::Unit& u) const {
        const int L = i * G + c; const int ntile = ts[NE]; if (L >= ntile * 4) return false;
        const int rt = L >> 2, pn = L & 3; int e = 0;
#pragma unroll 1
        for (int q = 1; q < NE; ++q) e += (ts[q] <= rt) ? 1 : 0;
        u.pm = rt; u.pn = pn; u.A = A + (size_t)rt * strideA; u.B = W + (size_t)e * strideE + (size_t)pn * strideN; return true;
    }
};
struct ChanDftOrder {          static constexpr bool GATHER = false;
    int G, c; const char* A; const char* H;
    __device__ __forceinline__ int rowoffB(int R, int pitch) const { return ((R & 63) * 64 + (R >> 6)) * pitch; }
    __device__ bool next(int i, pg8::Unit& u) const {
        const int L = i * G + c; if (L >= 1024) return false;
        const int nt = L >> 3, g = (L >> 1) & 3, mt = L & 1, b = nt >> 4, t2 = nt & 15;
        u.pm = g * 2 + mt; u.pn = nt; u.A = A + (size_t)mt * 256 * 256 * 2; u.B = H + ((size_t)(b * SEQ + 4 * t2) * D + g * 256) * 2; return true;
    }
};
struct Dft1Order {             static constexpr bool GATHER = false;
    int G, c; const char* A; const char* GT1;
    __device__ __forceinline__ int rowoffB(int R, int pitch) const { return (R >> 6) * 8192 + (R & 63) * 64; }
    __device__ bool next(int i, pg8::Unit& u) const {
        const int L = i * G + c; if (L >= NB * 256) return false;
        u.pm = 0; u.pn = L; u.A = A; u.B = GT1 + (size_t)L * 4 * 8192 * 2; return true;
    }
};
struct Dft2Order {             static constexpr bool GATHER = false;
    int G, c; const char* A; const char* U;
    __device__ __forceinline__ int rowoffB(int R, int pitch) const { return R * pitch; }
    __device__ bool next(int i, pg8::Unit& u) const {
        const int L = i * G + c; if (L >= NB * 64 * 4) return false;
        const int pn = L & 3, ka = (L >> 2) & 63, b = L >> 8;
        u.pm = b * 64 + ka; u.pn = pn; u.A = A; u.B = U + ((size_t)(b * 1024 + pn * 256) * 8192 + ka * 64) * 2; return true;
    }
};

struct EpiInProj {
    static constexpr bool PERM = true;
    bf16_t *GX, *QB, *KB, *VB; const float* rope;
    __device__ __forceinline__ void operator()(const f32x4 (&acc)[2][2][4][2], const pg8::Unit& u, int wr, int wc, int fr, int fq) const {
        const int region = u.pn >> 1, cb = (u.pn & 1) * 256 + wc * 32 + 8 * fq; const bool latent = u.pm < (NLAT / 256);
        const bool dorope = latent && (region == 2 || region == 3); const int axis = wc & 1, half = fq >> 1, f0 = 8 * (fq & 1);
        if (region == 2 && !latent) return;
#pragma unroll
        for (int ai = 0; ai < 2; ++ai)
#pragma unroll
            for (int m = 0; m < 4; ++m) { const int row = u.pm * 256 + ai * 128 + wr * 64 + m * 16 + fr;
#pragma unroll
                for (int bj = 0; bj < 2; ++bj) { const int c = cb + bj * 128; float v[8];
#pragma unroll
                    for (int i = 0; i < 4; ++i) { v[i] = acc[ai][bj][m][0][i]; v[4 + i] = acc[ai][bj][m][1][i]; }
                    if (dorope) { const int tn = row & 4095, pos = axis ? (tn & 63) : (tn >> 6); const f32x4* cs = (const f32x4*)(rope + (size_t)(pos * 16 + f0) * 2);
                        const f32x4 c0 = cs[0], c1 = cs[1], c2 = cs[2], c3 = cs[3];
                        const float co[8] = {c0.x, c0.z, c1.x, c1.z, c2.x, c2.z, c3.x, c3.z}, si[8] = {c0.y, c0.w, c1.y, c1.w, c2.y, c2.w, c3.y, c3.w};
#pragma unroll
                        for (int i = 0; i < 8; ++i) { const float pv = __shfl_xor(v[i], 32); v[i] = v[i] * co[i] + (half ? pv : -pv) * si[i]; } }
                    if (region == 2) {
#pragma unroll
                        for (int i = 0; i < 8; ++i) v[i] *= QSCALE; }
                    const u32x4 w = (u32x4){pg8::cvt_pk_bf16(v[0], v[1]), pg8::cvt_pk_bf16(v[2], v[3]), pg8::cvt_pk_bf16(v[4], v[5]), pg8::cvt_pk_bf16(v[6], v[7])};
                    bf16_t* dst = region == 0 ? GX + (size_t)row * D + c : region == 1 ? GX + (size_t)row * D + 512 + c : region == 2 ? QB + (size_t)row * 512 + c : region == 3 ? KB + (size_t)row * 512 + c : VB + (size_t)row * 512 + c;
                    *(u32x4*)dst = w; } }
    }
};
struct EpiF32 {
    static constexpr bool PERM = false;
    float* C;
    __device__ __forceinline__ void operator()(const f32x4 (&acc)[2][2][4][2], const pg8::Unit& u, int wr, int wc, int fr, int fq) const {
        const int row0 = u.pm * 256 + wr * 64 + fr, col0 = u.pn * 256 + wc * 32 + 4 * fq;
#pragma unroll
        for (int ai = 0; ai < 2; ++ai)
#pragma unroll
            for (int m = 0; m < 4; ++m) { float* rowp = C + (size_t)(row0 + ai * 128 + m * 16) * D + col0;
#pragma unroll
                for (int bj = 0; bj < 2; ++bj)
#pragma unroll
                    for (int n = 0; n < 2; ++n) *(f32x4*)(rowp + bj * 128 + n * 16) = acc[ai][bj][m][n]; }
    }
};
struct EpiSwiGLU {
    static constexpr bool PERM = true;
    bf16_t* HID;
    __device__ __forceinline__ void operator()(const f32x4 (&acc)[2][2][4][2], const pg8::Unit& u, int wr, int wc, int fr, int fq) const {
        const int cb = u.pn * 256 + wc * 32 + 8 * fq;
#pragma unroll
        for (int ai = 0; ai < 2; ++ai)
#pragma unroll
            for (int m = 0; m < 4; ++m) { const int row = u.pm * 256 + ai * 128 + wr * 64 + m * 16 + fr;
#pragma unroll
                for (int bj = 0; bj < 2; ++bj) { const int j0 = ((cb + bj * 128) >> 3) * 4; const f32x4 a = acc[ai][bj][m][0], b = acc[ai][bj][m][1];
                    const float h0 = silu_f(a[0]) * b[0], h1 = silu_f(a[1]) * b[1], h2 = silu_f(a[2]) * b[2], h3 = silu_f(a[3]) * b[3];
                    *(u32x2*)(HID + (size_t)row * FF + j0) = (u32x2){pg8::cvt_pk_bf16(h0, h1), pg8::cvt_pk_bf16(h2, h3)}; } }
    }
};
struct EpiScatter {
    static constexpr bool PERM = true;
    bf16_t* MOUT; const int* rowtok; const float* ew;
    __device__ __forceinline__ void operator()(const f32x4 (&acc)[2][2][4][2], const pg8::Unit& u, int wr, int wc, int fr, int fq) const {
        const int cb = u.pn * 256 + wc * 32 + 8 * fq;
#pragma unroll
        for (int ai = 0; ai < 2; ++ai)
#pragma unroll
            for (int m = 0; m < 4; ++m) { const int row = u.pm * 256 + ai * 128 + wr * 64 + m * 16 + fr; const int a = rowtok[row];
                if (a >= 0) { const float w = ew[a]; bf16_t* dst = MOUT + ((size_t)(a & 1) * NLAT + (a >> 1)) * D + cb;
#pragma unroll
                    for (int bj = 0; bj < 2; ++bj) { const f32x4 x = acc[ai][bj][m][0] * w, y = acc[ai][bj][m][1] * w;
                        *(u32x4*)(dst + bj * 128) = (u32x4){pg8::cvt_pk_bf16(x[0], x[1]), pg8::cvt_pk_bf16(x[2], x[3]), pg8::cvt_pk_bf16(y[0], y[1]), pg8::cvt_pk_bf16(y[2], y[3])}; } } }
    }
};
struct EpiGT1 {
    static constexpr bool PERM = true;
    bf16_t* GT1;
    __device__ __forceinline__ void operator()(const f32x4 (&acc)[2][2][4][2], const pg8::Unit& u, int wr, int wc, int fr, int fq) const {
        const int g = u.pm >> 1, mt = u.pm & 1, b = u.pn >> 4, t2 = u.pn & 15; const int cl0 = wc * 32 + 8 * fq;
#pragma unroll
        for (int ai = 0; ai < 2; ++ai)
#pragma unroll
            for (int m = 0; m < 4; ++m) { const int mrow = mt * 256 + ai * 128 + wr * 64 + m * 16 + fr; const int chan = g * 256 + (mrow & 255), part = mrow >> 8;
#pragma unroll
                for (int bj = 0; bj < 2; ++bj) { const int cl = cl0 + bj * 128, n2 = 4 * t2 + (cl >> 6), n1 = cl & 63; const f32x4 x = acc[ai][bj][m][0], y = acc[ai][bj][m][1];
                    *(u32x4*)(GT1 + ((size_t)((b * 1024 + chan) * 2 + part) * 4096) + n2 * 64 + n1) = (u32x4){pg8::cvt_pk_bf16(x[0], x[1]), pg8::cvt_pk_bf16(x[2], x[3]), pg8::cvt_pk_bf16(y[0], y[1]), pg8::cvt_pk_bf16(y[2], y[3])}; } }
    }
};
struct EpiTw {
    static constexpr bool PERM = true;
    bf16_t* U; const float* tw;
    __device__ __forceinline__ void operator()(const f32x4 (&acc)[2][2][4][2], const pg8::Unit& u, int wr, int wc, int fr, int fq) const {
        const int b = u.pn >> 8, q = u.pn & 255; const int cl0 = wc * 32 + 8 * fq;
#pragma unroll
        for (int mp = 0; mp < 2; ++mp) { const int ka = 32 * wr + 16 * mp + fr;
#pragma unroll
            for (int bj = 0; bj < 2; ++bj) { const int cl = cl0 + bj * 128, chan = 4 * q + (cl >> 6), n2 = cl & 63;
                const f32x4* t4 = (const f32x4*)(tw + ((size_t)ka * 64 + n2) * 2); const f32x4 w0 = t4[0], w1 = t4[1], w2 = t4[2], w3 = t4[3];
                const float co[8] = {w0.x, w0.z, w1.x, w1.z, w2.x, w2.z, w3.x, w3.z}, si[8] = {w0.y, w0.w, w1.y, w1.w, w2.y, w2.w, w3.y, w3.w};
                float ur[8], ui[8];
#pragma unroll
                for (int i = 0; i < 8; ++i) { const float tr = acc[0][bj][mp][i >> 2][i & 3], ti = acc[0][bj][mp + 2][i >> 2][i & 3]; ur[i] = tr * co[i] + ti * si[i]; ui[i] = ti * co[i] - tr * si[i]; }
                bf16_t* dst = U + ((size_t)((b * 1024 + chan) * 2) * 4096) + ka * 64 + n2;
                *(u32x4*)dst = (u32x4){pg8::cvt_pk_bf16(ur[0], ur[1]), pg8::cvt_pk_bf16(ur[2], ur[3]), pg8::cvt_pk_bf16(ur[4], ur[5]), pg8::cvt_pk_bf16(ur[6], ur[7])};
                *(u32x4*)(dst + 4096) = (u32x4){pg8::cvt_pk_bf16(ui[0], ui[1]), pg8::cvt_pk_bf16(ui[2], ui[3]), pg8::cvt_pk_bf16(ui[4], ui[5]), pg8::cvt_pk_bf16(ui[6], ui[7])}; } }
    }
};
struct EpiYF2 {
    static constexpr bool PERM = true;
    bf16_t* YF;
    __device__ __forceinline__ void operator()(const f32x4 (&acc)[2][2][4][2], const pg8::Unit& u, int wr, int wc, int fr, int fq) const {
        if (wr != 0) return;
        const int b = u.pm >> 6, ka = u.pm & 63; const int cb = u.pn * 256 + wc * 32 + 8 * fq;
#pragma unroll
        for (int m = 0; m < 4; ++m) { const int kb = 16 * m + fr; bf16_t* dst = YF + ((size_t)b * SEQ + ka + 64 * kb) * D + cb;
#pragma unroll
            for (int bj = 0; bj < 2; ++bj) { const f32x4 x = acc[0][bj][m][0] * (1.f / 1024.f), y = acc[0][bj][m][1] * (1.f / 1024.f);
                *(u32x4*)(dst + bj * 128) = (u32x4){pg8::cvt_pk_bf16(x[0], x[1]), pg8::cvt_pk_bf16(x[2], x[3]), pg8::cvt_pk_bf16(y[0], y[1]), pg8::cvt_pk_bf16(y[2], y[3])}; } }
    }
};
struct EpiBf16S {
    static constexpr bool PERM = true;
    bf16_t* O; float scale;
    __device__ __forceinline__ void operator()(const f32x4 (&acc)[2][2][4][2], const pg8::Unit& u, int wr, int wc, int fr, int fq) const {
        const int cb = u.pn * 256 + wc * 32 + 8 * fq;
#pragma unroll
        for (int ai = 0; ai < 2; ++ai)
#pragma unroll
            for (int m = 0; m < 4; ++m) { const int row = u.pm * 256 + ai * 128 + wr * 64 + m * 16 + fr;
#pragma unroll
                for (int bj = 0; bj < 2; ++bj) { const f32x4 x = acc[ai][bj][m][0] * scale, y = acc[ai][bj][m][1] * scale;
                    *(u32x4*)(O + (size_t)row * D + cb + bj * 128) = (u32x4){pg8::cvt_pk_bf16(x[0], x[1]), pg8::cvt_pk_bf16(x[2], x[3]), pg8::cvt_pk_bf16(y[0], y[1]), pg8::cvt_pk_bf16(y[2], y[3])}; } }
    }
};
template <class Epi, class Sched> __device__ __forceinline__ void run_gemm(Frame& F, const pg8::Shape g, const Sched& S, const Epi& E) {
#if FAST_GEMM
    pg8::Shape gg = g; asm volatile("" : "+s"(gg.K));
    pg8::gemm_phase<Epi, Sched, true>(F.lds, gg, S, E);
#else
    pg8::gemm_phase_ref<Epi, Sched>(g, S, E);
#endif
}

__device__ __forceinline__ void lru_simple(Frame& F, int b) {
    const bf16_t* GX = (const bf16_t*)(F.ws + WS_R1 + R1_GX); bf16_t* CAT = (bf16_t*)(F.ws + WS_R0); float* YF = (float*)(F.ws + WS_R2);
    const float* cw = F.in[9]; const float* cbp = F.in[10]; const float* sp = (const float*)(F.ws + WS_SMALL) + 64;
    LAS bf16_t* wl = (LAS bf16_t*)F.lds;
    LAS float* xs = (LAS float*)(F.lds + LDSCTL_OFF + LC_XS);
    const int c = F.tid, h = c >> 6, j = c & 63;
    const float w0 = cw[c], w1 = cw[LW + c], w2 = cw[2 * LW + c], w3 = cw[3 * LW + c], cb = cbp[c];
    for (int d = 0; d < 2; ++d) {
        __syncthreads();
        for (int i = F.tid; i < 2 * 8 * 64 * 64; i += NTHREADS) { const int jj = i & 63, ii = (i >> 6) & 63, hh = (i >> 12) & 7, t = i >> 15; const float* w = t ? F.in[13] : F.in[11];
            wl[i] = (bf16_t)f2bf(w[(((size_t)d * 8 + hh) * 64 + ii) * 64 + jj]); }
        __syncthreads();
        const float ba = F.in[12][d * LW + c], bx = F.in[14][d * LW + c], spc = sp[d * LW + c];
        float hst = 0.f;
        for (int step = 0; step < CTX + SEQ; ++step) {
            const bool isctx = step < CTX; const int n = isctx ? (d == 0 ? step : CTX - 1 - step) : (d == 0 ? step - CTX : SEQ - 1 - (step - CTX));
            const int len = isctx ? CTX : SEQ; const size_t row0 = isctx ? (size_t)NLAT + (size_t)b * CTX : (size_t)b * SEQ;
            float xc = cb;
            if (n - 2 >= 0) xc += bf2f(GX[(row0 + n - 2) * D + 512 + c]) * w0;
            if (n - 1 >= 0) xc += bf2f(GX[(row0 + n - 1) * D + 512 + c]) * w1;
            xc += bf2f(GX[(row0 + n) * D + 512 + c]) * w2;
            if (n + 1 < len) xc += bf2f(GX[(row0 + n + 1) * D + 512 + c]) * w3;
            __syncthreads();
            xs[c] = bf2f(f2bf(xc));
            __syncthreads();
            float ra = 0.f, rx = 0.f;
            for (int i = 0; i < 64; ++i) { const float xv = xs[h * 64 + i]; ra += xv * bf2f(wl[((0 * 8 + h) * 64 + i) * 64 + j]); rx += xv * bf2f(wl[((1 * 8 + h) * 64 + i) * 64 + j]); }
            const float r = sigmoid_f(ra + ba), ig = sigmoid_f(rx + bx);
            const float log_a = -8.f * spc * r; const float a = expf(log_a); const float mult = sqrtf(-expm1f(2.f * log_a));
            hst = a * hst + mult * ig * xc;
            if (!isctx) { const size_t o = ((size_t)b * SEQ + n) * LW + c;
                if (d == 0) YF[o] = hst;
                else { const float g = bf2f(GX[((size_t)b * SEQ + n) * D + c]); CAT[((size_t)b * SEQ + n) * D + c] = (bf16_t)f2bf((YF[o] + hst) * gelu_tanh_f(g)); } }
        }
    }
    __syncthreads();
}

__device__ __forceinline__ void attn_simple(Frame& F) {
    const bf16_t* QB = (const bf16_t*)(F.ws + WS_R1 + R1_QB); const bf16_t* KB = (const bf16_t*)(F.ws + WS_R1 + R1_KB); const bf16_t* VB = (const bf16_t*)(F.ws + WS_R1 + R1_VB);
    bf16_t* CAT = (bf16_t*)(F.ws + WS_R0); const float lam = ((const float*)(F.ws + WS_SMALL))[0]; const float* subln = F.in[17];
    LAS float* Qs = (LAS float*)F.lds;
    LAS float* Ks = Qs + 64 * 128;
    LAS float* Vs = Ks + 64 * 129;
    LAS float* Ps = Vs + 64 * 128;
    const int lane = F.lane, wv = F.wave;
    for (int u = F.vcu; u < NB * NH * (SEQ / 64); u += F.G) {
        const int qb = u & 63, h = (u >> 6) & 3, b = u >> 8;
        __syncthreads();
        for (int i = F.tid; i < 64 * 128; i += NTHREADS) { const int r = i >> 7, cc = i & 127; Qs[i] = bf2f(QB[((size_t)b * SEQ + qb * 64 + r) * 512 + h * 128 + cc]); }
        float m1[8], m2[8], l1[8], l2[8], o1a[8], o1b[8], o2a[8], o2b[8];
#pragma unroll
        for (int r = 0; r < 8; ++r) { m1[r] = -INFINITY; m2[r] = -INFINITY; l1[r] = 0.f; l2[r] = 0.f; o1a[r] = 0.f; o1b[r] = 0.f; o2a[r] = 0.f; o2b[r] = 0.f; }
        for (int pass = 0; pass < 2; ++pass) {
            for (int t = 0; t < (CTX + SEQ) / 64; ++t) {
                const size_t krow0 = t < 4 ? (size_t)NLAT + (size_t)b * CTX + t * 64 : (size_t)b * SEQ + (t - 4) * 64;
                __syncthreads();
                for (int i = F.tid; i < 64 * 128; i += NTHREADS) { const int r = i >> 7, cc = i & 127; Ks[r * 129 + cc] = bf2f(KB[(krow0 + r) * 512 + h * 128 + cc]); Vs[i] = bf2f(VB[(krow0 + r) * 512 + h * 128 + cc]); }
                __syncthreads();
#pragma unroll
                for (int r = 0; r < 8; ++r) {
                    const LAS float* q = Qs + (wv * 8 + r) * 128; const LAS float* k = Ks + lane * 129;
                    float s1 = 0.f, s2 = 0.f;
                    for (int dd = 0; dd < 64; ++dd) { s1 += q[dd] * k[dd]; s2 += q[64 + dd] * k[64 + dd]; }
                    if (pass == 0) { m1[r] = fmaxf(m1[r], s1); m2[r] = fmaxf(m2[r], s2); }
                    else {
                        const float p1 = exp2f(s1 - m1[r]), p2 = exp2f(s2 - m2[r]);
                        l1[r] += p1; l2[r] += p2;
                        Ps[(wv * 2 + 0) * 64 + lane] = p1; Ps[(wv * 2 + 1) * 64 + lane] = p2;
                        LDS_WAIT(); asm volatile("" ::: "memory");
                        float a0 = 0.f, a1 = 0.f, c0 = 0.f, c1 = 0.f;
                        for (int kk = 0; kk < 64; ++kk) { const float pp1 = Ps[(wv * 2 + 0) * 64 + kk], pp2 = Ps[(wv * 2 + 1) * 64 + kk]; const float va = Vs[kk * 128 + lane], vb = Vs[kk * 128 + 64 + lane];
                            a0 += pp1 * va; a1 += pp1 * vb; c0 += pp2 * va; c1 += pp2 * vb; }
                        o1a[r] += a0; o1b[r] += a1; o2a[r] += c0; o2b[r] += c1;
                        LDS_WAIT(); asm volatile("" ::: "memory");
                    }
                }
            }
            if (pass == 0) {
#pragma unroll
                for (int r = 0; r < 8; ++r) { m1[r] = wave_max(m1[r]); m2[r] = wave_max(m2[r]); }
            }
        }
#pragma unroll
        for (int r = 0; r < 8; ++r) {
            const float L1 = wave_sum(l1[r]), L2 = wave_sum(l2[r]);
            const float oa = o1a[r] / L1 - lam * o2a[r] / L2, ob = o1b[r] / L1 - lam * o2b[r] / L2;
            const float ms = wave_sum(oa * oa + ob * ob) * (1.f / 128.f); const float rs = 1.f / sqrtf(ms + LN_EPS);
            bf16_t* dst = CAT + ((size_t)b * SEQ + qb * 64 + wv * 8 + r) * D + 512 + h * 128;
            dst[lane] = (bf16_t)f2bf(oa * rs * subln[lane] * 0.8f); dst[64 + lane] = (bf16_t)f2bf(ob * rs * subln[64 + lane] * 0.8f);
        }
    }
    __syncthreads();
}

namespace att {
typedef float f32x16 __attribute__((ext_vector_type(16)));
typedef short s16x4 __attribute__((ext_vector_type(4)));
typedef short v4i16_t __attribute__((ext_vector_type(4)));
constexpr int KSLOT = 8192, VSLOT = 16384, NSLOT = 3, NT = (CTX + SEQ) / 64;
constexpr int L_K = 0, L_V = NSLOT * KSLOT, L_WS = L_V + NSLOT * VSLOT;
__device__ __forceinline__ int crow(int r, int hi) { return (r & 3) + 8 * (r >> 2) + 4 * hi; }
#define ATT_WAITBAR(N) asm volatile("s_waitcnt vmcnt(" #N ") lgkmcnt(0)\n\ts_barrier" ::: "memory")
__device__ __forceinline__ unsigned cvtpk(float lo, float hi) { unsigned r; asm("v_cvt_pk_bf16_f32 %0, %1, %2" : "=v"(r) : "v"(lo), "v"(hi)); return r; }
__device__ __forceinline__ s16x4 vtr(const LAS unsigned char* p) { return __builtin_bit_cast(s16x4, __builtin_amdgcn_ds_read_tr16_b64_v4i16((LAS v4i16_t*)p)); }

__device__ __forceinline__ void attn_fast(Frame& F) {
    const bf16_t* QB = (const bf16_t*)(F.ws + WS_R1 + R1_QB); const bf16_t* KB = (const bf16_t*)(F.ws + WS_R1 + R1_KB); const bf16_t* VB = (const bf16_t*)(F.ws + WS_R1 + R1_VB);
    bf16_t* CAT = (bf16_t*)(F.ws + WS_R0); const float lam = ((const float*)(F.ws + WS_SMALL))[0]; const float* subln = F.in[17];
    LAS unsigned char* lds = F.lds;
    const int lane = F.lane, r32 = lane & 31, hi = lane >> 5, wid = F.wave;
    LAS float* wsf = (LAS float*)(lds + L_WS) + wid * 64;
    for (int u = F.vcu; u < NB * NH * (SEQ / 256); u += F.G) {
        const int bh = u >> 4, qb = u & 15, b = bh >> 2, h = bh & 3;
        const size_t qrow = (size_t)b * SEQ + qb * 256 + wid * 32;
        unsigned o2p[4][8];
        f32x16 o[4];
#pragma unroll 1
        for (int pass = 0; pass < 2; ++pass) {
            const int s = 1 - pass;
            bf16x8 qf[4];
#pragma unroll
            for (int d0 = 0; d0 < 4; ++d0) qf[d0] = *(const bf16x8*)(QB + (qrow + r32) * 512 + h * 128 + s * 64 + d0 * 16 + hi * 8);
#pragma unroll
            for (int dq = 0; dq < 4; ++dq)
#pragma unroll
                for (int r = 0; r < 16; ++r) o[dq][r] = 0.f;
            float lsum = 0.f;
            const bf16_t* ksrc = KB + (size_t)lane * 512 + h * 128 + s * 64 + wid * 8;
            const bf16_t* vsrc0 = VB + (size_t)(16 * ((wid * 2) & 3) + (lane >> 2)) * 512 + h * 128 + ((wid * 2) >> 2) * 32 + (lane & 3) * 8;
            const bf16_t* vsrc1 = VB + (size_t)(16 * ((wid * 2 + 1) & 3) + (lane >> 2)) * 512 + h * 128 + ((wid * 2 + 1) >> 2) * 32 + (lane & 3) * 8;
#define ATT_DMA(t, slot) do { const size_t r0_ = ((t) < 4 ? (size_t)NLAT + (size_t)b * CTX + (t) * 64 : (size_t)b * SEQ + ((t) - 4) * 64) * 512; \
        __builtin_amdgcn_global_load_lds((const unsigned*)(ksrc + r0_), (LAS unsigned*)(lds + L_K + (slot) * KSLOT + wid * 1024), 16, 0, 0); \
        __builtin_amdgcn_global_load_lds((const unsigned*)(vsrc0 + r0_), (LAS unsigned*)(lds + L_V + (slot) * VSLOT + (wid * 2) * 1024), 16, 0, 0); \
        __builtin_amdgcn_global_load_lds((const unsigned*)(vsrc1 + r0_), (LAS unsigned*)(lds + L_V + (slot) * VSLOT + (wid * 2 + 1) * 1024), 16, 0, 0); } while (0)
            ATT_DMA(0, 0); ATT_DMA(1, 1);
            ATT_WAITBAR(3);
            int slot = 0;
#pragma unroll 1
            for (int t = 0; t < NT; ++t) {
                const int s2 = slot == 0 ? 2 : slot - 1;
                if (t + 2 < NT) ATT_DMA(t + 2, s2);
                f32x16 p0, p1;
#pragma unroll
                for (int r = 0; r < 16; ++r) { p0[r] = 0.f; p1[r] = 0.f; }
                const LAS unsigned char* kb = lds + L_K + slot * KSLOT + hi * 1024 + r32 * 16;
#pragma unroll
                for (int d0 = 0; d0 < 4; ++d0) {
                    const bf16x8 k0 = *(const LAS bf16x8*)(kb + d0 * 2048), k1 = *(const LAS bf16x8*)(kb + d0 * 2048 + 512);
                    p0 = __builtin_amdgcn_mfma_f32_32x32x16_bf16(k0, qf[d0], p0, 0, 0, 0);
                    p1 = __builtin_amdgcn_mfma_f32_32x32x16_bf16(k1, qf[d0], p1, 0, 0, 0);
                }
                float sa = 0.f, sb = 0.f;
#pragma unroll
                for (int r = 0; r < 16; ++r) { p0[r] = __builtin_amdgcn_exp2f(p0[r]); p1[r] = __builtin_amdgcn_exp2f(p1[r]); sa += p0[r]; sb += p1[r]; }
                lsum += sa + sb;
                u32x4 pk[4];
#pragma unroll
                for (int i = 0; i < 4; ++i) { pk[0][i] = cvtpk(p0[2 * i], p0[2 * i + 1]); pk[1][i] = cvtpk(p0[8 + 2 * i], p0[8 + 2 * i + 1]); pk[2][i] = cvtpk(p1[2 * i], p1[2 * i + 1]); pk[3][i] = cvtpk(p1[8 + 2 * i], p1[8 + 2 * i + 1]); }
                const LAS unsigned char* vb = lds + L_V + slot * VSLOT + ((lane >> 4) & 1) * 32 + (lane & 3) * 8 + (4 * hi + ((lane & 15) >> 2)) * 64;
#pragma unroll
                for (int dq = 0; dq < 4; ++dq)
#pragma unroll
                    for (int ks = 0; ks < 4; ++ks) {
                        const s16x4 vlo = vtr(vb + dq * 4096 + ks * 1024), vhi = vtr(vb + dq * 4096 + ks * 1024 + 512);
                        const bf16x8 vf = (bf16x8){vlo[0], vlo[1], vlo[2], vlo[3], vhi[0], vhi[1], vhi[2], vhi[3]};
                        o[dq] = __builtin_amdgcn_mfma_f32_32x32x16_bf16(__builtin_bit_cast(bf16x8, pk[ks]), vf, o[dq], 0, 0, 0);
                    }
                if (t + 2 < NT) ATT_WAITBAR(3); else ATT_WAITBAR(0);
                slot = slot == 2 ? 0 : slot + 1;
            }
#undef ATT_DMA
            { auto rr = __builtin_amdgcn_permlane32_swap(__float_as_uint(lsum), __float_as_uint(lsum), false, false); lsum = __uint_as_float(rr[0]) + __uint_as_float(rr[1]); }
            if (hi == 0) wsf[r32] = 1.0f / lsum;
            asm volatile("s_waitcnt lgkmcnt(0)" ::: "memory");
            float rl[16];
#pragma unroll
            for (int r = 0; r < 16; ++r) rl[r] = wsf[crow(r, hi)];
            asm volatile("s_waitcnt lgkmcnt(0)" ::: "memory");
            if (pass == 0) {
#pragma unroll
                for (int dq = 0; dq < 4; ++dq)
#pragma unroll
                    for (int i = 0; i < 8; ++i) o2p[dq][i] = cvtpk(lam * o[dq][2 * i] * rl[2 * i], lam * o[dq][2 * i + 1] * rl[2 * i + 1]);
            } else {
#pragma unroll
                for (int dq = 0; dq < 4; ++dq)
#pragma unroll
                    for (int r = 0; r < 16; ++r) o[dq][r] *= rl[r];
            }
        }
        float ss[16];
#pragma unroll
        for (int r = 0; r < 16; ++r) ss[r] = 0.f;
#pragma unroll
        for (int dq = 0; dq < 4; ++dq)
#pragma unroll
            for (int i = 0; i < 8; ++i) { const unsigned w = o2p[dq][i]; o[dq][2 * i] -= bflo(w); o[dq][2 * i + 1] -= bfhi(w); ss[2 * i] += o[dq][2 * i] * o[dq][2 * i]; ss[2 * i + 1] += o[dq][2 * i + 1] * o[dq][2 * i + 1]; }
#pragma unroll
        for (int r = 0; r < 16; ++r) {
#pragma unroll
            for (int off = 1; off < 32; off <<= 1) ss[r] += __shfl_xor(ss[r], off);
            ss[r] = 0.8f / sqrtf(ss[r] * (1.f / 128.f) + LN_EPS);
        }
#pragma unroll
        for (int dq = 0; dq < 4; ++dq) { const float g = subln[dq * 32 + r32];
#pragma unroll
            for (int r = 0; r < 16; ++r) { bf16_t* p_ = CAT + (qrow + 4 * hi) * D + 512 + h * 128 + r32; asm volatile("" : "+v"(p_)); p_[((r & 3) + 8 * (r >> 2)) * D + dq * 32] = (bf16_t)f2bf(o[dq][r] * ss[r] * g); } }
    }
    asm volatile("s_waitcnt vmcnt(0) lgkmcnt(0)\n\ts_barrier" ::: "memory");
}
}

namespace lru {
constexpr int NCHUNK = 68, XCB_PITCH = 272;
constexpr int L_XCB = 0, L_XCF = 17408, L_Y0 = L_XCF + 33280, L_Y1 = L_Y0 + 33280;
constexpr int L_SUM = L_Y0, L_HIN = L_SUM + (NCHUNK + 4) * 1024;
constexpr int L_BIAS = L_HIN + 1024;
static_assert(L_BIAS + 3072 <= LDSCTL_OFF && L_HIN >= L_Y1 + 33280, "LRU LDS map");
template <int K> __device__ __forceinline__ float dpp_shr(float v, float ident) { return __int_as_float(__builtin_amdgcn_update_dpp(__float_as_int(ident), __float_as_int(v), 0x110 + K, 0xf, 0xf, false)); }
template <int K> __device__ __forceinline__ float dpp_shl(float v, float ident) { return __int_as_float(__builtin_amdgcn_update_dpp(__float_as_int(ident), __float_as_int(v), 0x100 + K, 0xf, 0xf, false)); }
__device__ __forceinline__ float rcp_f(float x) { return __builtin_amdgcn_rcpf(x); }
__device__ __forceinline__ float sigm(float x) { return rcp_f(1.f + __expf(-x)); }

template <int MODE>
__device__ __forceinline__ void lru_phase(Frame& F) {
    const bf16_t* GX = (const bf16_t*)(F.ws + WS_R1 + R1_GX); bf16_t* CAT = (bf16_t*)(F.ws + WS_R0);
    const bf16_t* GW = (const bf16_t*)(F.ws + WS_GATEW); const float* SP = (const float*)(F.ws + WS_SMALL) + 64; float* SUMM = (float*)(F.ws + WS_MISC + MISC_SUMM);
    LAS unsigned char* lds = F.lds; const int tid = F.tid, lane = F.lane, wid = F.wave;
    const int quarter = F.vcu & 3;
    const int cp = tid & 63, tg = tid >> 6, c0 = quarter * 128 + 2 * cp;
    const float w00 = F.in[9][c0], w01 = F.in[9][c0 + 1], w10 = F.in[9][LW + c0], w11 = F.in[9][LW + c0 + 1], w20 = F.in[9][2 * LW + c0], w21 = F.in[9][2 * LW + c0 + 1], w30 = F.in[9][3 * LW + c0], w31 = F.in[9][3 * LW + c0 + 1];
    const float cb0 = F.in[10][c0], cb1 = F.in[10][c0 + 1];
    const int pr = wid >> 1, d = pr & 1, hl = pr >> 1, h = quarter * 2 + hl, fr = lane & 15, fq = lane >> 4;
    for (int i = tid; i < 3 * 256; i += NTHREADS) { const int cl = i & 127, dd = (i >> 7) & 1, arr = i >> 8, c = quarter * 128 + cl;
        ((LAS float*)(lds + L_BIAS))[i] = arr == 0 ? F.in[12][dd * LW + c] : arr == 1 ? F.in[14][dd * LW + c] : SP[dd * LW + c]; }
    const unsigned gwoff0 = (unsigned)((((d * 2) * 8 + h) * 64 + 16 * ((wid & 1) * 2) + fr) * 64 + 8 * fq);
    const int nunit = MODE == 0 ? NB * NCHUNK * 4 : NB * 64 * 4;
    for (int u = F.vcu; u < nunit; u += F.G) {
        const int b = MODE == 0 ? (u >> 2) / NCHUNK : u >> 8, chunk = MODE == 0 ? (u >> 2) % NCHUNK : 4 + ((u >> 2) & 63);
        const bool isctx = chunk < 4; const int tok0 = isctx ? chunk * 64 : (chunk - 4) * 64, len = isctx ? CTX : SEQ; const size_t row0 = isctx ? (size_t)NLAT + (size_t)b * CTX : (size_t)b * SEQ;
        bf16x8 af[2][2][2];
        { unsigned go = gwoff0; asm volatile("" : "+v"(go));
#pragma unroll
          for (int mi = 0; mi < 2; ++mi)
#pragma unroll
              for (int t = 0; t < 2; ++t)
#pragma unroll
                  for (int ks = 0; ks < 2; ++ks) af[mi][t][ks] = *(const bf16x8*)(GW + go + (t * 8 * 64 * 64 + mi * 16 * 64 + ks * 32)); }
        { unsigned x[11];
#pragma unroll
          for (int i = 0; i < 11; ++i) { const int n = tok0 + 8 * tg - 2 + i; x[i] = (n >= 0 && n < len) ? *(const unsigned*)(GX + (row0 + n) * D + 512 + c0) : 0u; }
          if (MODE == 1) {
              const float* S = SUMM + (size_t)b * 2 * NCHUNK * 1024 + quarter * 128; LAS float* LS = (LAS float*)(lds + L_SUM);
              for (int i = tid; i < (NCHUNK + 4) * 256; i += NTHREADS) { const int cc = i & 127, ab = (i >> 7) & 1, jj = i >> 8; const int j = jj < NCHUNK ? jj : jj - NCHUNK, dd = jj < NCHUNK ? (j < chunk ? 0 : 1) : 1;
                  LS[i] = S[((size_t)dd * NCHUNK + j) * 1024 + ab * 512 + cc]; } }
#pragma unroll
          for (int i = 0; i < 8; ++i) { const int tl = 8 * tg + i;
              const float a0 = cb0 + bflo(x[i]) * w00 + bflo(x[i + 1]) * w10 + bflo(x[i + 2]) * w20 + bflo(x[i + 3]) * w30;
              const float a1 = cb1 + bfhi(x[i]) * w01 + bfhi(x[i + 1]) * w11 + bfhi(x[i + 2]) * w21 + bfhi(x[i + 3]) * w31;
              *(LAS unsigned*)(lds + L_XCB + tl * XCB_PITCH + cp * 4) = pk2(a0, a1);
              ((LAS float*)(lds + L_XCF))[(2 * cp) * 65 + tl] = a0; ((LAS float*)(lds + L_XCF))[(2 * cp + 1) * 65 + tl] = a1; } }
        __syncthreads();
        if (MODE == 1) {
            if (tid < 256) { const int dd = tid >> 7, cl = tid & 127; const LAS float* LS = (const LAS float*)(lds + L_SUM) + cl; float hcar = 0.f;
                if (dd == 0) { for (int j = 0; j < chunk; ++j) hcar = LS[j * 256] * hcar + LS[j * 256 + 128]; }
                else { for (int j = 3; j >= 0; --j) hcar = LS[(NCHUNK + j) * 256] * hcar + LS[(NCHUNK + j) * 256 + 128];
                       for (int j = NCHUNK - 1; j > chunk; --j) hcar = LS[j * 256] * hcar + LS[j * 256 + 128]; }
                ((LAS float*)(lds + L_HIN))[tid] = hcar; }
            __syncthreads(); }
        { bf16x8 bfr[4][2];
#pragma unroll
          for (int nt = 0; nt < 4; ++nt)
#pragma unroll
              for (int ks = 0; ks < 2; ++ks) bfr[nt][ks] = *(const LAS bf16x8*)(lds + L_XCB + (16 * nt + fr) * XCB_PITCH + (hl * 64 + 32 * ks + 8 * fq) * 2);
          const int cbase = hl * 64 + (wid & 1) * 32 + 4 * fq;
          const LAS float* xcf = (const LAS float*)(lds + L_XCF) + cbase * 65 + fr; LAS float* Yd = (LAS float*)(lds + (d ? L_Y1 : L_Y0)) + cbase * 65 + fr;
#pragma unroll
          for (int mi = 0; mi < 2; ++mi) { const int mt = (wid & 1) * 2 + mi;
              f32x4 acc[2][4];
#pragma unroll
              for (int t = 0; t < 2; ++t)
#pragma unroll
                  for (int nt = 0; nt < 4; ++nt) { acc[t][nt] = (f32x4){0.f, 0.f, 0.f, 0.f};
#pragma unroll
                      for (int ks = 0; ks < 2; ++ks) acc[t][nt] = __builtin_amdgcn_mfma_f32_16x16x32_bf16(af[mi][t][ks], bfr[nt][ks], acc[t][nt], 0, 0, 0); }
#pragma unroll
              for (int reg = 0; reg < 4; ++reg) { const int cl = hl * 64 + 16 * mt + 4 * fq + reg, c = quarter * 128 + cl;
                  const LAS float* bb_ = (const LAS float*)(lds + L_BIAS) + d * 128 + cbase + 16 * mi + reg; const float ba = bb_[0], bx = bb_[256], spc = bb_[512];
                  float A[4], Bv[4];
#pragma unroll
                  for (int nt = 0; nt < 4; ++nt) { const float xcv = xcf[(16 * mi + reg) * 65 + 16 * nt];
                      const float r = sigm(acc[0][nt][reg] + ba), ig = sigm(acc[1][nt][reg] + bx);
                      const float la = -8.f * spc * r, a = __expf(la), x2 = 2.f * la;
                      const float m2 = x2 > -0.3f ? -x2 * (1.f + x2 * (0.5f + x2 * (1.f / 6.f + x2 * (1.f / 24.f + x2 * (1.f / 120.f + x2 * (1.f / 720.f + x2 * (1.f / 5040.f))))))) : 1.f - __expf(x2);
                      A[nt] = a; Bv[nt] = sqrtf(m2) * ig * xcv; }
                  if (d == 0) {
#pragma unroll
                      for (int nt = 0; nt < 4; ++nt) {
                          { const float ap = dpp_shr<1>(A[nt], 1.f), bp = dpp_shr<1>(Bv[nt], 0.f); Bv[nt] = A[nt] * bp + Bv[nt]; A[nt] *= ap; }
                          { const float ap = dpp_shr<2>(A[nt], 1.f), bp = dpp_shr<2>(Bv[nt], 0.f); Bv[nt] = A[nt] * bp + Bv[nt]; A[nt] *= ap; }
                          { const float ap = dpp_shr<4>(A[nt], 1.f), bp = dpp_shr<4>(Bv[nt], 0.f); Bv[nt] = A[nt] * bp + Bv[nt]; A[nt] *= ap; }
                          { const float ap = dpp_shr<8>(A[nt], 1.f), bp = dpp_shr<8>(Bv[nt], 0.f); Bv[nt] = A[nt] * bp + Bv[nt]; A[nt] *= ap; } }
                      if (MODE == 0) { float Ac = 1.f, Bc = 0.f;
#pragma unroll
                          for (int nt = 0; nt < 4; ++nt) { const float At = __shfl(A[nt], (lane & 48) | 15), Bt = __shfl(Bv[nt], (lane & 48) | 15); Bc = At * Bc + Bt; Ac *= At; }
                          if (fr == 0) { float* S = SUMM + ((size_t)(b * 2 + d) * NCHUNK + chunk) * 1024 + c; S[0] = Ac; S[512] = Bc; } }
                      else { float hc = ((const LAS float*)(lds + L_HIN))[d * 128 + cl];
#pragma unroll
                          for (int nt = 0; nt < 4; ++nt) { const float hv = A[nt] * hc + Bv[nt]; Yd[(16 * mi + reg) * 65 + 16 * nt] = hv; hc = __shfl(hv, (lane & 48) | 15); } }
                  } else {
#pragma unroll
                      for (int nt = 0; nt < 4; ++nt) {
                          { const float ap = dpp_shl<1>(A[nt], 1.f), bp = dpp_shl<1>(Bv[nt], 0.f); Bv[nt] = A[nt] * bp + Bv[nt]; A[nt] *= ap; }
                          { const float ap = dpp_shl<2>(A[nt], 1.f), bp = dpp_shl<2>(Bv[nt], 0.f); Bv[nt] = A[nt] * bp + Bv[nt]; A[nt] *= ap; }
                          { const float ap = dpp_shl<4>(A[nt], 1.f), bp = dpp_shl<4>(Bv[nt], 0.f); Bv[nt] = A[nt] * bp + Bv[nt]; A[nt] *= ap; }
                          { const float ap = dpp_shl<8>(A[nt], 1.f), bp = dpp_shl<8>(Bv[nt], 0.f); Bv[nt] = A[nt] * bp + Bv[nt]; A[nt] *= ap; } }
                      if (MODE == 0) { float Ac = 1.f, Bc = 0.f;
#pragma unroll
                          for (int nt = 3; nt >= 0; --nt) { const float At = __shfl(A[nt], lane & 48), Bt = __shfl(Bv[nt], lane & 48); Bc = At * Bc + Bt; Ac *= At; }
                          if (fr == 0) { float* S = SUMM + ((size_t)(b * 2 + d) * NCHUNK + chunk) * 1024 + c; S[0] = Ac; S[512] = Bc; } }
                      else { float hc = ((const LAS float*)(lds + L_HIN))[d * 128 + cl];
#pragma unroll
                          for (int nt = 3; nt >= 0; --nt) { const float hv = A[nt] * hc + Bv[nt]; Yd[(16 * mi + reg) * 65 + 16 * nt] = hv; hc = __shfl(hv, lane & 48); } }
                  }
                  __builtin_amdgcn_sched_barrier(0);
              } } }
        __syncthreads();
        if (MODE == 1) {
            const LAS float* Y0 = (const LAS float*)(lds + L_Y0); const LAS float* Y1 = (const LAS float*)(lds + L_Y1);
#pragma unroll
            for (int i = 0; i < 8; ++i) { const int tl = 8 * tg + i; const size_t row = row0 + tok0 + tl; const unsigned g = *(const unsigned*)(GX + row * D + c0);
                const float y0 = Y0[(2 * cp) * 65 + tl] + Y1[(2 * cp) * 65 + tl], y1 = Y0[(2 * cp + 1) * 65 + tl] + Y1[(2 * cp + 1) * 65 + tl];
                *(unsigned*)(CAT + row * D + c0) = pk2(y0 * gelu_tanh_f(bflo(g)), y1 * gelu_tanh_f(bfhi(g))); }
            __syncthreads();
        }
    }
}
}

constexpr int NPHASE = 18;
__global__ void __launch_bounds__(NTHREADS, 2) mk_fwd(Args args) {
    extern __shared__ __attribute__((aligned(16))) unsigned char lds_raw[];
    Frame F{(LAS unsigned char*)lds_raw, (unsigned*)(args.ws + WS_CTL), args.ws, 0, 0, 0, 0, 0, InRef{args}, args.out};
    F.tid = threadIdx.x; F.lane = F.tid & 63; F.wave = __builtin_amdgcn_readfirstlane(F.tid >> 6);
    F.G = gridDim.x; { const int bx = blockIdx.x; F.vcu = (F.G % 8 == 0) ? (bx % 8) * (F.G / 8) + bx / 8 : bx; }
    for (int u = F.tid; u < (LDS_BYTES - LDSCTL_OFF) / 4; u += NTHREADS) ((LAS unsigned*)(F.lds + LDSCTL_OFF))[u] = 0u;
    __syncthreads();
    XcdBarrier bar = xcd_barrier_post(F.ctl + CW_BAR, (volatile LAS unsigned*)(F.lds + LDSCTL_OFF + LC_BAR));
#if defined(PH_RUNTIME)
    const int lo = args.ph_lo, hi = args.ph_hi;
#else
    constexpr int lo = 0, hi = NPHASE;
#endif
#ifndef TIME_PHASE
#define TIME_PHASE -1
#endif
#ifndef REP3
#define REP3 0u
#endif
#ifndef REP_MASK
#define REP_MASK 0u
#endif
#define REPS(k) for (int rep_ = 0; rep_ <= (int)((REP_MASK >> (k)) & 1u); ++rep_)
#define REPBAR() do { if (rep_ > 0) xcd_barrier(bar); } while (0)
#ifndef SKIP_MASK
#define SKIP_MASK 0u
#endif
#define IN(k) (!((SKIP_MASK >> (k)) & 1u) && lo <= (k) && (k) < hi)
#define SEAM(k) do { if (IN(k) && IN((k) + 1)) xcd_barrier(bar); } while (0)
#define TPB(k) do { if ((k) == TIME_PHASE && blockIdx.x == 0 && threadIdx.x == 0) ((volatile LAS unsigned long long*)(F.lds + LDSCTL_OFF + LC_TP))[0] = __builtin_amdgcn_s_memrealtime(); } while (0)
#define TPE(k) do { if ((k) == TIME_PHASE && blockIdx.x == 0 && threadIdx.x == 0) { volatile LAS unsigned long long* tp_ = (volatile LAS unsigned long long*)(F.lds + LDSCTL_OFF + LC_TP); tp_[1] = tp_[1] + (__builtin_amdgcn_s_memrealtime() - tp_[0]); } } while (0)
#define PHB() do { int t_ = threadIdx.x; asm volatile("" : "+v"(t_)); F.tid = t_; F.lane = t_ & 63; F.wave = __builtin_amdgcn_readfirstlane(t_ >> 6); } while (0)
    unsigned char* ws = args.ws;
    bf16_t* R0 = (bf16_t*)(ws + WS_R0); unsigned char* R1 = ws + WS_R1;

    TPB(0); if (IN(0)) REPS(0) { REPBAR(); PHB(); p0_prologue(F); } SEAM(0); TPE(0);
    TPB(1); if (IN(1)) REPS(1) { REPBAR(); PHB(); p1_lnmod(F); } SEAM(1); TPE(1);
    TPB(2); if (IN(2)) REPS(2) { REPBAR();
        DenseOrder S; S.init(MALL / 256, INE / 256, F.G, (int)blockIdx.x, R0, (size_t)256 * D * 2, ws + WS_WIN, (size_t)256 * D * 2);
        EpiInProj E{(bf16_t*)(R1 + R1_GX), (bf16_t*)(R1 + R1_QB), (bf16_t*)(R1 + R1_KB), (bf16_t*)(R1 + R1_VB), (const float*)(ws + WS_ROPE)};
        run_gemm(F, pg8::Shape{D, D, D, 0u, 0u}, S, E);
    } SEAM(2); TPE(2);
    TPB(3); if (IN(3)) REPS(3) { REPBAR();
#if FAST_LRU
        for (int q_ = 0; q_ <= (int)(REP3 & 1u); ++q_) { PHB(); lru::lru_phase<0>(F); }
        xcd_barrier(bar);
        for (int q_ = 0; q_ <= (int)((REP3 >> 1) & 1u); ++q_) { PHB(); lru::lru_phase<1>(F); }
#else
        PHB(); if ((int)blockIdx.x < NB) lru_simple(F, (int)blockIdx.x);
#endif
#if FAST_ATTN
        for (int q_ = 0; q_ <= (int)((REP3 >> 2) & 1u); ++q_) { PHB(); att::attn_fast(F); }
#else
        PHB(); attn_simple(F);
#endif
    } SEAM(3); TPE(3);
    TPB(4); if (IN(4)) REPS(4) { REPBAR();
        DenseOrder S; S.init(NLAT / 256, D / 256, F.G, (int)blockIdx.x, R0, (size_t)256 * D * 2, ws + WS_WOUT, (size_t)256 * D * 2);
        EpiBf16S E{(bf16_t*)R1, 1.f};
        run_gemm(F, pg8::Shape{D, D, D, 0u, 0u}, S, E);
    } SEAM(4); TPE(4);
    TPB(5); if (IN(5)) { PHB(); row_phase_a(F, 0, F.in[0], nullptr); } SEAM(5); TPE(5);
#pragma unroll
    for (int layer = 0; layer < 2; ++layer) {
        const int pb = layer == 0 ? 6 : 14;
        unsigned char* moew = ws + WS_MOEW + (size_t)layer * MOEW_LAYER;
        TPB(pb); if (IN(pb)) { PHB(); moe_positions(F, layer); } SEAM(pb); TPE(pb);
        TPB(pb + 1); if (IN(pb + 1)) REPS(pb + 1) { REPBAR();
            PHB(); moe_tile_prefix(F, layer);
            MoeOrder<true> S{(const LAS int*)(F.lds + LDSCTL_OFF + LC_TSTART), F.G, (int)blockIdx.x, (const char*)R0, (const char*)moew, (size_t)0, (size_t)D * D * 2, (size_t)256 * D * 2, (const int*)(ws + WS_MISC + MISC_ROWTOK)};
            EpiSwiGLU E{(bf16_t*)(ws + WS_R2)};
            run_gemm(F, pg8::Shape{D, D, D, 0u, 0u}, S, E);
        } SEAM(pb + 1); TPE(pb + 1);
        TPB(pb + 2); if (IN(pb + 2)) REPS(pb + 2) { REPBAR();
            PHB(); moe_tile_prefix(F, layer);
            MoeOrder<false> S{(const LAS int*)(F.lds + LDSCTL_OFF + LC_TSTART), F.G, (int)blockIdx.x, (const char*)(ws + WS_R2), (const char*)(moew + MOEW_W2), (size_t)256 * FF * 2, (size_t)D * FF * 2, (size_t)256 * FF * 2, (const int*)(ws + WS_MISC + MISC_ROWTOK)};
            EpiScatter E{(bf16_t*)R1, (const int*)(ws + WS_MISC + MISC_ROWTOK), (const float*)(ws + WS_MISC + MISC_EW)};
            run_gemm(F, pg8::Shape{FF, FF, FF, 0u, 0u}, S, E);
        } SEAM(pb + 2); TPE(pb + 2);
        TPB(pb + 3); if (IN(pb + 3)) { PHB(); row_phase_b(F, layer, layer == 0); } SEAM(pb + 3); TPE(pb + 3);
        if (layer == 0) {
            TPB(10); if (IN(10)) REPS(10) { REPBAR();
                { ChanDftOrder S{F.G, (int)blockIdx.x, (const char*)(ws + WS_CDFT), (const char*)R0};
                  EpiGT1 E{(bf16_t*)R1};
                  run_gemm(F, pg8::Shape{256, 256, D, 0u, (unsigned)(2 * D * 2)}, S, E); }
                xcd_barrier(bar);
                { Dft1Order S{F.G, (int)blockIdx.x, (const char*)(ws + WS_M1), (const char*)R1};
                  EpiTw E{(bf16_t*)(ws + WS_U), (const float*)(ws + WS_TW)};
                  run_gemm(F, pg8::Shape{128, 128, 0, (unsigned)(4096 * 2), (unsigned)(2 * 8192 * 2)}, S, E); }
            } SEAM(10); TPE(10);
            TPB(11); if (IN(11)) REPS(11) { REPBAR();
                Dft2Order S{F.G, (int)blockIdx.x, (const char*)(ws + WS_M3), (const char*)(ws + WS_U)};
                EpiYF2 E{R0};
                run_gemm(F, pg8::Shape{128, 128, 8192, (unsigned)(4096 * 2), 0u}, S, E);
            } SEAM(11); TPE(11);
            TPB(12); if (IN(12)) REPS(12) { REPBAR();
                DenseOrder S; S.init(NLAT / 256, D / 256, F.G, (int)blockIdx.x, R0, (size_t)256 * D * 2, ws + WS_ODW, (size_t)256 * D * 2);
                EpiBf16S E{(bf16_t*)R1, 1.f};
                run_gemm(F, pg8::Shape{D, D, D, 0u, 0u}, S, E);
            } SEAM(12); TPE(12);
            TPB(13); if (IN(13)) { PHB(); row_phase_a(F, 1, F.out, F.in[20]); } SEAM(13); TPE(13);
        }
    }
    if ((TIME_PHASE >= 0 || TIME_SUB >= 0) && blockIdx.x == 0 && threadIdx.x == 0) { const unsigned long long tp_acc = ((volatile LAS unsigned long long*)(F.lds + LDSCTL_OFF + LC_TP))[1];
        const unsigned long long t0 = __builtin_amdgcn_s_memrealtime(); while (__builtin_amdgcn_s_memrealtime() - t0 < 8ull * tp_acc) __builtin_amdgcn_s_sleep(8); }
#undef IN
#undef SEAM
}

extern "C" void kernel_launch(void* const* d_in, const int* in_sizes, int n_in, void* d_out, int out_size, void* d_ws, size_t ws_size, hipStream_t stream) {
    static int grid = 0;
    if (grid == 0) {
        if (n_in != 28 || out_size != NLAT * D || ws_size < WS_END) { fprintf(stderr, "kernel_launch: unexpected problem (n_in %d, out %d, ws %zu < %zu)\n", n_in, out_size, ws_size, (size_t)WS_END); grid = -1; return; }
        int dev = 0, cus = 0, per_cu = 0;
        if (hipGetDevice(&dev) != hipSuccess || hipDeviceGetAttribute(&cus, hipDeviceAttributeMultiprocessorCount, dev) != hipSuccess) { grid = -1; return; }
        if (hipFuncSetAttribute((const void*)mk_fwd, hipFuncAttributeMaxDynamicSharedMemorySize, LDS_BYTES) != hipSuccess) { fprintf(stderr, "kernel_launch: hipFuncSetAttribute failed\n"); grid = -1; return; }
        if (hipOccupancyMaxActiveBlocksPerMultiprocessor(&per_cu, (const void*)mk_fwd, NTHREADS, LDS_BYTES) != hipSuccess || per_cu < 1) fprintf(stderr, "kernel_launch: occupancy query reports %d\n", per_cu);
        (void)hipGetLastError();
        grid = cus;
        if (grid > 256) grid = 256;
        if ((NLAT / 32) % grid != 0) { fprintf(stderr, "kernel_launch: %d CUs: the row phases need a workgroup count dividing 1024\n", cus); grid = -1; return; }
    }
    if (grid < 0) return;
    if (hipMemsetAsync((char*)d_ws + WS_CTL, 0, CTL_ZERO_BYTES, stream) != hipSuccess) return;
    Args a{};
    for (int i = 0; i < 28; ++i) a.in[i] = (const float*)d_in[i];
    a.out = (float*)d_out; a.ws = (unsigned char*)d_ws; a.ph_lo = 0; a.ph_hi = NPHASE;
    hipLaunchKernelGGL(mk_fwd, dim3(grid), dim3(NTHREADS), LDS_BYTES, stream, a);
}
```

```cpp
#include <hip/hip_runtime.h>
#include <stdio.h>
#include <stdint.h>
#include <math.h>

#ifndef FAST_LRU
#define FAST_LRU 1
#endif
#ifndef FAST_ATTN
#define FAST_ATTN 1
#endif
#ifndef FAST_GEMM
#define FAST_GEMM 1
#endif

constexpr int D = 1024, NB = 8, SEQ = 4096, CTX = 256, NLAT = NB * SEQ, NCTX = NB * CTX, MALL = NLAT + NCTX;
constexpr int INE = 2560, LW = 512, NH = 4, NE = 32, FF = 512;
constexpr int MOE_ROWS = 2 * NLAT + NE * 256, MOE_TILES = MOE_ROWS / 256;
constexpr float LN_EPS = 1e-6f, ALPHA = 1.41421356237309515f;
constexpr float QSCALE = 0.125f * 1.4426950408889634f;
constexpr int NWAVES = 8, NTHREADS = 512;

constexpr size_t MiB = 1u << 20;
constexpr size_t WS_CTL = 0, CTL_ZERO_BYTES = 1 * MiB;
constexpr size_t WS_MODS = 1 * MiB;
constexpr size_t WS_ROPE = WS_MODS + 512 * 1024;
constexpr size_t WS_SMALL = WS_ROPE + 16 * 1024;
constexpr size_t WS_GATEW = WS_MODS + 768 * 1024;
constexpr size_t WS_CDFT = 2 * MiB;
constexpr size_t WS_WIN = 3 * MiB, WS_WOUT = 8 * MiB, WS_ODW = 10 * MiB;
constexpr size_t WS_U = 12 * MiB;
constexpr size_t WS_M1 = WS_CDFT + 256 * 1024, WS_M3 = WS_M1 + 64 * 1024;
constexpr size_t WS_TW = WS_M3 + 64 * 1024;
constexpr size_t WS_MOEW = 76 * MiB, MOEW_LAYER = 96 * MiB, MOEW_W2 = 64 * MiB;
constexpr size_t WS_R0 = 268 * MiB;
constexpr size_t WS_R1 = 336 * MiB;
constexpr size_t R1_GX = 0, R1_QB = 68 * MiB, R1_KB = 100 * MiB, R1_VB = 134 * MiB;
constexpr size_t WS_R2 = 504 * MiB;
constexpr size_t WS_MISC = 576 * MiB;
constexpr size_t MISC_EIDX = 0, MISC_EW = 256 * 1024, MISC_ROWTOK = 512 * 1024;
constexpr size_t MISC_BCNT = 896 * 1024;
constexpr size_t MISC_WRT = 5632 * 1024;
constexpr size_t MISC_SUMM = 1 * MiB;
constexpr size_t WS_END = 582 * MiB;
constexpr int CW_BAR = 4096;
constexpr int CW_CNT = 16384;
constexpr int RING_BYTES = 131072, LDSCTL_OFF = 155648, LDS_BYTES = 163840;
constexpr int LC_BAR = 0;
constexpr int LC_TSTART = 64;
constexpr int LC_XS = 1024;
constexpr int LC_HIST = 3072, LC_BASE = 3200, LC_LCUR = 3328;
constexpr int LC_TP = 3456;
constexpr int LC_POS = 4096;

#define GAS __attribute__((address_space(1)))
#define LAS __attribute__((address_space(3)))
typedef unsigned short bf16_t;
typedef short bf16x8 __attribute__((ext_vector_type(8)));
typedef float f32x4 __attribute__((ext_vector_type(4)));
typedef float f32x2 __attribute__((ext_vector_type(2)));
typedef unsigned u32x4 __attribute__((ext_vector_type(4)));
typedef unsigned u32x2 __attribute__((ext_vector_type(2)));

__device__ __forceinline__ unsigned f2bf(float f) { unsigned u = __float_as_uint(f); return (u + 0x7fffu + ((u >> 16) & 1u)) >> 16; }
__device__ __forceinline__ float bf2f(unsigned b) { return __uint_as_float(b << 16); }
__device__ __forceinline__ unsigned pk2(float lo, float hi) { return f2bf(lo) | (f2bf(hi) << 16); }
__device__ __forceinline__ float bflo(unsigned w) { return __uint_as_float(w << 16); }
__device__ __forceinline__ float bfhi(unsigned w) { return __uint_as_float(w & 0xffff0000u); }
__device__ __forceinline__ float wave_sum(float v) {
#pragma unroll
    for (int o = 1; o < 64; o <<= 1) v += __shfl_xor(v, o);
    return v;
}
__device__ __forceinline__ float wave_max(float v) {
#pragma unroll
    for (int o = 1; o < 64; o <<= 1) v = fmaxf(v, __shfl_xor(v, o));
    return v;
}
__device__ __forceinline__ float sigmoid_f(float x) { return 1.f / (1.f + __expf(-x)); }
__device__ __forceinline__ float silu_f(float x) { return x / (1.f + __expf(-x)); }
__device__ __forceinline__ float gelu_tanh_f(float x) { const float u = 0.7978845608028654f * (x + 0.044715f * x * x * x); return x / (1.f + __expf(-2.f * u)); }

#define XB_TMO      128
#define XB_XCNT(j)  (256  + 64 * (j))
#define XB_XSUB(j)  (1280 + 64 * (j))
#define XB_XGEN(j)  (2304 + 64 * (j))
#define XB_TOP      3328
#define XB_TOPGEN   3392
#define XCD_BAR_WORDS 3456
#define XB_SPIN_CAP (1u << 18)
__device__ __forceinline__ unsigned xb_ld(unsigned* p)              { return __hip_atomic_load(p, __ATOMIC_RELAXED, __HIP_MEMORY_SCOPE_AGENT); }
__device__ __forceinline__ unsigned xb_add(unsigned* p, unsigned v) { return __hip_atomic_fetch_add(p, v, __ATOMIC_RELAXED, __HIP_MEMORY_SCOPE_AGENT); }
__device__ __forceinline__ unsigned xb_xcc_id() { return (unsigned)__builtin_amdgcn_s_getreg((3 << 11) | 20) & 0xFu; }
#define XB_SPIN(cond, bar) do { unsigned _sp = 0; while (cond) { __builtin_amdgcn_s_sleep(1); \
    if ((++_sp & 255u) == 0u) { if (xb_ld(&(bar)[XB_TMO])) break; if (_sp > XB_SPIN_CAP) { atomicAdd(&(bar)[XB_TMO], 1u); break; } } } } while (0)
struct XcdBarrier { unsigned* bar; unsigned x; volatile LAS unsigned* st; };
__device__ __forceinline__ XcdBarrier xcd_barrier_post(unsigned* bar, volatile LAS unsigned* st) {
    XcdBarrier b; b.bar = bar; b.x = xb_xcc_id(); b.st = st;
    if (threadIdx.x == 0) (void)xb_add(&bar[XB_XCNT(b.x)], 1u);
    return b;
}
__device__ __forceinline__ void xcd_barrier_complete(unsigned* bar, unsigned x, unsigned& nloc, unsigned& nx) {
    const unsigned G = gridDim.x * gridDim.y * gridDim.z;
    unsigned sum, cnt, mine, sp = 0u;
    for (;;) {
        sum = 0u; cnt = 0u; mine = 0u;
#pragma unroll
        for (unsigned j = 0; j < 16; ++j) { const unsigned c = xb_ld(&bar[XB_XCNT(j)]); sum += c; cnt += (c > 0u) ? 1u : 0u; mine = (j == x) ? c : mine; }
        if (sum == G) break;
        __builtin_amdgcn_s_sleep(1);
        if ((++sp & 255u) == 0u) { if (xb_ld(&bar[XB_TMO])) break; if (sp > XB_SPIN_CAP) { atomicAdd(&bar[XB_TMO], 1u); break; } }
    }
    nloc = mine > 0u ? mine : 1u; nx = cnt > 0u ? cnt : 1u;
}
__device__ __forceinline__ void xcd_barrier(const XcdBarrier& b) {
    asm volatile("s_waitcnt vmcnt(0)" ::: "memory");
    __syncthreads();
    if (threadIdx.x == 0) {
        unsigned* bar = b.bar;
        __builtin_amdgcn_s_waitcnt(0);
        unsigned nloc = b.st[0], nx = b.st[1];
        if (nloc == 0u) { xcd_barrier_complete(bar, b.x, nloc, nx); b.st[0] = nloc; b.st[1] = nx; }
        const unsigned old = xb_add(&bar[XB_XSUB(b.x)], 1u);
        const unsigned gen = old / nloc;
        if (old + 1u == (gen + 1u) * nloc) {
            __builtin_amdgcn_fence(__ATOMIC_RELEASE, "agent");
            asm volatile("s_waitcnt vmcnt(0)" ::: "memory");
            const unsigned og = xb_add(&bar[XB_TOP], 1u);
            const unsigned tg = og / nx;
            if (og + 1u == (tg + 1u) * nx) xb_add(&bar[XB_TOPGEN], 1u);
            else XB_SPIN(xb_ld(&bar[XB_TOPGEN]) == tg, bar);
            __builtin_amdgcn_fence(__ATOMIC_ACQUIRE, "agent");
            xb_add(&bar[XB_XGEN(b.x)], 1u);
            asm volatile("s_waitcnt vmcnt(0)" ::: "memory");
        } else {
            XB_SPIN(xb_ld(&bar[XB_XGEN(b.x)]) == gen, bar);
            __builtin_amdgcn_fence(__ATOMIC_ACQUIRE, "agent");
            asm volatile("s_waitcnt vmcnt(0)" ::: "memory");
        }
    }
    __syncthreads();
}

namespace pg8 {
constexpr int BM = 256, BK = 64, HALF = 128, HTB = HALF * BK * 2, STAGE_BYTES = 8 * HTB, NXCD = 8, WGM = 8;
__host__ __device__ __forceinline__ int lds_byte(int r, int c) { const int st = (r >> 4) * 2 + (c >> 5), rr = r & 15, cc = c & 31, ob = rr * 64 + cc * 2; return st * 1024 + (ob ^ (((ob >> 9) & 1) << 5)); }
__host__ __device__ __forceinline__ void stage_rc(int b, int& R, int& C) { const int st = b / 1024, sb = b % 1024, swz = sb ^ (((sb >> 9) & 1) << 5); R = (st >> 1) * 16 + swz / 64; C = (st & 1) * 32 + (swz % 64) / 2; }
__host__ __device__ __forceinline__ int perm32(int rho) { const int n = rho >> 4, i = rho & 15; return 8 * (i >> 2) + 4 * n + (i & 3); }
struct Unit { int pm, pn; const char* A; const char* B; };
struct Shape { int K, pitchA, pitchB; unsigned kstepB, hstepB; };
__device__ __forceinline__ unsigned cvt_pk_bf16(float lo, float hi) { unsigned r; asm volatile("v_cvt_pk_bf16_f32 %0, %1, %2" : "=v"(r) : "v"(lo), "v"(hi)); return r; }

template <class Epi, class Sched, bool ALIGN_EPI = true>
__device__ __forceinline__ void gemm_phase(LAS unsigned char* lds, const Shape g, const Sched& S, const Epi& E) {
    int tid_ = threadIdx.x; asm volatile("" : "+v"(tid_));
    const int tid = tid_, wid = __builtin_amdgcn_readfirstlane(tid >> 6), lane = tid & 63, wr = wid >> 2, wc = wid & 3, fr = lane & 15, fq = lane >> 4;
    const int K = g.K, nt = K / BK;
    unsigned voffA[2], voffB[2];
#pragma unroll
    for (int i = 0; i < 2; ++i) { int R, C; stage_rc(tid * 16 + i * 8192, R, C); const int Rb = Epi::PERM ? ((R & ~31) + perm32(R & 31)) : R;
        voffA[i] = (unsigned)(R * g.pitchA + C) * 2u; voffB[i] = (unsigned)(S.rowoffB(Rb, g.pitchB) + C) * 2u; }
    const size_t kstep = (size_t)(BK * 2), kstepB = g.kstepB ? (size_t)g.kstepB : kstep;
    const size_t hstepA = (size_t)HALF * g.pitchA * 2, hstepB = g.hstepB ? (size_t)g.hstepB : (size_t)HALF * g.pitchB * 2;
    const unsigned ldsw = (unsigned)wid * 1024u;
    const int aoff = lds_byte(wr * 64 + fr, fq * 8), boff = lds_byte(wc * 32 + fr, fq * 8);
    int gR[2], gC[2]; unsigned gcur[2][2], gnxt[2][2];
#pragma unroll
    for (int i = 0; i < 2; ++i) { stage_rc(tid * 16 + i * 8192, gR[i], gC[i]); gcur[0][i] = gcur[1][i] = gnxt[0][i] = gnxt[1][i] = 0u; }
#define PG8_GLOAD(dst, unit) do { _Pragma("unroll") for (int h_ = 0; h_ < 2; ++h_) _Pragma("unroll") for (int i_ = 0; i_ < 2; ++i_) dst[h_][i_] = (unsigned)(S.arow(unit, h_ * 128 + gR[i_]) * g.pitchA + gC[i_]) * 2u; } while (0)
#define PG8_STAGEA(bufoff, half, nextu, koff) do { if constexpr (Sched::GATHER) { const char* gb_ = (const char*)S.abase() + (koff); \
            const unsigned o0_ = (nextu) ? gnxt[half][0] : gcur[half][0], o1_ = (nextu) ? gnxt[half][1] : gcur[half][1]; \
            __builtin_amdgcn_global_load_lds((const unsigned*)(gb_ + o0_), (LAS unsigned*)(lds + (bufoff) + ldsw), 16, 0, 0); \
            __builtin_amdgcn_global_load_lds((const unsigned*)(gb_ + o1_), (LAS unsigned*)(lds + (bufoff) + ldsw + 8192), 16, 0, 0); } \
        else { PG8_STAGE(bufoff, ((nextu) ? nA : cA) + (half) * hstepA + (koff), voffA); } } while (0)
#define PG8_SA(b, h) (((b) * 2 + (h)) * HTB)
#define PG8_SB(b, h) ((4 + (b) * 2 + (h)) * HTB)
#define PG8_STAGE(bufoff, gbase, voff) do { _Pragma("unroll") for (int _i = 0; _i < 2; ++_i) \
        __builtin_amdgcn_global_load_lds((const unsigned*)((const char*)(gbase) + (voff)[_i]), (LAS unsigned*)(lds + (bufoff) + ldsw + _i * 8192), 16, 0, 0); } while (0)
#define PG8_LDA(dst, b, h) do { _Pragma("unroll") for (int m = 0; m < 4; ++m) _Pragma("unroll") for (int k = 0; k < 2; ++k) dst[m][k] = *(const LAS bf16x8*)(lds + PG8_SA(b, h) + aoff + m * 2048 + k * 1024); } while (0)
#define PG8_LDB(dst, b, h) do { _Pragma("unroll") for (int n = 0; n < 2; ++n) _Pragma("unroll") for (int k = 0; k < 2; ++k) dst[n][k] = *(const LAS bf16x8*)(lds + PG8_SB(b, h) + boff + n * 2048 + k * 1024); } while (0)
#define PG8_MMA(ai, bj, At, Bt) do { __builtin_amdgcn_s_setprio(1); _Pragma("unroll") for (int m = 0; m < 4; ++m) _Pragma("unroll") for (int n = 0; n < 2; ++n) _Pragma("unroll") for (int k = 0; k < 2; ++k) \
        acc[ai][bj][m][n] = __builtin_amdgcn_mfma_f32_16x16x32_bf16(Bt[n][k], At[m][k], acc[ai][bj][m][n], 0, 0, 0); __builtin_amdgcn_s_setprio(0); } while (0)
#define PG8_WAIT_V(n) asm volatile("s_waitcnt vmcnt(" #n ")" ::: "memory")
#define PG8_WAIT_L(n) asm volatile("s_waitcnt lgkmcnt(" #n ")" ::: "memory")
#define PG8_BAR __builtin_amdgcn_s_barrier()
#define PG8_SCHED __builtin_amdgcn_sched_barrier(0)
    Unit cur, nxt; int ui = 0;
    if (!S.next(0, cur)) return;
    f32x4 acc[2][2][4][2];
#pragma unroll
    for (int a = 0; a < 2; ++a)
#pragma unroll
        for (int b = 0; b < 2; ++b)
#pragma unroll
            for (int m = 0; m < 4; ++m)
#pragma unroll
                for (int n = 0; n < 2; ++n) acc[a][b][m][n] = (f32x4){0.f, 0.f, 0.f, 0.f};
    bf16x8 At[4][2], B0[2][2], B1[2][2];
    const char* cA = cur.A; const char* cB = cur.B; const char* nA = cA;
    if constexpr (Sched::GATHER) { PG8_GLOAD(gcur, cur); }
    PG8_STAGE(PG8_SB(0, 0), cB, voffB); PG8_STAGE(PG8_SB(0, 1), cB + hstepB, voffB); PG8_STAGEA(PG8_SA(0, 0), 0, false, (size_t)0); PG8_STAGEA(PG8_SA(0, 1), 1, false, (size_t)0);
    if (wr == 1) PG8_BAR;
    PG8_WAIT_V(2); PG8_BAR;
    PG8_STAGE(PG8_SB(1, 0), cB + kstepB, voffB); PG8_STAGEA(PG8_SA(1, 0), 0, false, kstep); PG8_STAGE(PG8_SB(1, 1), cB + hstepB + kstepB, voffB);
    PG8_WAIT_V(6); PG8_BAR;
    for (;;) {
        const bool has_next = S.next(ui + 1, nxt);
        nA = has_next ? nxt.A : cA; const char* nB = has_next ? nxt.B : cB;
        if constexpr (Sched::GATHER) { if (has_next) { PG8_GLOAD(gnxt, nxt); } else {
#pragma unroll
            for (int h_ = 0; h_ < 2; ++h_)
#pragma unroll
                for (int i_ = 0; i_ < 2; ++i_) gnxt[h_][i_] = gcur[h_][i_]; } }
        for (int t = 0; t < nt; t += 2) {
            const bool last = (t == nt - 2);
            const size_t ka1 = (size_t)(t + 1) * kstep, ka2 = last ? (size_t)0 : (size_t)(t + 2) * kstep, ka3 = ka2 + kstep;
            const char* b2 = last ? nB : cB + (size_t)(t + 2) * kstepB;
            const char* b3 = b2 + kstepB;
            PG8_LDB(B0, 0, 0); PG8_LDB(B1, 0, 1); PG8_SCHED; PG8_LDA(At, 0, 0); PG8_STAGEA(PG8_SA(1, 1), 1, false, ka1);
            PG8_WAIT_V(8); PG8_WAIT_L(0); PG8_BAR; PG8_MMA(0, 0, At, B0); PG8_MMA(0, 1, At, B1); PG8_BAR; PG8_SCHED;
            PG8_LDA(At, 0, 1); PG8_STAGE(PG8_SB(0, 0), b2, voffB); PG8_STAGE(PG8_SB(0, 1), b2 + hstepB, voffB); PG8_STAGEA(PG8_SA(0, 0), 0, last, ka2);
            PG8_WAIT_V(8); PG8_WAIT_L(0); PG8_BAR; PG8_MMA(1, 0, At, B0); PG8_MMA(1, 1, At, B1); PG8_BAR; PG8_SCHED;
            PG8_LDB(B0, 1, 0); PG8_LDB(B1, 1, 1); PG8_SCHED; PG8_LDA(At, 1, 0); PG8_STAGEA(PG8_SA(0, 1), 1, last, ka2);
            PG8_WAIT_V(8); PG8_WAIT_L(0); PG8_BAR; PG8_MMA(0, 0, At, B0); PG8_MMA(0, 1, At, B1); PG8_BAR; PG8_SCHED;
            PG8_LDA(At, 1, 1); PG8_STAGE(PG8_SB(1, 0), b3, voffB); PG8_STAGE(PG8_SB(1, 1), b3 + hstepB, voffB); PG8_STAGEA(PG8_SA(1, 0), 0, last, ka3);
            PG8_WAIT_V(8); PG8_WAIT_L(0); PG8_BAR; PG8_MMA(1, 0, At, B0); PG8_MMA(1, 1, At, B1); PG8_BAR; PG8_SCHED;
        }
        if constexpr (ALIGN_EPI) { if (wr == 0) PG8_BAR; }
        E(acc, cur, wr, wc, fr, fq);
        if (!has_next) break;
#pragma unroll
        for (int a = 0; a < 2; ++a)
#pragma unroll
            for (int b = 0; b < 2; ++b)
#pragma unroll
                for (int m = 0; m < 4; ++m)
#pragma unroll
                    for (int n = 0; n < 2; ++n) acc[a][b][m][n] = (f32x4){0.f, 0.f, 0.f, 0.f};
        cur = nxt; cA = nA; cB = nB; ++ui;
        if constexpr (Sched::GATHER) {
#pragma unroll
            for (int h_ = 0; h_ < 2; ++h_)
#pragma unroll
                for (int i_ = 0; i_ < 2; ++i_) gcur[h_][i_] = gnxt[h_][i_]; }
        if constexpr (ALIGN_EPI) { if (wr == 1) PG8_BAR; }
    }
    PG8_WAIT_V(0);
    if constexpr (!ALIGN_EPI) { if (wr == 0) PG8_BAR; }
    PG8_BAR;
#undef PG8_SA
#undef PG8_SB
#undef PG8_STAGE
#undef PG8_STAGEA
#undef PG8_GLOAD
#undef PG8_LDA
#undef PG8_LDB
#undef PG8_MMA
#undef PG8_WAIT_V
#undef PG8_WAIT_L
#undef PG8_BAR
#undef PG8_SCHED
}

template <class Epi, class Sched>
__device__ __forceinline__ void gemm_phase_ref(const Shape g, const Sched& S, const Epi& E) {
    const int tid = threadIdx.x, wid = __builtin_amdgcn_readfirstlane(tid >> 6), lane = tid & 63, wr = wid >> 2, wc = wid & 3, fr = lane & 15, fq = lane >> 4;
    Unit u;
    for (int it = 0; S.next(it, u); ++it) {
        f32x4 acc[2][2][4][2];
#pragma unroll
        for (int a = 0; a < 2; ++a)
#pragma unroll
            for (int b = 0; b < 2; ++b)
#pragma unroll
                for (int m = 0; m < 4; ++m)
#pragma unroll
                    for (int n = 0; n < 2; ++n) acc[a][b][m][n] = (f32x4){0.f, 0.f, 0.f, 0.f};
#pragma unroll
        for (int ai = 0; ai < 2; ++ai) {
            for (int k8 = 0; k8 < g.K / 8; ++k8) {
                float a[4][8];
#pragma unroll
                for (int m = 0; m < 4; ++m) { const u32x4 w = *(const u32x4*)(u.A + ((size_t)(ai * 128 + wr * 64 + m * 16 + fr) * g.pitchA + k8 * 8) * 2);
                    a[m][0] = bflo(w.x); a[m][1] = bfhi(w.x); a[m][2] = bflo(w.y); a[m][3] = bfhi(w.y); a[m][4] = bflo(w.z); a[m][5] = bfhi(w.z); a[m][6] = bflo(w.w); a[m][7] = bfhi(w.w); }
#pragma unroll
                for (int bj = 0; bj < 2; ++bj)
#pragma unroll
                    for (int n = 0; n < 2; ++n)
#pragma unroll
                        for (int ii = 0; ii < 4; ++ii) {
                            const int col = bj * 128 + wc * 32 + (Epi::PERM ? 8 * fq + 4 * n + ii : 16 * n + 4 * fq + ii);
                            const size_t kb_ = g.kstepB ? (size_t)(k8 >> 3) * g.kstepB + (size_t)(k8 & 7) * 16 : (size_t)k8 * 16;
                            const u32x4 w = *(const u32x4*)(u.B + (size_t)(col >> 7) * (g.hstepB ? (size_t)g.hstepB : (size_t)HALF * g.pitchB * 2) + (size_t)S.rowoffB(col & 127, g.pitchB) * 2 + kb_);
                            const float b0 = bflo(w.x), b1 = bfhi(w.x), b2 = bflo(w.y), b3 = bfhi(w.y), b4 = bflo(w.z), b5 = bfhi(w.z), b6 = bflo(w.w), b7 = bfhi(w.w);
#pragma unroll
                            for (int m = 0; m < 4; ++m)
                                acc[ai][bj][m][n][ii] += a[m][0] * b0 + a[m][1] * b1 + a[m][2] * b2 + a[m][3] * b3 + a[m][4] * b4 + a[m][5] * b5 + a[m][6] * b6 + a[m][7] * b7;
                        }
            }
        }
        E(acc, u, wr, wc, fr, fq);
    }
}
}

struct Args { const float* in[28]; float* out; unsigned char* ws; int ph_lo, ph_hi; };
struct InRef { const Args& a; __device__ __forceinline__ const float* operator[](int k) const { return a.in[k]; } };
struct Frame {
    LAS unsigned char* lds; unsigned* ctl; unsigned char* ws;
    int tid, lane, wave, G, vcu;
    InRef in; float* out;
};
#define LDS_WAIT() asm volatile("s_waitcnt lgkmcnt(0)" ::: "memory")
#ifndef TIME_SUB
#define TIME_SUB -1
#endif
#define TSB(id) do { if ((id) == TIME_SUB && blockIdx.x == 0 && threadIdx.x == 0) ((volatile LAS unsigned long long*)(F.lds + LDSCTL_OFF + LC_TP))[0] = __builtin_amdgcn_s_memrealtime(); } while (0)
#define TSE(id) do { if ((id) == TIME_SUB && blockIdx.x == 0 && threadIdx.x == 0) { volatile LAS unsigned long long* tp_ = (volatile LAS unsigned long long*)(F.lds + LDSCTL_OFF + LC_TP); tp_[1] = tp_[1] + (__builtin_amdgcn_s_memrealtime() - tp_[0]); } } while (0)

template <class RowMap>
__device__ __forceinline__ void p0_transpose_item(const float* W, int K, int N, bf16_t* WT, RowMap rowmap, LAS float* scr, int item, int lane) {
    const int nblk = N / 32, kb = item / nblk, nb = item % nblk, k0 = 64 * kb, n0 = 32 * nb;
    float v[32];
#pragma unroll
    for (int i = 0; i < 32; ++i) v[i] = __builtin_nontemporal_load(W + (size_t)(k0 + 2 * i + (lane >> 5)) * N + n0 + (lane & 31));
#pragma unroll
    for (int i = 0; i < 32; ++i) scr[(2 * i + (lane >> 5)) * 33 + (lane & 31)] = v[i];
    LDS_WAIT(); asm volatile("" ::: "memory");
    const int c = lane & 7;
#pragma unroll
    for (int j = 0; j < 4; ++j) { const int n = (lane >> 3) + 8 * j; const LAS float* s = scr + (8 * c) * 33 + n;
        u32x4 o; o.x = pk2(s[0 * 33], s[1 * 33]); o.y = pk2(s[2 * 33], s[3 * 33]); o.z = pk2(s[4 * 33], s[5 * 33]); o.w = pk2(s[6 * 33], s[7 * 33]);
        *(u32x4*)(WT + (size_t)rowmap(n0 + n) * K + k0 + 8 * c) = o; }
    LDS_WAIT(); asm volatile("" ::: "memory");
}
struct RmId { __device__ int operator()(int n) const { return n; } };
struct RmW1 { __device__ int operator()(int j) const { return (j >> 2) * 8 + (j & 3); } };
struct RmW3 { __device__ int operator()(int j) const { return (j >> 2) * 8 + 4 + (j & 3); } };

__device__ __forceinline__ void p0_prologue(Frame& F) {
    unsigned char* ws = F.ws;
    LAS float* scr = (LAS float*)(F.lds + F.wave * 16384);
    const int gw = F.vcu * NWAVES + F.wave, NGW = F.G * NWAVES;
    constexpr int I_WIN = 16 * 80, I_SQ = 16 * 32, I_W13 = 16 * 16, I_W2 = 8 * 32;
    constexpr int N0 = I_WIN, N1 = N0 + I_SQ, N2 = N1 + I_SQ, N3 = N2 + 2 * NE * I_W13  , N4 = N3 + 2 * NE * I_W13  , N5 = N4 + 2 * NE * I_W2;
    for (int it = gw; it < N5; it += NGW) {
        if (it < N0) { p0_transpose_item(F.in[8], D, INE, (bf16_t*)(ws + WS_WIN), RmId(), scr, it, F.lane); continue; }
        if (it < N1) { p0_transpose_item(F.in[18], D, D, (bf16_t*)(ws + WS_WOUT), RmId(), scr, it - N0, F.lane); continue; }
        if (it < N2) { p0_transpose_item(F.in[19], D, D, (bf16_t*)(ws + WS_ODW), RmId(), scr, it - N1, F.lane); continue; }
        if (it < N3) { const int r = it - N2, le = r / I_W13, l = le / NE, e = le % NE;
            p0_transpose_item(F.in[25] + (size_t)le * D * FF, D, FF, (bf16_t*)(ws + WS_MOEW + l * MOEW_LAYER) + (size_t)e * D * D, RmW1(), scr, r % I_W13, F.lane); continue; }
        if (it < N4) { const int r = it - N3, le = r / I_W13, l = le / NE, e = le % NE;
            p0_transpose_item(F.in[26] + (size_t)le * D * FF, D, FF, (bf16_t*)(ws + WS_MOEW + l * MOEW_LAYER) + (size_t)e * D * D, RmW3(), scr, r % I_W13, F.lane); continue; }
        { const int r = it - N4, le = r / I_W2, l = le / NE, e = le % NE;
            p0_transpose_item(F.in[27] + (size_t)le * FF * D, FF, D, (bf16_t*)(ws + WS_MOEW + l * MOEW_LAYER + MOEW_W2) + (size_t)e * D * FF, RmId(), scr, r % I_W2, F.lane); }
    }
    const int gt = F.vcu * NTHREADS + F.tid, NGT = F.G * NTHREADS;
    { bf16_t* gwt = (bf16_t*)(ws + WS_GATEW);
      for (int i = gt; i < 2 * 2 * 8 * 64 * 64; i += NGT) { const int k = i & 63, n = (i >> 6) & 63, h = (i >> 12) & 7, t = (i >> 15) & 1, d = i >> 16;
          const float* w = t ? F.in[13] : F.in[11]; gwt[i] = (bf16_t)f2bf(w[(((size_t)d * 8 + h) * 64 + k) * 64 + n]); } }
    { bf16_t* wrt = (bf16_t*)(ws + WS_MISC + MISC_WRT);
      for (int i = gt; i < 2 * 48 * 1024; i += NGT) { const int k = i & 1023, n = (i >> 10) % 48, l = i / (48 * 1024);
          const float w = n < 4 ? F.in[21][((size_t)l * D + k) * 4 + n] : n < 36 ? F.in[23][((size_t)l * D + k) * 32 + (n - 4)] : 0.f;
          const unsigned hi = f2bf(w); const unsigned lo = f2bf(w - bf2f(hi));
          wrt[((size_t)(l * 2 + 0) * 48 + n) * 1024 + k] = (bf16_t)hi; wrt[((size_t)(l * 2 + 1) * 48 + n) * 1024 + k] = (bf16_t)lo; } }
    { float* rope = (float*)(ws + WS_ROPE);
      for (int i = gt; i < 64 * 16; i += NGT) { const int f = i & 15, pos = i >> 4; const float freq = powf(10000.f, -(float)f / 16.f); const float ang = (float)pos * freq;
          rope[i * 2] = (float)cos((double)ang); rope[i * 2 + 1] = (float)sin((double)ang); }
      float* sm = (float*)(ws + WS_SMALL);
      for (int i = gt; i < 2 * LW; i += NGT) { const float l = F.in[15][i]; sm[64 + i] = (-l > 20.f) ? -l : log1pf(expf(-l)); }
      if (blockIdx.x == 0 && F.wave == 0) { const float* dl = F.in[16]; const float a = wave_sum(dl[F.lane] * dl[64 + F.lane]), b = wave_sum(dl[128 + F.lane] * dl[192 + F.lane]);
          if (F.lane == 0) sm[0] = expf(a) - expf(b) + 0.2f; } }
    __syncthreads();
    { LAS float* tab = (LAS float*)F.lds;
      for (int i = F.tid; i < 4096; i += NTHREADS) tab[i] = (float)cos(2.0 * 3.14159265358979323846 * (double)i / 4096.0);
      __syncthreads();
      bf16_t* cd = (bf16_t*)(ws + WS_CDFT);
      for (int i = gt; i < 512 * 256; i += NGT) { const int c = i & 255, m = i >> 8; const int j = ((m & 255) * c) & 255; cd[i] = (bf16_t)f2bf(m < 256 ? tab[j * 16] : tab[(j * 16 + 3072) & 4095]); }
      bf16_t* m1 = (bf16_t*)(ws + WS_M1); bf16_t* m3 = (bf16_t*)(ws + WS_M3); float* twp = (float*)(ws + WS_TW);
      for (int i = gt; i < 256 * 128; i += NGT) { const int k = i & 127, r = i >> 7, n = k & 63, im_in = k >> 6;
          float v1 = 0.f; if (r < 128) { const int ka = 32 * (r >> 6) + 16 * ((r >> 4) & 1) + (r & 15), im_out = (r >> 5) & 1; const int j = ((ka * n) & 63) * 64; const float cc = tab[j], ss = tab[(j + 3072) & 4095];
              v1 = im_out == 0 ? (im_in == 0 ? cc : -ss) : (im_in == 0 ? -ss : -cc); }
          m1[i] = (bf16_t)f2bf(v1);
          float v3 = 0.f; if (r < 64) { const int j = ((r * n) & 63) * 64; v3 = im_in == 0 ? tab[j] : tab[(j + 3072) & 4095]; }
          m3[i] = (bf16_t)f2bf(v3); }
      for (int i = gt; i < 64 * 64; i += NGT) { const int n2 = i & 63, ka = i >> 6; const int j = (ka * n2) & 4095; twp[2 * i] = tab[j]; twp[2 * i + 1] = tab[(j + 3072) & 4095]; }
      __syncthreads(); }
    { LAS float* sc = (LAS float*)F.lds;
      LAS float* red = sc + 9 * 1024;
      for (int i = F.tid; i < 9 * 1024; i += NTHREADS) { const int r = i >> 10, k = i & 1023; const float v = r < 8 ? F.in[1][r * D + k] : F.in[3][k]; sc[i] = v / (1.f + expf(-v)); }
      __syncthreads();
      float* mods = (float*)(ws + WS_MODS);
      for (int u = F.vcu; u < 2 * 96; u += F.G) { const int l = u / 96, n0 = (u % 96) * 64, col = F.tid & 63, kc = F.tid >> 6;
          float a9[9];
#pragma unroll
          for (int r = 0; r < 9; ++r) a9[r] = 0.f;
          const float* w = F.in[4] + ((size_t)l * D + kc * 128) * 6144 + n0 + col;
#pragma unroll 1
          for (int k0 = 0; k0 < 128; k0 += 16) { float wv[16];
#pragma unroll
              for (int k = 0; k < 16; ++k) wv[k] = __builtin_nontemporal_load(w + (size_t)(k0 + k) * 6144);
#pragma unroll
              for (int k = 0; k < 16; ++k)
#pragma unroll
                  for (int r = 0; r < 9; ++r) a9[r] += sc[r * 1024 + kc * 128 + k0 + k] * wv[k]; }
#pragma unroll
          for (int r = 0; r < 9; ++r) red[(kc * 9 + r) * 64 + col] = a9[r];
          __syncthreads();
          for (int i = F.tid; i < 9 * 64; i += NTHREADS) { const int r = i >> 6, c = i & 63; float s = 0.f;
#pragma unroll
              for (int q = 0; q < 8; ++q) s += red[(q * 9 + r) * 64 + c];
              mods[((size_t)l * 9 + r) * 6144 + n0 + c] = s + F.in[5][l * 6144 + n0 + c]; }
          __syncthreads(); } }
}

template <int CTRL> __device__ __forceinline__ float dpp_f(float v) { return __int_as_float(__builtin_amdgcn_update_dpp(0, __float_as_int(v), CTRL, 0xf, 0xf, true)); }
__device__ __forceinline__ float row16_sum(float v) { v += dpp_f<0x128>(v); v += dpp_f<0x124>(v); v += dpp_f<0x122>(v); v += dpp_f<0x121>(v); v += __shfl_xor(v, 16); return v; }
__device__ __forceinline__ void ln_stats16(f32x4 (&v)[8], float& mean, float& rstd) {
    float s = 0.f;
#pragma unroll
    for (int j = 0; j < 8; ++j) s += (v[j].x + v[j].y) + (v[j].z + v[j].w);
    mean = row16_sum(s) * (1.f / D); float q = 0.f;
#pragma unroll
    for (int j = 0; j < 8; ++j) { const f32x4 d = v[j] - mean; q += (d.x * d.x + d.y * d.y) + (d.z * d.z + d.w * d.w); }
    rstd = 1.f / sqrtf(row16_sum(q) * (1.f / D) + LN_EPS);
}
__device__ __forceinline__ void p1_lnmod(Frame& F) {
    const int gw = F.vcu * NWAVES + F.wave, NGW = F.G * NWAVES, r4 = F.lane >> 5, sub = F.lane & 31; const float* mods = (const float*)(F.ws + WS_MODS); bf16_t* H = (bf16_t*)(F.ws + WS_R0);
    LAS f32x4* LSH = (LAS f32x4*)F.lds; LAS f32x4* LSC = (LAS f32x4*)(F.lds + 9 * 4096);
    for (int i = F.tid; i < 9 * 256; i += NTHREADS) { const int r = i >> 8, q = i & 255; LSH[i] = ((const f32x4*)(mods + (size_t)r * 6144))[q]; LSC[i] = ((const f32x4*)(mods + (size_t)r * 6144 + 1024))[q]; }
    __syncthreads();
    for (int quad = gw; quad < MALL / 2; quad += NGW) { const int row = quad * 2 + r4;
        const float* src = row < NLAT ? F.in[0] + (size_t)row * D : F.in[2] + (size_t)(row - NLAT) * D; const int r = row < NLAT ? (row >> 12) : 8;
        f32x4 v[8];
#pragma unroll
        for (int j = 0; j < 8; ++j) v[j] = ((const f32x4*)src)[sub + 32 * j];
        float mean, rstd; ln_stats16(v, mean, rstd);
#pragma unroll
        for (int j = 0; j < 8; ++j) { const f32x4 a = LSH[r * 256 + sub + 32 * j], bb = LSC[r * 256 + sub + 32 * j]; const f32x4 o = (v[j] - mean) * rstd * (bb + 1.f) + a;
            ((u32x2*)(H + (size_t)row * D))[sub + 32 * j] = (u32x2){pk2(o.x, o.y), pk2(o.z, o.w)}; }
    }
    __syncthreads();
}
constexpr int RT_PITCH = 2064;
__device__ __forceinline__ void row_phase_a(Frame& F, int layer, const float* xin) {
    const float* mods = (const float*)(F.ws + WS_MODS) + (size_t)layer * 9 * 6144;
    const bf16_t* Y = (const bf16_t*)(F.ws + WS_R1); bf16_t* T = (bf16_t*)(F.ws + WS_R0); float* X = F.out;
    const float* lg = F.in[6] + (size_t)(layer * 2) * D; const float* lb = F.in[7] + (size_t)(layer * 2) * D;
    const float* bg = F.in[22] + layer * 4; const float* bfp = F.in[24] + layer * 32;
    const bf16_t* WRT = (const bf16_t*)(F.ws + WS_MISC + MISC_WRT) + (size_t)layer * 2 * 48 * 1024;
    int* eidx = (int*)(F.ws + WS_MISC + MISC_EIDX); float* ew = (float*)(F.ws + WS_MISC + MISC_EW); unsigned* cnt = F.ctl + CW_CNT + layer * 128;
    unsigned* bcnt = (unsigned*)(F.ws + WS_MISC + MISC_BCNT);
    LAS unsigned char* lds = F.lds; LAS unsigned char* TH = lds; LAS unsigned char* TL = lds + 32 * RT_PITCH;
    LAS float* PART = (LAS float*)lds; LAS float* LOG = (LAS float*)(lds + 8 * 32 * 48 * 4);
    LAS unsigned* hist = (LAS unsigned*)(lds + LDSCTL_OFF + LC_HIST);
    const int lane = F.lane, wid = F.wave;
    if (F.tid < 32) hist[F.tid] = 0u;
    const int TPB = (NLAT / 32) / F.G;
    LAS f32x4* LM = (LAS f32x4*)(lds + 64 * RT_PITCH);
    { const int b0 = ((int)blockIdx.x * TPB * 32) >> 12; const float* mr = mods + (size_t)b0 * 6144;
      for (int i = F.tid; i < 5 * 256; i += NTHREADS) { const int a = i >> 8, q = i & 255; LM[i] = a == 0 ? ((const f32x4*)(mr + 2 * 1024))[q] : a == 1 ? ((const f32x4*)lg)[q] : a == 2 ? ((const f32x4*)lb)[q] : a == 3 ? ((const f32x4*)(mr + 4 * 1024))[q] : ((const f32x4*)(mr + 3 * 1024))[q]; } }
    __syncthreads();
    for (int ti = 0; ti < TPB; ++ti) { const int tile = (int)blockIdx.x * TPB + ti;
        TSB(100);
#pragma unroll 1
        for (int hh = 0; hh < 2; ++hh) { int lane_ = lane; asm volatile("" : "+v"(lane_));
            const int r4 = lane_ >> 5, sub = lane_ & 31, rl = wid * 4 + 2 * hh + r4, row = tile * 32 + rl;
            f32x4 v[8];
#pragma unroll
            for (int j = 0; j < 8; ++j) { if (j == 4) __builtin_amdgcn_sched_barrier(0); const int q = sub + 32 * j; const u32x2 yw = ((const u32x2*)(Y + (size_t)row * D))[q]; const f32x4 y = (f32x4){bflo(yw.x), bfhi(yw.x), bflo(yw.y), bfhi(yw.y)};
                v[j] = ((const f32x4*)(xin + (size_t)row * D))[q] * ALPHA + LM[q] * y; }
            float mean, rstd; ln_stats16(v, mean, rstd);
#pragma unroll
            for (int j = 0; j < 8; ++j) { const int q = sub + 32 * j; v[j] = (v[j] - mean) * rstd * LM[256 + q] + LM[512 + q]; ((f32x4*)(X + (size_t)row * D))[q] = v[j]; }
            ln_stats16(v, mean, rstd);
#pragma unroll
            for (int j = 0; j < 8; ++j) { const int q = sub + 32 * j; const f32x4 t = (v[j] - mean) * rstd * (LM[768 + q] + 1.f) + LM[1024 + q];
                const unsigned h0 = f2bf(t.x), h1 = f2bf(t.y), h2 = f2bf(t.z), h3 = f2bf(t.w);
                const u32x2 hw = (u32x2){h0 | (h1 << 16), h2 | (h3 << 16)};
                const u32x2 lw = (u32x2){pk2(t.x - bf2f(h0), t.y - bf2f(h1)), pk2(t.z - bf2f(h2), t.w - bf2f(h3))};
                ((u32x2*)(T + (size_t)row * D))[q] = hw;
                *(LAS u32x2*)(TH + rl * RT_PITCH + q * 8) = hw; *(LAS u32x2*)(TL + rl * RT_PITCH + q * 8) = lw; } }
        __syncthreads();
        TSE(100); TSB(101);
        f32x4 acc[2][3];
        int lane2_ = lane; asm volatile("" : "+v"(lane2_)); const int fr = lane2_ & 15, fq = lane2_ >> 4;
#pragma unroll
        for (int mt = 0; mt < 2; ++mt)
#pragma unroll
            for (int nt = 0; nt < 3; ++nt) acc[mt][nt] = (f32x4){0.f, 0.f, 0.f, 0.f};
#pragma unroll
        for (int ks = 0; ks < 4; ++ks) { const int k0 = wid * 128 + ks * 32 + 8 * fq;
            bf16x8 ah[2], al[2], bh[3], bl[3];
#pragma unroll
            for (int mt = 0; mt < 2; ++mt) { ah[mt] = *(const LAS bf16x8*)(TH + (16 * mt + fr) * RT_PITCH + k0 * 2); al[mt] = *(const LAS bf16x8*)(TL + (16 * mt + fr) * RT_PITCH + k0 * 2); }
#pragma unroll
            for (int nt = 0; nt < 3; ++nt) { bh[nt] = *(const bf16x8*)(WRT + (size_t)(16 * nt + fr) * 1024 + k0); bl[nt] = *(const bf16x8*)(WRT + (size_t)(48 + 16 * nt + fr) * 1024 + k0); }
#pragma unroll
            for (int mt = 0; mt < 2; ++mt)
#pragma unroll
                for (int nt = 0; nt < 3; ++nt) {
                    acc[mt][nt] = __builtin_amdgcn_mfma_f32_16x16x32_bf16(ah[mt], bh[nt], acc[mt][nt], 0, 0, 0);
                    acc[mt][nt] = __builtin_amdgcn_mfma_f32_16x16x32_bf16(ah[mt], bl[nt], acc[mt][nt], 0, 0, 0);
                    acc[mt][nt] = __builtin_amdgcn_mfma_f32_16x16x32_bf16(al[mt], bh[nt], acc[mt][nt], 0, 0, 0); } }
        __syncthreads();
        TSE(101); TSB(102);
#pragma unroll
        for (int mt = 0; mt < 2; ++mt)
#pragma unroll
            for (int nt = 0; nt < 3; ++nt)
#pragma unroll
                for (int reg = 0; reg < 4; ++reg) PART[(wid * 32 + 16 * mt + 4 * fq + reg) * 48 + 16 * nt + fr] = acc[mt][nt][reg];
        __syncthreads();
        for (int idx = F.tid; idx < 32 * 36; idx += NTHREADS) { const int r = idx / 36, o = idx - r * 36; float sacc = o < 4 ? bg[o] : bfp[o - 4];
#pragma unroll
            for (int w = 0; w < 8; ++w) sacc += PART[(w * 32 + r) * 48 + o];
            LOG[r * 36 + o] = sacc; }
        __syncthreads();
        if (F.tid < 32) { const int r = F.tid, row = tile * 32 + r; const LAS float* L = LOG + r * 36;
            const float g0 = L[0], g1 = L[1], g2 = L[2], g3 = L[3];
            int gi = 0; float gm = g0;
            if (g1 > gm) { gm = g1; gi = 1; }
            if (g2 > gm) { gm = g2; gi = 2; }
            if (g3 > gm) { gm = g3; gi = 3; }
            const float pg = 1.f / (expf(g0 - gm) + expf(g1 - gm) + expf(g2 - gm) + expf(g3 - gm));
            int i0 = 0; float v0 = -INFINITY; int i1 = 0; float v1 = -INFINITY;
#pragma unroll
            for (int j = 0; j < 8; ++j) { const float vv = L[4 + gi * 8 + j];
                if (vv > v0) { v1 = v0; i1 = i0; v0 = vv; i0 = j; } else if (vv > v1) { v1 = vv; i1 = j; } }
            const float e1 = expf(v1 - v0); const float w0 = 1.f / (1.f + e1), w1 = e1 / (1.f + e1);
            const int ea = gi * 8 + i0, eb = gi * 8 + i1; eidx[row * 2] = ea; eidx[row * 2 + 1] = eb; ew[row * 2] = w0 * pg; ew[row * 2 + 1] = w1 * pg;
            __hip_atomic_fetch_add(hist + ea, 1u, __ATOMIC_RELAXED, __HIP_MEMORY_SCOPE_WORKGROUP); __hip_atomic_fetch_add(hist + eb, 1u, __ATOMIC_RELAXED, __HIP_MEMORY_SCOPE_WORKGROUP); }
        __syncthreads();
        TSE(102);
    }
    if (F.tid < 32) { const unsigned c = hist[F.tid]; atomicAdd(cnt + F.tid, c); bcnt[(size_t)blockIdx.x * 32 + F.tid] = c; }
}
__device__ __forceinline__ void row_phase_b(Frame& F, int layer, bool make_h) {
    const int gw = F.vcu * NWAVES + F.wave, NGW = F.G * NWAVES, r4 = F.lane >> 5, sub = F.lane & 31; const float* mods = (const float*)(F.ws + WS_MODS) + (size_t)layer * 9 * 6144;
    const float* modn = (const float*)(F.ws + WS_MODS) + (size_t)(layer + 1) * 9 * 6144;
    const bf16_t* MO = (const bf16_t*)(F.ws + WS_R1); bf16_t* H = (bf16_t*)(F.ws + WS_R0); float* X = F.out;
    const float* lg = F.in[6] + (size_t)(layer * 2 + 1) * D; const float* lb = F.in[7] + (size_t)(layer * 2 + 1) * D;
    LAS f32x4* LG = (LAS f32x4*)F.lds; LAS f32x4* LB = LG + 256; LAS f32x4* G2 = LG + 512; LAS f32x4* SC = G2 + 8 * 256; LAS f32x4* SH = SC + 8 * 256;
    for (int i = F.tid; i < 256; i += NTHREADS) { LG[i] = ((const f32x4*)lg)[i]; LB[i] = ((const f32x4*)lb)[i]; }
    for (int i = F.tid; i < 8 * 256; i += NTHREADS) { const int b = i >> 8, q = i & 255; G2[i] = ((const f32x4*)(mods + (size_t)b * 6144 + 5 * 1024))[q];
        if (make_h) { SC[i] = ((const f32x4*)(modn + (size_t)b * 6144 + 1024))[q]; SH[i] = ((const f32x4*)(modn + (size_t)b * 6144))[q]; } }
    __syncthreads();
    for (int quad = gw; quad < NLAT / 2; quad += NGW) { const int row = quad * 2 + r4;
        const int b = row >> 12;
        f32x4 v[8];
#pragma unroll
        for (int j = 0; j < 8; ++j) { const int q = sub + 32 * j; const u32x2 m0 = ((const u32x2*)(MO + (size_t)row * D))[q], m1 = ((const u32x2*)(MO + ((size_t)NLAT + row) * D))[q];
            const f32x4 m = (f32x4){bflo(m0.x) + bflo(m1.x), bfhi(m0.x) + bfhi(m1.x), bflo(m0.y) + bflo(m1.y), bfhi(m0.y) + bfhi(m1.y)};
            v[j] = ((const f32x4*)(X + (size_t)row * D))[q] * ALPHA + G2[b * 256 + q] * m; }
        float mean, rstd; ln_stats16(v, mean, rstd);
#pragma unroll
        for (int j = 0; j < 8; ++j) { const int q = sub + 32 * j; v[j] = (v[j] - mean) * rstd * LG[q] + LB[q]; ((f32x4*)(X + (size_t)row * D))[q] = v[j]; }
        if (make_h) {
            ln_stats16(v, mean, rstd);
#pragma unroll
            for (int j = 0; j < 8; ++j) { const int q = sub + 32 * j; const f32x4 o = (v[j] - mean) * rstd * (SC[b * 256 + q] + 1.f) + SH[b * 256 + q];
                ((u32x2*)(H + (size_t)row * D))[q] = (u32x2){pk2(o.x, o.y), pk2(o.z, o.w)}; } }
    }
    __syncthreads();
}

__device__ __forceinline__ void moe_tile_prefix(Frame& F, int layer) {
    volatile LAS int* ts = (volatile LAS int*)(F.lds + LDSCTL_OFF + LC_TSTART);
    if (F.tid == 0) { int acc = 0; for (int e = 0; e < NE; ++e) { ts[e] = acc; acc += (int)((xb_ld(F.ctl + CW_CNT + layer * 128 + e) + 255u) >> 8); } ts[NE] = acc; }
    __syncthreads();
}
__device__ __forceinline__ void moe_positions(Frame& F, int layer) {
    moe_tile_prefix(F, layer);
    const LAS int* ts = (const LAS int*)(F.lds + LDSCTL_OFF + LC_TSTART);
    const int* eidx = (const int*)(F.ws + WS_MISC + MISC_EIDX); int* rowtok = (int*)(F.ws + WS_MISC + MISC_ROWTOK);
    const unsigned* bcnt = (const unsigned*)(F.ws + WS_MISC + MISC_BCNT); unsigned* cnt = F.ctl + CW_CNT + layer * 128;
    LAS unsigned* part = (LAS unsigned*)F.lds;
    LAS unsigned* base = (LAS unsigned*)(F.lds + LDSCTL_OFF + LC_BASE); LAS unsigned* lcur = (LAS unsigned*)(F.lds + LDSCTL_OFF + LC_LCUR);
    const int blk = (int)blockIdx.x, APB = (2 * NLAT) / F.G;
    { const int e = F.tid & 31, p = F.tid >> 5; unsigned sacc = 0u; for (int bb = p; bb < blk; bb += 16) sacc += bcnt[(size_t)bb * 32 + e]; part[p * 32 + e] = sacc; }
    __syncthreads();
    if (F.tid < 32) { unsigned sacc = 0u;
#pragma unroll
        for (int p = 0; p < 16; ++p) sacc += part[p * 32 + F.tid];
        base[F.tid] = (unsigned)ts[F.tid] * 256u + sacc; lcur[F.tid] = 0u; }
    __syncthreads();
    for (int al = F.tid; al < APB; al += NTHREADS) { const int a = blk * APB + al; const int e = eidx[a];
        const int pos = (int)(base[e] + __hip_atomic_fetch_add(lcur + e, 1u, __ATOMIC_RELAXED, __HIP_MEMORY_SCOPE_WORKGROUP)); rowtok[pos] = a; }
    __syncthreads();
    const int gt = F.vcu * NTHREADS + F.tid;
    if (gt < NE * 256) { const int e = gt >> 8, r = gt & 255; const int c = (int)xb_ld(cnt + e); const int padded = (c + 255) & ~255; if (c + r < padded) rowtok[ts[e] * 256 + c + r] = -1; }
    __syncthreads();
}

struct DenseOrder {            static constexpr bool GATHER = false; __device__ __forceinline__ int rowoffB(int R, int pitch) const { return R * pitch; }
    int nM, nN, nwg, G, c; const char* A; const char* B; size_t strideA, strideB;
    __device__ void init(int nM_, int nN_, int G_, int c_, const void* A_, size_t sA, const void* B_, size_t sB) { nM = nM_; nN = nN_; nwg = nM * nN; G = G_; c = c_; A = (const char*)A_; B = (const char*)B_; strideA = sA; strideB = sB; }
    __device__ bool next(int i, pg8::Unit& u) const {
        const long L = (long)i * G + c; if (L >= nwg) return false;
        int wgid = (int)L; { const int q = nwg / 8, r = nwg % 8, xcd = wgid % 8, off = wgid / 8; wgid = (xcd < r ? xcd * (q + 1) : r * (q + 1) + (xcd - r) * q) + off; }
        const int nig = 8 * nN, gid = wgid / nig, fm = gid * 8, gsz = (nM - fm) < 8 ? (nM - fm) : 8;
        u.pm = fm + ((wgid % nig) % gsz); u.pn = (wgid % nig) / gsz; u.A = A + (size_t)u.pm * strideA; u.B = B + (size_t)u.pn * strideB; return true;
    }
};
template <bool GATHER_> struct MoeOrder {
    static constexpr bool GATHER = GATHER_;
    const LAS int* ts; int G, c; const char* A; const char* W; size_t strideA, strideE, strideN; const int* rowtok;
    __device__ __forceinline__ int rowoffB(int R, int pitch) const { return R * pitch; }
    __device__ __forceinline__ const char* abase() const { return A; }
    __device__ __forceinline__ int arow(const pg8::Unit& u, int r) const { const int a = rowtok[u.pm * 256 + r]; return a < 0 ? 0 : (a >> 1); }
    __device__ bool next(int i, pg8::Unit& u) const {
        const int L = i * G + c; const int ntile = ts[NE]; if (L >= ntile * 4) return false;
        const int rt = L >> 2, pn = L & 3; int e = 0;
#pragma unroll 1
        for (int q = 1; q < NE; ++q) e += (ts[q] <= rt) ? 1 : 0;
        u.pm = rt; u.pn = pn; u.A = A + (size_t)rt * strideA; u.B = W + (size_t)e * strideE + (size_t)pn * strideN; return true;
    }
};
struct ChanDftOrder {          static constexpr bool GATHER = false;
    int G, c; const char* A; const char* H;
    __device__ __forceinline__ int rowoffB(int R, int pitch) const { return ((R & 63) * 64 + (R >> 6)) * pitch; }
    __device__ bool next(int i, pg8::Unit& u) const {
        const int L = i * G + c; if (L >= 1024) return false;
        const int nt = L >> 3, g = (L >> 1) & 3, mt = L & 1, b = nt >> 4, t2 = nt & 15;
        u.pm = g * 2 + mt; u.pn = nt; u.A = A + (size_t)mt * 256 * 256 * 2; u.B = H + ((size_t)(b * SEQ + 4 * t2) * D + g * 256) * 2; return true;
    }
};
struct Dft1Order {             static constexpr bool GATHER = false;
    int G, c; const char* A; const char* GT1;
    __device__ __forceinline__ int rowoffB(int R, int pitch) const { return (R >> 6) * 8192 + (R & 63) * 64; }
    __device__ bool next(int i, pg8::Unit& u) const {
        const int L = i * G + c; if (L >= NB * 256) return false;
        u.pm = 0; u.pn = L; u.A = A; u.B = GT1 + (size_t)L * 4 * 8192 * 2; return true;
    }
};
struct Dft2Order {             static constexpr bool GATHER = false;
    int G, c; const char* A; const char* U;
    __device__ __forceinline__ int rowoffB(int R, int pitch) const { return R * pitch; }
    __device__ bool next(int i, pg8::Unit& u) const {
        const int L = i * G + c; if (L >= NB * 64 * 4) return false;
        const int pn = L & 3, ka = (L >> 2) & 63, b = L >> 8;
        u.pm = b * 64 + ka; u.pn = pn; u.A = A; u.B = U + ((size_t)(b * 1024 + pn * 256) * 8192 + ka * 64) * 2; return true;
    }
};

struct EpiInProj {
    static constexpr bool PERM = true;
    bf16_t *GX, *QB, *KB, *VB; const float* rope;
    __device__ __forceinline__ void operator()(const f32x4 (&acc)[2][2][4][2], const pg8::Unit& u, int wr, int wc, int fr, int fq) const {
        const int region = u.pn >> 1, cb = (u.pn & 1) * 256 + wc * 32 + 8 * fq; const bool latent = u.pm < (NLAT / 256);
        const bool dorope = latent && (region == 2 || region == 3); const int axis = wc & 1, half = fq >> 1, f0 = 8 * (fq & 1);
        if (region == 2 && !latent) return;
#pragma unroll
        for (int ai = 0; ai < 2; ++ai)
#pragma unroll
            for (int m = 0; m < 4; ++m) { const int row = u.pm * 256 + ai * 128 + wr * 64 + m * 16 + fr;
#pragma unroll
                for (int bj = 0; bj < 2; ++bj) { const int c = cb + bj * 128; float v[8];
#pragma unroll
                    for (int i = 0; i < 4; ++i) { v[i] = acc[ai][bj][m][0][i]; v[4 + i] = acc[ai][bj][m][1][i]; }
                    if (dorope) { const int tn = row & 4095, pos = axis ? (tn & 63) : (tn >> 6); const f32x4* cs = (const f32x4*)(rope + (size_t)(pos * 16 + f0) * 2);
                        const f32x4 c0 = cs[0], c1 = cs[1], c2 = cs[2], c3 = cs[3];
                        const float co[8] = {c0.x, c0.z, c1.x, c1.z, c2.x, c2.z, c3.x, c3.z}, si[8] = {c0.y, c0.w, c1.y, c1.w, c2.y, c2.w, c3.y, c3.w};
#pragma unroll
                        for (int i = 0; i < 8; ++i) { const float pv = __shfl_xor(v[i], 32); v[i] = v[i] * co[i] + (half ? pv : -pv) * si[i]; } }
                    if (region == 2) {
#pragma unroll
                        for (int i = 0; i < 8; ++i) v[i] *= QSCALE; }
                    const u32x4 w = (u32x4){pg8::cvt_pk_bf16(v[0], v[1]), pg8::cvt_pk_bf16(v[2], v[3]), pg8::cvt_pk_bf16(v[4], v[5]), pg8::cvt_pk_bf16(v[6], v[7])};
                    bf16_t* dst = region == 0 ? GX + (size_t)row * D + c : region == 1 ? GX + (size_t)row * D + 512 + c : region == 2 ? QB + (size_t)row * 512 + c : region == 3 ? KB + (size_t)row * 512 + c : VB + (size_t)row * 512 + c;
                    *(u32x4*)dst = w; } }
    }
};
struct EpiF32 {
    static constexpr bool PERM = false;
    float* C;
    __device__ __forceinline__ void operator()(const f32x4 (&acc)[2][2][4][2], const pg8::Unit& u, int wr, int wc, int fr, int fq) const {
        const int row0 = u.pm * 256 + wr * 64 + fr, col0 = u.pn * 256 + wc * 32 + 4 * fq;
#pragma unroll
        for (int ai = 0; ai < 2; ++ai)
#pragma unroll
            for (int m = 0; m < 4; ++m) { float* rowp = C + (size_t)(row0 + ai * 128 + m * 16) * D + col0;
#pragma unroll
                for (int bj = 0; bj < 2; ++bj)
#pragma unroll
                    for (int n = 0; n < 2; ++n) *(f32x4*)(rowp + bj * 128 + n * 16) = acc[ai][bj][m][n]; }
    }
};
struct EpiSwiGLU {
    static constexpr bool PERM = true;
    bf16_t* HID;
    __device__ __forceinline__ void operator()(const f32x4 (&acc)[2][2][4][2], const pg8::Unit& u, int wr, int wc, int fr, int fq) const {
        const int cb = u.pn * 256 + wc * 32 + 8 * fq;
#pragma unroll
        for (int ai = 0; ai < 2; ++ai)
#pragma unroll
            for (int m = 0; m < 4; ++m) { const int row = u.pm * 256 + ai * 128 + wr * 64 + m * 16 + fr;
#pragma unroll
                for (int bj = 0; bj < 2; ++bj) { const int j0 = ((cb + bj * 128) >> 3) * 4; const f32x4 a = acc[ai][bj][m][0], b = acc[ai][bj][m][1];
                    const float h0 = silu_f(a[0]) * b[0], h1 = silu_f(a[1]) * b[1], h2 = silu_f(a[2]) * b[2], h3 = silu_f(a[3]) * b[3];
                    *(u32x2*)(HID + (size_t)row * FF + j0) = (u32x2){pg8::cvt_pk_bf16(h0, h1), pg8::cvt_pk_bf16(h2, h3)}; } }
    }
};
struct EpiScatter {
    static constexpr bool PERM = true;
    bf16_t* MOUT; const int* rowtok; const float* ew;
    __device__ __forceinline__ void operator()(const f32x4 (&acc)[2][2][4][2], const pg8::Unit& u, int wr, int wc, int fr, int fq) const {
        const int cb = u.pn * 256 + wc * 32 + 8 * fq;
#pragma unroll
        for (int ai = 0; ai < 2; ++ai)
#pragma unroll
            for (int m = 0; m < 4; ++m) { const int row = u.pm * 256 + ai * 128 + wr * 64 + m * 16 + fr; const int a = rowtok[row];
                if (a >= 0) { const float w = ew[a]; bf16_t* dst = MOUT + ((size_t)(a & 1) * NLAT + (a >> 1)) * D + cb;
#pragma unroll
                    for (int bj = 0; bj < 2; ++bj) { const f32x4 x = acc[ai][bj][m][0] * w, y = acc[ai][bj][m][1] * w;
                        *(u32x4*)(dst + bj * 128) = (u32x4){pg8::cvt_pk_bf16(x[0], x[1]), pg8::cvt_pk_bf16(x[2], x[3]), pg8::cvt_pk_bf16(y[0], y[1]), pg8::cvt_pk_bf16(y[2], y[3])}; } } }
    }
};
struct EpiGT1 {
    static constexpr bool PERM = true;
    bf16_t* GT1;
    __device__ __forceinline__ void operator()(const f32x4 (&acc)[2][2][4][2], const pg8::Unit& u, int wr, int wc, int fr, int fq) const {
        const int g = u.pm >> 1, mt = u.pm & 1, b = u.pn >> 4, t2 = u.pn & 15; const int cl0 = wc * 32 + 8 * fq;
#pragma unroll
        for (int ai = 0; ai < 2; ++ai)
#pragma unroll
            for (int m = 0; m < 4; ++m) { const int mrow = mt * 256 + ai * 128 + wr * 64 + m * 16 + fr; const int chan = g * 256 + (mrow & 255), part = mrow >> 8;
#pragma unroll
                for (int bj = 0; bj < 2; ++bj) { const int cl = cl0 + bj * 128, n2 = 4 * t2 + (cl >> 6), n1 = cl & 63; const f32x4 x = acc[ai][bj][m][0], y = acc[ai][bj][m][1];
                    *(u32x4*)(GT1 + ((size_t)((b * 1024 + chan) * 2 + part) * 4096) + n2 * 64 + n1) = (u32x4){pg8::cvt_pk_bf16(x[0], x[1]), pg8::cvt_pk_bf16(x[2], x[3]), pg8::cvt_pk_bf16(y[0], y[1]), pg8::cvt_pk_bf16(y[2], y[3])}; } }
    }
};
struct EpiTw {
    static constexpr bool PERM = true;
    bf16_t* U; const float* tw;
    __device__ __forceinline__ void operator()(const f32x4 (&acc)[2][2][4][2], const pg8::Unit& u, int wr, int wc, int fr, int fq) const {
        const int b = u.pn >> 8, q = u.pn & 255; const int cl0 = wc * 32 + 8 * fq;
#pragma unroll
        for (int mp = 0; mp < 2; ++mp) { const int ka = 32 * wr + 16 * mp + fr;
#pragma unroll
            for (int bj = 0; bj < 2; ++bj) { const int cl = cl0 + bj * 128, chan = 4 * q + (cl >> 6), n2 = cl & 63;
                const f32x4* t4 = (const f32x4*)(tw + ((size_t)ka * 64 + n2) * 2); const f32x4 w0 = t4[0], w1 = t4[1], w2 = t4[2], w3 = t4[3];
                const float co[8] = {w0.x, w0.z, w1.x, w1.z, w2.x, w2.z, w3.x, w3.z}, si[8] = {w0.y, w0.w, w1.y, w1.w, w2.y, w2.w, w3.y, w3.w};
                float ur[8], ui[8];
#pragma unroll
                for (int i = 0; i < 8; ++i) { const float tr = acc[0][bj][mp][i >> 2][i & 3], ti = acc[0][bj][mp + 2][i >> 2][i & 3]; ur[i] = tr * co[i] + ti * si[i]; ui[i] = ti * co[i] - tr * si[i]; }
                bf16_t* dst = U + ((size_t)((b * 1024 + chan) * 2) * 4096) + ka * 64 + n2;
                *(u32x4*)dst = (u32x4){pg8::cvt_pk_bf16(ur[0], ur[1]), pg8::cvt_pk_bf16(ur[2], ur[3]), pg8::cvt_pk_bf16(ur[4], ur[5]), pg8::cvt_pk_bf16(ur[6], ur[7])};
                *(u32x4*)(dst + 4096) = (u32x4){pg8::cvt_pk_bf16(ui[0], ui[1]), pg8::cvt_pk_bf16(ui[2], ui[3]), pg8::cvt_pk_bf16(ui[4], ui[5]), pg8::cvt_pk_bf16(ui[6], ui[7])}; } }
    }
};
struct EpiYF2 {
    static constexpr bool PERM = true;
    bf16_t* YF;
    __device__ __forceinline__ void operator()(const f32x4 (&acc)[2][2][4][2], const pg8::Unit& u, int wr, int wc, int fr, int fq) const {
        if (wr != 0) return;
        const int b = u.pm >> 6, ka = u.pm & 63; const int cb = u.pn * 256 + wc * 32 + 8 * fq;
#pragma unroll
        for (int m = 0; m < 4; ++m) { const int kb = 16 * m + fr; bf16_t* dst = YF + ((size_t)b * SEQ + ka + 64 * kb) * D + cb;
#pragma unroll
            for (int bj = 0; bj < 2; ++bj) { const f32x4 x = acc[0][bj][m][0] * (1.f / 1024.f), y = acc[0][bj][m][1] * (1.f / 1024.f);
                *(u32x4*)(dst + bj * 128) = (u32x4){pg8::cvt_pk_bf16(x[0], x[1]), pg8::cvt_pk_bf16(x[2], x[3]), pg8::cvt_pk_bf16(y[0], y[1]), pg8::cvt_pk_bf16(y[2], y[3])}; } }
    }
};
struct EpiBf16S {
    static constexpr bool PERM = true;
    bf16_t* O; float scale; const float* bias;
    __device__ __forceinline__ void operator()(const f32x4 (&acc)[2][2][4][2], const pg8::Unit& u, int wr, int wc, int fr, int fq) const {
        const int cb = u.pn * 256 + wc * 32 + 8 * fq;
        f32x4 bv[2][2];
#pragma unroll
        for (int bj = 0; bj < 2; ++bj)
#pragma unroll
            for (int n = 0; n < 2; ++n) bv[bj][n] = bias ? *(const f32x4*)(bias + cb + bj * 128 + 4 * n) : (f32x4){0.f, 0.f, 0.f, 0.f};
#pragma unroll
        for (int ai = 0; ai < 2; ++ai)
#pragma unroll
            for (int m = 0; m < 4; ++m) { const int row = u.pm * 256 + ai * 128 + wr * 64 + m * 16 + fr;
#pragma unroll
                for (int bj = 0; bj < 2; ++bj) { const f32x4 x = acc[ai][bj][m][0] * scale + bv[bj][0], y = acc[ai][bj][m][1] * scale + bv[bj][1];
                    *(u32x4*)(O + (size_t)row * D + cb + bj * 128) = (u32x4){pg8::cvt_pk_bf16(x[0], x[1]), pg8::cvt_pk_bf16(x[2], x[3]), pg8::cvt_pk_bf16(y[0], y[1]), pg8::cvt_pk_bf16(y[2], y[3])}; } }
    }
};
template <class Epi, class Sched> __device__ __forceinline__ void run_gemm(Frame& F, const pg8::Shape g, const Sched& S, const Epi& E) {
#if FAST_GEMM
    pg8::Shape gg = g; asm volatile("" : "+s"(gg.K));
    pg8::gemm_phase<Epi, Sched, true>(F.lds, gg, S, E);
#else
    pg8::gemm_phase_ref<Epi, Sched>(g, S, E);
#endif
}

__device__ __forceinline__ void lru_simple(Frame& F, int b) {
    const bf16_t* GX = (const bf16_t*)(F.ws + WS_R1 + R1_GX); bf16_t* CAT = (bf16_t*)(F.ws + WS_R0); float* YF = (float*)(F.ws + WS_R2);
    const float* cw = F.in[9]; const float* cbp = F.in[10]; const float* sp = (const float*)(F.ws + WS_SMALL) + 64;
    LAS bf16_t* wl = (LAS bf16_t*)F.lds;
    LAS float* xs = (LAS float*)(F.lds + LDSCTL_OFF + LC_XS);
    const int c = F.tid, h = c >> 6, j = c & 63;
    const float w0 = cw[c], w1 = cw[LW + c], w2 = cw[2 * LW + c], w3 = cw[3 * LW + c], cb = cbp[c];
    for (int d = 0; d < 2; ++d) {
        __syncthreads();
        for (int i = F.tid; i < 2 * 8 * 64 * 64; i += NTHREADS) { const int jj = i & 63, ii = (i >> 6) & 63, hh = (i >> 12) & 7, t = i >> 15; const float* w = t ? F.in[13] : F.in[11];
            wl[i] = (bf16_t)f2bf(w[(((size_t)d * 8 + hh) * 64 + ii) * 64 + jj]); }
        __syncthreads();
        const float ba = F.in[12][d * LW + c], bx = F.in[14][d * LW + c], spc = sp[d * LW + c];
        float hst = 0.f;
        for (int step = 0; step < CTX + SEQ; ++step) {
            const bool isctx = step < CTX; const int n = isctx ? (d == 0 ? step : CTX - 1 - step) : (d == 0 ? step - CTX : SEQ - 1 - (step - CTX));
            const int len = isctx ? CTX : SEQ; const size_t row0 = isctx ? (size_t)NLAT + (size_t)b * CTX : (size_t)b * SEQ;
            float xc = cb;
            if (n - 2 >= 0) xc += bf2f(GX[(row0 + n - 2) * D + 512 + c]) * w0;
            if (n - 1 >= 0) xc += bf2f(GX[(row0 + n - 1) * D + 512 + c]) * w1;
            xc += bf2f(GX[(row0 + n) * D + 512 + c]) * w2;
            if (n + 1 < len) xc += bf2f(GX[(row0 + n + 1) * D + 512 + c]) * w3;
            __syncthreads();
            xs[c] = bf2f(f2bf(xc));
            __syncthreads();
            float ra = 0.f, rx = 0.f;
            for (int i = 0; i < 64; ++i) { const float xv = xs[h * 64 + i]; ra += xv * bf2f(wl[((0 * 8 + h) * 64 + i) * 64 + j]); rx += xv * bf2f(wl[((1 * 8 + h) * 64 + i) * 64 + j]); }
            const float r = sigmoid_f(ra + ba), ig = sigmoid_f(rx + bx);
            const float log_a = -8.f * spc * r; const float a = expf(log_a); const float mult = sqrtf(-expm1f(2.f * log_a));
            hst = a * hst + mult * ig * xc;
            if (!isctx) { const size_t o = ((size_t)b * SEQ + n) * LW + c;
                if (d == 0) YF[o] = hst;
                else { const float g = bf2f(GX[((size_t)b * SEQ + n) * D + c]); CAT[((size_t)b * SEQ + n) * D + c] = (bf16_t)f2bf((YF[o] + hst) * gelu_tanh_f(g)); } }
        }
    }
    __syncthreads();
}

__device__ __forceinline__ void attn_simple(Frame& F) {
    const bf16_t* QB = (const bf16_t*)(F.ws + WS_R1 + R1_QB); const bf16_t* KB = (const bf16_t*)(F.ws + WS_R1 + R1_KB); const bf16_t* VB = (const bf16_t*)(F.ws + WS_R1 + R1_VB);
    bf16_t* CAT = (bf16_t*)(F.ws + WS_R0); const float lam = ((const float*)(F.ws + WS_SMALL))[0]; const float* subln = F.in[17];
    LAS float* Qs = (LAS float*)F.lds;
    LAS float* Ks = Qs + 64 * 128;
    LAS float* Vs = Ks + 64 * 129;
    LAS float* Ps = Vs + 64 * 128;
    const int lane = F.lane, wv = F.wave;
    for (int u = F.vcu; u < NB * NH * (SEQ / 64); u += F.G) {
        const int qb = u & 63, h = (u >> 6) & 3, b = u >> 8;
        __syncthreads();
        for (int i = F.tid; i < 64 * 128; i += NTHREADS) { const int r = i >> 7, cc = i & 127; Qs[i] = bf2f(QB[((size_t)b * SEQ + qb * 64 + r) * 512 + h * 128 + cc]); }
        float m1[8], m2[8], l1[8], l2[8], o1a[8], o1b[8], o2a[8], o2b[8];
#pragma unroll
        for (int r = 0; r < 8; ++r) { m1[r] = -INFINITY; m2[r] = -INFINITY; l1[r] = 0.f; l2[r] = 0.f; o1a[r] = 0.f; o1b[r] = 0.f; o2a[r] = 0.f; o2b[r] = 0.f; }
        for (int pass = 0; pass < 2; ++pass) {
            for (int t = 0; t < (CTX + SEQ) / 64; ++t) {
                const size_t krow0 = t < 4 ? (size_t)NLAT + (size_t)b * CTX + t * 64 : (size_t)b * SEQ + (t - 4) * 64;
                __syncthreads();
                for (int i = F.tid; i < 64 * 128; i += NTHREADS) { const int r = i >> 7, cc = i & 127; Ks[r * 129 + cc] = bf2f(KB[(krow0 + r) * 512 + h * 128 + cc]); Vs[i] = bf2f(VB[(krow0 + r) * 512 + h * 128 + cc]); }
                __syncthreads();
#pragma unroll
                for (int r = 0; r < 8; ++r) {
                    const LAS float* q = Qs + (wv * 8 + r) * 128; const LAS float* k = Ks + lane * 129;
                    float s1 = 0.f, s2 = 0.f;
                    for (int dd = 0; dd < 64; ++dd) { s1 += q[dd] * k[dd]; s2 += q[64 + dd] * k[64 + dd]; }
                    if (pass == 0) { m1[r] = fmaxf(m1[r], s1); m2[r] = fmaxf(m2[r], s2); }
                    else {
                        const float p1 = exp2f(s1 - m1[r]), p2 = exp2f(s2 - m2[r]);
                        l1[r] += p1; l2[r] += p2;
                        Ps[(wv * 2 + 0) * 64 + lane] = p1; Ps[(wv * 2 + 1) * 64 + lane] = p2;
                        LDS_WAIT(); asm volatile("" ::: "memory");
                        float a0 = 0.f, a1 = 0.f, c0 = 0.f, c1 = 0.f;
                        for (int kk = 0; kk < 64; ++kk) { const float pp1 = Ps[(wv * 2 + 0) * 64 + kk], pp2 = Ps[(wv * 2 + 1) * 64 + kk]; const float va = Vs[kk * 128 + lane], vb = Vs[kk * 128 + 64 + lane];
                            a0 += pp1 * va; a1 += pp1 * vb; c0 += pp2 * va; c1 += pp2 * vb; }
                        o1a[r] += a0; o1b[r] += a1; o2a[r] += c0; o2b[r] += c1;
                        LDS_WAIT(); asm volatile("" ::: "memory");
                    }
                }
            }
            if (pass == 0) {
#pragma unroll
                for (int r = 0; r < 8; ++r) { m1[r] = wave_max(m1[r]); m2[r] = wave_max(m2[r]); }
            }
        }
#pragma unroll
        for (int r = 0; r < 8; ++r) {
            const float L1 = wave_sum(l1[r]), L2 = wave_sum(l2[r]);
            const float oa = o1a[r] / L1 - lam * o2a[r] / L2, ob = o1b[r] / L1 - lam * o2b[r] / L2;
            const float ms = wave_sum(oa * oa + ob * ob) * (1.f / 128.f); const float rs = 1.f / sqrtf(ms + LN_EPS);
            bf16_t* dst = CAT + ((size_t)b * SEQ + qb * 64 + wv * 8 + r) * D + 512 + h * 128;
            dst[lane] = (bf16_t)f2bf(oa * rs * subln[lane] * 0.8f); dst[64 + lane] = (bf16_t)f2bf(ob * rs * subln[64 + lane] * 0.8f);
        }
    }
    __syncthreads();
}

namespace att {
typedef float f32x16 __attribute__((ext_vector_type(16)));
typedef short s16x4 __attribute__((ext_vector_type(4)));
typedef short v4i16_t __attribute__((ext_vector_type(4)));
constexpr int KSLOT = 8192, VSLOT = 16384, NSLOT = 3, NT = (CTX + SEQ) / 64;
constexpr int L_K = 0, L_V = NSLOT * KSLOT, L_WS = L_V + NSLOT * VSLOT;
__device__ __forceinline__ int crow(int r, int hi) { return (r & 3) + 8 * (r >> 2) + 4 * hi; }
#define ATT_WAITBAR(N) asm volatile("s_waitcnt vmcnt(" #N ") lgkmcnt(0)\n\ts_barrier" ::: "memory")
__device__ __forceinline__ unsigned cvtpk(float lo, float hi) { unsigned r; asm("v_cvt_pk_bf16_f32 %0, %1, %2" : "=v"(r) : "v"(lo), "v"(hi)); return r; }
__device__ __forceinline__ s16x4 vtr(const LAS unsigned char* p) { return __builtin_bit_cast(s16x4, __builtin_amdgcn_ds_read_tr16_b64_v4i16((LAS v4i16_t*)p)); }

__device__ __forceinline__ void attn_fast(Frame& F) {
    const bf16_t* QB = (const bf16_t*)(F.ws + WS_R1 + R1_QB); const bf16_t* KB = (const bf16_t*)(F.ws + WS_R1 + R1_KB); const bf16_t* VB = (const bf16_t*)(F.ws + WS_R1 + R1_VB);
    bf16_t* CAT = (bf16_t*)(F.ws + WS_R0); const float lam = ((const float*)(F.ws + WS_SMALL))[0]; const float* subln = F.in[17];
    LAS unsigned char* lds = F.lds;
    const int lane = F.lane, r32 = lane & 31, hi = lane >> 5, wid = F.wave;
    LAS float* wsf = (LAS float*)(lds + L_WS) + wid * 64;
    for (int u = F.vcu; u < NB * NH * (SEQ / 256); u += F.G) {
        const int bh = u >> 4, qb = u & 15, b = bh >> 2, h = bh & 3;
        const size_t qrow = (size_t)b * SEQ + qb * 256 + wid * 32;
        unsigned o2p[4][8];
        f32x16 o[4];
#pragma unroll 1
        for (int pass = 0; pass < 2; ++pass) {
            const int s = 1 - pass;
            bf16x8 qf[4];
#pragma unroll
            for (int d0 = 0; d0 < 4; ++d0) qf[d0] = *(const bf16x8*)(QB + (qrow + r32) * 512 + h * 128 + s * 64 + d0 * 16 + hi * 8);
#pragma unroll
            for (int dq = 0; dq < 4; ++dq)
#pragma unroll
                for (int r = 0; r < 16; ++r) o[dq][r] = 0.f;
            float lsum = 0.f;
            const bf16_t* ksrc = KB + (size_t)lane * 512 + h * 128 + s * 64 + wid * 8;
            const bf16_t* vsrc0 = VB + (size_t)(16 * ((wid * 2) & 3) + (lane >> 2)) * 512 + h * 128 + ((wid * 2) >> 2) * 32 + (lane & 3) * 8;
            const bf16_t* vsrc1 = VB + (size_t)(16 * ((wid * 2 + 1) & 3) + (lane >> 2)) * 512 + h * 128 + ((wid * 2 + 1) >> 2) * 32 + (lane & 3) * 8;
#define ATT_DMA(t, slot) do { const size_t r0_ = ((t) < 4 ? (size_t)NLAT + (size_t)b * CTX + (t) * 64 : (size_t)b * SEQ + ((t) - 4) * 64) * 512; \
        __builtin_amdgcn_global_load_lds((const unsigned*)(ksrc + r0_), (LAS unsigned*)(lds + L_K + (slot) * KSLOT + wid * 1024), 16, 0, 0); \
        __builtin_amdgcn_global_load_lds((const unsigned*)(vsrc0 + r0_), (LAS unsigned*)(lds + L_V + (slot) * VSLOT + (wid * 2) * 1024), 16, 0, 0); \
        __builtin_amdgcn_global_load_lds((const unsigned*)(vsrc1 + r0_), (LAS unsigned*)(lds + L_V + (slot) * VSLOT + (wid * 2 + 1) * 1024), 16, 0, 0); } while (0)
            ATT_DMA(0, 0); ATT_DMA(1, 1);
            ATT_WAITBAR(3);
            int slot = 0;
#pragma unroll 1
            for (int t = 0; t < NT; ++t) {
                const int s2 = slot == 0 ? 2 : slot - 1;
                if (t + 2 < NT) ATT_DMA(t + 2, s2);
                f32x16 p0, p1;
#pragma unroll
                for (int r = 0; r < 16; ++r) { p0[r] = 0.f; p1[r] = 0.f; }
                const LAS unsigned char* kb = lds + L_K + slot * KSLOT + hi * 1024 + r32 * 16;
#pragma unroll
                for (int d0 = 0; d0 < 4; ++d0) {
                    const bf16x8 k0 = *(const LAS bf16x8*)(kb + d0 * 2048), k1 = *(const LAS bf16x8*)(kb + d0 * 2048 + 512);
                    p0 = __builtin_amdgcn_mfma_f32_32x32x16_bf16(k0, qf[d0], p0, 0, 0, 0);
                    p1 = __builtin_amdgcn_mfma_f32_32x32x16_bf16(k1, qf[d0], p1, 0, 0, 0);
                }
                float sa = 0.f, sb = 0.f;
#pragma unroll
                for (int r = 0; r < 16; ++r) { p0[r] = __builtin_amdgcn_exp2f(p0[r]); p1[r] = __builtin_amdgcn_exp2f(p1[r]); sa += p0[r]; sb += p1[r]; }
                lsum += sa + sb;
                u32x4 pk[4];
#pragma unroll
                for (int i = 0; i < 4; ++i) { pk[0][i] = cvtpk(p0[2 * i], p0[2 * i + 1]); pk[1][i] = cvtpk(p0[8 + 2 * i], p0[8 + 2 * i + 1]); pk[2][i] = cvtpk(p1[2 * i], p1[2 * i + 1]); pk[3][i] = cvtpk(p1[8 + 2 * i], p1[8 + 2 * i + 1]); }
                const LAS unsigned char* vb = lds + L_V + slot * VSLOT + ((lane >> 4) & 1) * 32 + (lane & 3) * 8 + (4 * hi + ((lane & 15) >> 2)) * 64;
#pragma unroll
                for (int dq = 0; dq < 4; ++dq)
#pragma unroll
                    for (int ks = 0; ks < 4; ++ks) {
                        const s16x4 vlo = vtr(vb + dq * 4096 + ks * 1024), vhi = vtr(vb + dq * 4096 + ks * 1024 + 512);
                        const bf16x8 vf = (bf16x8){vlo[0], vlo[1], vlo[2], vlo[3], vhi[0], vhi[1], vhi[2], vhi[3]};
                        o[dq] = __builtin_amdgcn_mfma_f32_32x32x16_bf16(__builtin_bit_cast(bf16x8, pk[ks]), vf, o[dq], 0, 0, 0);
                    }
                if (t + 2 < NT) ATT_WAITBAR(3); else ATT_WAITBAR(0);
                slot = slot == 2 ? 0 : slot + 1;
            }
#undef ATT_DMA
            { auto rr = __builtin_amdgcn_permlane32_swap(__float_as_uint(lsum), __float_as_uint(lsum), false, false); lsum = __uint_as_float(rr[0]) + __uint_as_float(rr[1]); }
            if (hi == 0) wsf[r32] = 1.0f / lsum;
            asm volatile("s_waitcnt lgkmcnt(0)" ::: "memory");
            float rl[16];
#pragma unroll
            for (int r = 0; r < 16; ++r) rl[r] = wsf[crow(r, hi)];
            asm volatile("s_waitcnt lgkmcnt(0)" ::: "memory");
            if (pass == 0) {
#pragma unroll
                for (int dq = 0; dq < 4; ++dq)
#pragma unroll
                    for (int i = 0; i < 8; ++i) o2p[dq][i] = cvtpk(lam * o[dq][2 * i] * rl[2 * i], lam * o[dq][2 * i + 1] * rl[2 * i + 1]);
            } else {
#pragma unroll
                for (int dq = 0; dq < 4; ++dq)
#pragma unroll
                    for (int r = 0; r < 16; ++r) o[dq][r] *= rl[r];
            }
        }
        float ss[16];
#pragma unroll
        for (int r = 0; r < 16; ++r) ss[r] = 0.f;
#pragma unroll
        for (int dq = 0; dq < 4; ++dq)
#pragma unroll
            for (int i = 0; i < 8; ++i) { const unsigned w = o2p[dq][i]; o[dq][2 * i] -= bflo(w); o[dq][2 * i + 1] -= bfhi(w); ss[2 * i] += o[dq][2 * i] * o[dq][2 * i]; ss[2 * i + 1] += o[dq][2 * i + 1] * o[dq][2 * i + 1]; }
#pragma unroll
        for (int r = 0; r < 16; ++r) {
#pragma unroll
            for (int off = 1; off < 32; off <<= 1) ss[r] += __shfl_xor(ss[r], off);
            ss[r] = 0.8f / sqrtf(ss[r] * (1.f / 128.f) + LN_EPS);
        }
#pragma unroll
        for (int dq = 0; dq < 4; ++dq) { const float g = subln[dq * 32 + r32];
#pragma unroll
            for (int r = 0; r < 16; ++r) { bf16_t* p_ = CAT + (qrow + 4 * hi) * D + 512 + h * 128 + r32; asm volatile("" : "+v"(p_)); p_[((r & 3) + 8 * (r >> 2)) * D + dq * 32] = (bf16_t)f2bf(o[dq][r] * ss[r] * g); } }
    }
    asm volatile("s_waitcnt vmcnt(0) lgkmcnt(0)\n\ts_barrier" ::: "memory");
}
}

namespace lru {
constexpr int NCHUNK = 68, XCB_PITCH = 272;
constexpr int L_XCB = 0, L_XCF = 17408, L_Y0 = L_XCF + 33280, L_Y1 = L_Y0 + 33280;
constexpr int L_SUM = L_Y0, L_HIN = L_SUM + (NCHUNK + 4) * 1024;
constexpr int L_BIAS = L_HIN + 1024;
static_assert(L_BIAS + 3072 <= LDSCTL_OFF && L_HIN >= L_Y1 + 33280, "LRU LDS map");
template <int K> __device__ __forceinline__ float dpp_shr(float v, float ident) { return __int_as_float(__builtin_amdgcn_update_dpp(__float_as_int(ident), __float_as_int(v), 0x110 + K, 0xf, 0xf, false)); }
template <int K> __device__ __forceinline__ float dpp_shl(float v, float ident) { return __int_as_float(__builtin_amdgcn_update_dpp(__float_as_int(ident), __float_as_int(v), 0x100 + K, 0xf, 0xf, false)); }
__device__ __forceinline__ float rcp_f(float x) { return __builtin_amdgcn_rcpf(x); }
__device__ __forceinline__ float sigm(float x) { return rcp_f(1.f + __expf(-x)); }

template <int MODE>
__device__ __forceinline__ void lru_phase(Frame& F) {
    const bf16_t* GX = (const bf16_t*)(F.ws + WS_R1 + R1_GX); bf16_t* CAT = (bf16_t*)(F.ws + WS_R0);
    const bf16_t* GW = (const bf16_t*)(F.ws + WS_GATEW); const float* SP = (const float*)(F.ws + WS_SMALL) + 64; float* SUMM = (float*)(F.ws + WS_MISC + MISC_SUMM);
    LAS unsigned char* lds = F.lds; const int tid = F.tid, lane = F.lane, wid = F.wave;
    const int quarter = F.vcu & 3;
    const int cp = tid & 63, tg = tid >> 6, c0 = quarter * 128 + 2 * cp;
    const float w00 = F.in[9][c0], w01 = F.in[9][c0 + 1], w10 = F.in[9][LW + c0], w11 = F.in[9][LW + c0 + 1], w20 = F.in[9][2 * LW + c0], w21 = F.in[9][2 * LW + c0 + 1], w30 = F.in[9][3 * LW + c0], w31 = F.in[9][3 * LW + c0 + 1];
    const float cb0 = F.in[10][c0], cb1 = F.in[10][c0 + 1];
    const int pr = wid >> 1, d = pr & 1, hl = pr >> 1, h = quarter * 2 + hl, fr = lane & 15, fq = lane >> 4;
    for (int i = tid; i < 3 * 256; i += NTHREADS) { const int cl = i & 127, dd = (i >> 7) & 1, arr = i >> 8, c = quarter * 128 + cl;
        ((LAS float*)(lds + L_BIAS))[i] = arr == 0 ? F.in[12][dd * LW + c] : arr == 1 ? F.in[14][dd * LW + c] : SP[dd * LW + c]; }
    const unsigned gwoff0 = (unsigned)((((d * 2) * 8 + h) * 64 + 16 * ((wid & 1) * 2) + fr) * 64 + 8 * fq);
    const int nunit = MODE == 0 ? NB * NCHUNK * 4 : NB * 64 * 4;
    for (int u = F.vcu; u < nunit; u += F.G) {
        const int b = MODE == 0 ? (u >> 2) / NCHUNK : u >> 8, chunk = MODE == 0 ? (u >> 2) % NCHUNK : 4 + ((u >> 2) & 63);
        const bool isctx = chunk < 4; const int tok0 = isctx ? chunk * 64 : (chunk - 4) * 64, len = isctx ? CTX : SEQ; const size_t row0 = isctx ? (size_t)NLAT + (size_t)b * CTX : (size_t)b * SEQ;
        bf16x8 af[2][2][2];
        { unsigned go = gwoff0; asm volatile("" : "+v"(go));
#pragma unroll
          for (int mi = 0; mi < 2; ++mi)
#pragma unroll
              for (int t = 0; t < 2; ++t)
#pragma unroll
                  for (int ks = 0; ks < 2; ++ks) af[mi][t][ks] = *(const bf16x8*)(GW + go + (t * 8 * 64 * 64 + mi * 16 * 64 + ks * 32)); }
        { unsigned x[11];
#pragma unroll
          for (int i = 0; i < 11; ++i) { const int n = tok0 + 8 * tg - 2 + i; x[i] = (n >= 0 && n < len) ? *(const unsigned*)(GX + (row0 + n) * D + 512 + c0) : 0u; }
          if (MODE == 1) {
              const float* S = SUMM + (size_t)b * 2 * NCHUNK * 1024 + quarter * 128; LAS float* LS = (LAS float*)(lds + L_SUM);
              for (int i = tid; i < (NCHUNK + 4) * 256; i += NTHREADS) { const int cc = i & 127, ab = (i >> 7) & 1, jj = i >> 8; const int j = jj < NCHUNK ? jj : jj - NCHUNK, dd = jj < NCHUNK ? (j < chunk ? 0 : 1) : 1;
                  LS[i] = S[((size_t)dd * NCHUNK + j) * 1024 + ab * 512 + cc]; } }
#pragma unroll
          for (int i = 0; i < 8; ++i) { const int tl = 8 * tg + i;
              const float a0 = cb0 + bflo(x[i]) * w00 + bflo(x[i + 1]) * w10 + bflo(x[i + 2]) * w20 + bflo(x[i + 3]) * w30;
              const float a1 = cb1 + bfhi(x[i]) * w01 + bfhi(x[i + 1]) * w11 + bfhi(x[i + 2]) * w21 + bfhi(x[i + 3]) * w31;
              *(LAS unsigned*)(lds + L_XCB + tl * XCB_PITCH + cp * 4) = pk2(a0, a1);
              ((LAS float*)(lds + L_XCF))[(2 * cp) * 65 + tl] = a0; ((LAS float*)(lds + L_XCF))[(2 * cp + 1) * 65 + tl] = a1; } }
        __syncthreads();
        if (MODE == 1) {
            if (tid < 256) { const int dd = tid >> 7, cl = tid & 127; const LAS float* LS = (const LAS float*)(lds + L_SUM) + cl; float hcar = 0.f;
                if (dd == 0) { for (int j = 0; j < chunk; ++j) hcar = LS[j * 256] * hcar + LS[j * 256 + 128]; }
                else { for (int j = 3; j >= 0; --j) hcar = LS[(NCHUNK + j) * 256] * hcar + LS[(NCHUNK + j) * 256 + 128];
                       for (int j = NCHUNK - 1; j > chunk; --j) hcar = LS[j * 256] * hcar + LS[j * 256 + 128]; }
                ((LAS float*)(lds + L_HIN))[tid] = hcar; }
            __syncthreads(); }
        { bf16x8 bfr[4][2];
#pragma unroll
          for (int nt = 0; nt < 4; ++nt)
#pragma unroll
              for (int ks = 0; ks < 2; ++ks) bfr[nt][ks] = *(const LAS bf16x8*)(lds + L_XCB + (16 * nt + fr) * XCB_PITCH + (hl * 64 + 32 * ks + 8 * fq) * 2);
          const int cbase = hl * 64 + (wid & 1) * 32 + 4 * fq;
          const LAS float* xcf = (const LAS float*)(lds + L_XCF) + cbase * 65 + fr; LAS float* Yd = (LAS float*)(lds + (d ? L_Y1 : L_Y0)) + cbase * 65 + fr;
#pragma unroll
          for (int mi = 0; mi < 2; ++mi) { const int mt = (wid & 1) * 2 + mi;
              f32x4 acc[2][4];
#pragma unroll
              for (int t = 0; t < 2; ++t)
#pragma unroll
                  for (int nt = 0; nt < 4; ++nt) { acc[t][nt] = (f32x4){0.f, 0.f, 0.f, 0.f};
#pragma unroll
                      for (int ks = 0; ks < 2; ++ks) acc[t][nt] = __builtin_amdgcn_mfma_f32_16x16x32_bf16(af[mi][t][ks], bfr[nt][ks], acc[t][nt], 0, 0, 0); }
#pragma unroll
              for (int reg = 0; reg < 4; ++reg) { const int cl = hl * 64 + 16 * mt + 4 * fq + reg, c = quarter * 128 + cl;
                  const LAS float* bb_ = (const LAS float*)(lds + L_BIAS) + d * 128 + cbase + 16 * mi + reg; const float ba = bb_[0], bx = bb_[256], spc = bb_[512];
                  float A[4], Bv[4];
#pragma unroll
                  for (int nt = 0; nt < 4; ++nt) { const float xcv = xcf[(16 * mi + reg) * 65 + 16 * nt];
                      const float r = sigm(acc[0][nt][reg] + ba), ig = sigm(acc[1][nt][reg] + bx);
                      const float la = -8.f * spc * r, a = __expf(la), x2 = 2.f * la;
                      const float m2 = x2 > -0.3f ? -x2 * (1.f + x2 * (0.5f + x2 * (1.f / 6.f + x2 * (1.f / 24.f + x2 * (1.f / 120.f + x2 * (1.f / 720.f + x2 * (1.f / 5040.f))))))) : 1.f - __expf(x2);
                      A[nt] = a; Bv[nt] = sqrtf(m2) * ig * xcv; }
                  if (d == 0) {
#pragma unroll
                      for (int nt = 0; nt < 4; ++nt) {
                          { const float ap = dpp_shr<1>(A[nt], 1.f), bp = dpp_shr<1>(Bv[nt], 0.f); Bv[nt] = A[nt] * bp + Bv[nt]; A[nt] *= ap; }
                          { const float ap = dpp_shr<2>(A[nt], 1.f), bp = dpp_shr<2>(Bv[nt], 0.f); Bv[nt] = A[nt] * bp + Bv[nt]; A[nt] *= ap; }
                          { const float ap = dpp_shr<4>(A[nt], 1.f), bp = dpp_shr<4>(Bv[nt], 0.f); Bv[nt] = A[nt] * bp + Bv[nt]; A[nt] *= ap; }
                          { const float ap = dpp_shr<8>(A[nt], 1.f), bp = dpp_shr<8>(Bv[nt], 0.f); Bv[nt] = A[nt] * bp + Bv[nt]; A[nt] *= ap; } }
                      if (MODE == 0) { float Ac = 1.f, Bc = 0.f;
#pragma unroll
                          for (int nt = 0; nt < 4; ++nt) { const float At = __shfl(A[nt], (lane & 48) | 15), Bt = __shfl(Bv[nt], (lane & 48) | 15); Bc = At * Bc + Bt; Ac *= At; }
                          if (fr == 0) { float* S = SUMM + ((size_t)(b * 2 + d) * NCHUNK + chunk) * 1024 + c; S[0] = Ac; S[512] = Bc; } }
                      else { float hc = ((const LAS float*)(lds + L_HIN))[d * 128 + cl];
#pragma unroll
                          for (int nt = 0; nt < 4; ++nt) { const float hv = A[nt] * hc + Bv[nt]; Yd[(16 * mi + reg) * 65 + 16 * nt] = hv; hc = __shfl(hv, (lane & 48) | 15); } }
                  } else {
#pragma unroll
                      for (int nt = 0; nt < 4; ++nt) {
                          { const float ap = dpp_shl<1>(A[nt], 1.f), bp = dpp_shl<1>(Bv[nt], 0.f); Bv[nt] = A[nt] * bp + Bv[nt]; A[nt] *= ap; }
                          { const float ap = dpp_shl<2>(A[nt], 1.f), bp = dpp_shl<2>(Bv[nt], 0.f); Bv[nt] = A[nt] * bp + Bv[nt]; A[nt] *= ap; }
                          { const float ap = dpp_shl<4>(A[nt], 1.f), bp = dpp_shl<4>(Bv[nt], 0.f); Bv[nt] = A[nt] * bp + Bv[nt]; A[nt] *= ap; }
                          { const float ap = dpp_shl<8>(A[nt], 1.f), bp = dpp_shl<8>(Bv[nt], 0.f); Bv[nt] = A[nt] * bp + Bv[nt]; A[nt] *= ap; } }
                      if (MODE == 0) { float Ac = 1.f, Bc = 0.f;
#pragma unroll
                          for (int nt = 3; nt >= 0; --nt) { const float At = __shfl(A[nt], lane & 48), Bt = __shfl(Bv[nt], lane & 48); Bc = At * Bc + Bt; Ac *= At; }
                          if (fr == 0) { float* S = SUMM + ((size_t)(b * 2 + d) * NCHUNK + chunk) * 1024 + c; S[0] = Ac; S[512] = Bc; } }
                      else { float hc = ((const LAS float*)(lds + L_HIN))[d * 128 + cl];
#pragma unroll
                          for (int nt = 3; nt >= 0; --nt) { const float hv = A[nt] * hc + Bv[nt]; Yd[(16 * mi + reg) * 65 + 16 * nt] = hv; hc = __shfl(hv, lane & 48); } }
                  }
                  __builtin_amdgcn_sched_barrier(0);
              } } }
        __syncthreads();
        if (MODE == 1) {
            const LAS float* Y0 = (const LAS float*)(lds + L_Y0); const LAS float* Y1 = (const LAS float*)(lds + L_Y1);
#pragma unroll
            for (int i = 0; i < 8; ++i) { const int tl = 8 * tg + i; const size_t row = row0 + tok0 + tl; const unsigned g = *(const unsigned*)(GX + row * D + c0);
                const float y0 = Y0[(2 * cp) * 65 + tl] + Y1[(2 * cp) * 65 + tl], y1 = Y0[(2 * cp + 1) * 65 + tl] + Y1[(2 * cp + 1) * 65 + tl];
                *(unsigned*)(CAT + row * D + c0) = pk2(y0 * gelu_tanh_f(bflo(g)), y1 * gelu_tanh_f(bfhi(g))); }
            __syncthreads();
        }
    }
}
}

constexpr int NPHASE = 18;
__global__ void __launch_bounds__(NTHREADS, 2) mk_fwd(Args args) {
    extern __shared__ __attribute__((aligned(16))) unsigned char lds_raw[];
    Frame F{(LAS unsigned char*)lds_raw, (unsigned*)(args.ws + WS_CTL), args.ws, 0, 0, 0, 0, 0, InRef{args}, args.out};
    F.tid = threadIdx.x; F.lane = F.tid & 63; F.wave = __builtin_amdgcn_readfirstlane(F.tid >> 6);
    F.G = gridDim.x; { const int bx = blockIdx.x; F.vcu = (F.G % 8 == 0) ? (bx % 8) * (F.G / 8) + bx / 8 : bx; }
    for (int u = F.tid; u < (LDS_BYTES - LDSCTL_OFF) / 4; u += NTHREADS) ((LAS unsigned*)(F.lds + LDSCTL_OFF))[u] = 0u;
    __syncthreads();
    XcdBarrier bar = xcd_barrier_post(F.ctl + CW_BAR, (volatile LAS unsigned*)(F.lds + LDSCTL_OFF + LC_BAR));
#if defined(PH_RUNTIME)
    const int lo = args.ph_lo, hi = args.ph_hi;
#else
    constexpr int lo = 0, hi = NPHASE;
#endif
#ifndef TIME_PHASE
#define TIME_PHASE -1
#endif
#ifndef REP3
#define REP3 0u
#endif
#ifndef REP_MASK
#define REP_MASK 0u
#endif
#define REPS(k) for (int rep_ = 0; rep_ <= (int)((REP_MASK >> (k)) & 1u); ++rep_)
#define REPBAR() do { if (rep_ > 0) xcd_barrier(bar); } while (0)
#ifndef SKIP_MASK
#define SKIP_MASK 0u
#endif
#define IN(k) (!((SKIP_MASK >> (k)) & 1u) && lo <= (k) && (k) < hi)
#define SEAM(k) do { if (IN(k) && IN((k) + 1)) xcd_barrier(bar); } while (0)
#define TPB(k) do { if ((k) == TIME_PHASE && blockIdx.x == 0 && threadIdx.x == 0) ((volatile LAS unsigned long long*)(F.lds + LDSCTL_OFF + LC_TP))[0] = __builtin_amdgcn_s_memrealtime(); } while (0)
#define TPE(k) do { if ((k) == TIME_PHASE && blockIdx.x == 0 && threadIdx.x == 0) { volatile LAS unsigned long long* tp_ = (volatile LAS unsigned long long*)(F.lds + LDSCTL_OFF + LC_TP); tp_[1] = tp_[1] + (__builtin_amdgcn_s_memrealtime() - tp_[0]); } } while (0)
#define PHB() do { int t_ = threadIdx.x; asm volatile("" : "+v"(t_)); F.tid = t_; F.lane = t_ & 63; F.wave = __builtin_amdgcn_readfirstlane(t_ >> 6); } while (0)
    unsigned char* ws = args.ws;
    bf16_t* R0 = (bf16_t*)(ws + WS_R0); unsigned char* R1 = ws + WS_R1;

    TPB(0); if (IN(0)) REPS(0) { REPBAR(); PHB(); p0_prologue(F); } SEAM(0); TPE(0);
    TPB(1); if (IN(1)) REPS(1) { REPBAR(); PHB(); p1_lnmod(F); } SEAM(1); TPE(1);
    TPB(2); if (IN(2)) REPS(2) { REPBAR();
        DenseOrder S; S.init(MALL / 256, INE / 256, F.G, (int)blockIdx.x, R0, (size_t)256 * D * 2, ws + WS_WIN, (size_t)256 * D * 2);
        EpiInProj E{(bf16_t*)(R1 + R1_GX), (bf16_t*)(R1 + R1_QB), (bf16_t*)(R1 + R1_KB), (bf16_t*)(R1 + R1_VB), (const float*)(ws + WS_ROPE)};
        run_gemm(F, pg8::Shape{D, D, D, 0u, 0u}, S, E);
    } SEAM(2); TPE(2);
    TPB(3); if (IN(3)) REPS(3) { REPBAR();
#if FAST_LRU
        for (int q_ = 0; q_ <= (int)(REP3 & 1u); ++q_) { PHB(); lru::lru_phase<0>(F); }
        xcd_barrier(bar);
        for (int q_ = 0; q_ <= (int)((REP3 >> 1) & 1u); ++q_) { PHB(); lru::lru_phase<1>(F); }
#else
        PHB(); if ((int)blockIdx.x < NB) lru_simple(F, (int)blockIdx.x);
#endif
#if FAST_ATTN
        for (int q_ = 0; q_ <= (int)((REP3 >> 2) & 1u); ++q_) { PHB(); att::attn_fast(F); }
#else
        PHB(); attn_simple(F);
#endif
    } SEAM(3); TPE(3);
    TPB(4); if (IN(4)) REPS(4) { REPBAR();
        DenseOrder S; S.init(NLAT / 256, D / 256, F.G, (int)blockIdx.x, R0, (size_t)256 * D * 2, ws + WS_WOUT, (size_t)256 * D * 2);
        EpiBf16S E{(bf16_t*)R1, 1.f, nullptr};
        run_gemm(F, pg8::Shape{D, D, D, 0u, 0u}, S, E);
    } SEAM(4); TPE(4);
    TPB(5); if (IN(5)) { PHB(); row_phase_a(F, 0, F.in[0]); } SEAM(5); TPE(5);
#pragma unroll
    for (int layer = 0; layer < 2; ++layer) {
        const int pb = layer == 0 ? 6 : 14;
        unsigned char* moew = ws + WS_MOEW + (size_t)layer * MOEW_LAYER;
        TPB(pb); if (IN(pb)) { PHB(); moe_positions(F, layer); } SEAM(pb); TPE(pb);
        TPB(pb + 1); if (IN(pb + 1)) REPS(pb + 1) { REPBAR();
            PHB(); moe_tile_prefix(F, layer);
            MoeOrder<true> S{(const LAS int*)(F.lds + LDSCTL_OFF + LC_TSTART), F.G, (int)blockIdx.x, (const char*)R0, (const char*)moew, (size_t)0, (size_t)D * D * 2, (size_t)256 * D * 2, (const int*)(ws + WS_MISC + MISC_ROWTOK)};
            EpiSwiGLU E{(bf16_t*)(ws + WS_R2)};
            run_gemm(F, pg8::Shape{D, D, D, 0u, 0u}, S, E);
        } SEAM(pb + 1); TPE(pb + 1);
        TPB(pb + 2); if (IN(pb + 2)) REPS(pb + 2) { REPBAR();
            PHB(); moe_tile_prefix(F, layer);
            MoeOrder<false> S{(const LAS int*)(F.lds + LDSCTL_OFF + LC_TSTART), F.G, (int)blockIdx.x, (const char*)(ws + WS_R2), (const char*)(moew + MOEW_W2), (size_t)256 * FF * 2, (size_t)D * FF * 2, (size_t)256 * FF * 2, (const int*)(ws + WS_MISC + MISC_ROWTOK)};
            EpiScatter E{(bf16_t*)R1, (const int*)(ws + WS_MISC + MISC_ROWTOK), (const float*)(ws + WS_MISC + MISC_EW)};
            run_gemm(F, pg8::Shape{FF, FF, FF, 0u, 0u}, S, E);
        } SEAM(pb + 2); TPE(pb + 2);
        TPB(pb + 3); if (IN(pb + 3)) { PHB(); row_phase_b(F, layer, layer == 0); } SEAM(pb + 3); TPE(pb + 3);
        if (layer == 0) {
            TPB(10); if (IN(10)) REPS(10) { REPBAR();
                { ChanDftOrder S{F.G, (int)blockIdx.x, (const char*)(ws + WS_CDFT), (const char*)R0};
                  EpiGT1 E{(bf16_t*)R1};
                  run_gemm(F, pg8::Shape{256, 256, D, 0u, (unsigned)(2 * D * 2)}, S, E); }
                xcd_barrier(bar);
                { Dft1Order S{F.G, (int)blockIdx.x, (const char*)(ws + WS_M1), (const char*)R1};
                  EpiTw E{(bf16_t*)(ws + WS_U), (const float*)(ws + WS_TW)};
                  run_gemm(F, pg8::Shape{128, 128, 0, (unsigned)(4096 * 2), (unsigned)(2 * 8192 * 2)}, S, E); }
            } SEAM(10); TPE(10);
            TPB(11); if (IN(11)) REPS(11) { REPBAR();
                Dft2Order S{F.G, (int)blockIdx.x, (const char*)(ws + WS_M3), (const char*)(ws + WS_U)};
                EpiYF2 E{R0};
                run_gemm(F, pg8::Shape{128, 128, 8192, (unsigned)(4096 * 2), 0u}, S, E);
            } SEAM(11); TPE(11);
            TPB(12); if (IN(12)) REPS(12) { REPBAR();
                DenseOrder S; S.init(NLAT / 256, D / 256, F.G, (int)blockIdx.x, R0, (size_t)256 * D * 2, ws + WS_ODW, (size_t)256 * D * 2);
                EpiBf16S E{(bf16_t*)R1, 1.f, F.in[20]};
                run_gemm(F, pg8::Shape{D, D, D, 0u, 0u}, S, E);
            } SEAM(12); TPE(12);
            TPB(13); if (IN(13)) { PHB(); row_phase_a(F, 1, F.out); } SEAM(13); TPE(13);
        }
    }
    if ((TIME_PHASE >= 0 || TIME_SUB >= 0) && blockIdx.x == 0 && threadIdx.x == 0) { const unsigned long long tp_acc = ((volatile LAS unsigned long long*)(F.lds + LDSCTL_OFF + LC_TP))[1];
        const unsigned long long t0 = __builtin_amdgcn_s_memrealtime(); while (__builtin_amdgcn_s_memrealtime() - t0 < 8ull * tp_acc) __builtin_amdgcn_s_sleep(8); }
#undef IN
#undef SEAM
}

extern "C" void kernel_launch(void* const* d_in, const int* in_sizes, int n_in, void* d_out, int out_size, void* d_ws, size_t ws_size, hipStream_t stream) {
    static int grid = 0;
    if (grid == 0) {
        if (n_in != 28 || out_size != NLAT * D || ws_size < WS_END) { fprintf(stderr, "kernel_launch: unexpected problem (n_in %d, out %d, ws %zu < %zu)\n", n_in, out_size, ws_size, (size_t)WS_END); grid = -1; return; }
        int dev = 0, cus = 0, per_cu = 0;
        if (hipGetDevice(&dev) != hipSuccess || hipDeviceGetAttribute(&cus, hipDeviceAttributeMultiprocessorCount, dev) != hipSuccess) { grid = -1; return; }
        if (hipFuncSetAttribute((const void*)mk_fwd, hipFuncAttributeMaxDynamicSharedMemorySize, LDS_BYTES) != hipSuccess) { fprintf(stderr, "kernel_launch: hipFuncSetAttribute failed\n"); grid = -1; return; }
        if (hipOccupancyMaxActiveBlocksPerMultiprocessor(&per_cu, (const void*)mk_fwd, NTHREADS, LDS_BYTES) != hipSuccess || per_cu < 1) fprintf(stderr, "kernel_launch: occupancy query reports %d\n", per_cu);
        (void)hipGetLastError();
        grid = cus;
        if (grid > 256) grid = 256;
        if ((NLAT / 32) % grid != 0) { fprintf(stderr, "kernel_launch: %d CUs: the row phases need a workgroup count dividing 1024\n", cus); grid = -1; return; }
    }
    if (grid < 0) return;
    if (hipMemsetAsync((char*)d_ws + WS_CTL, 0, CTL_ZERO_BYTES, stream) != hipSuccess) return;
    Args a{};
    for (int i = 0; i < 28; ++i) a.in[i] = (const float*)d_in[i];
    a.out = (float*)d_out; a.ws = (unsigned char*)d_ws; a.ph_lo = 0; a.ph_hi = NPHASE;
    hipLaunchKernelGGL(mk_fwd, dim3(grid), dim3(NTHREADS), LDS_BYTES, stream, a);
}
```
